# Optimizing an MI355X kernel written in HIP

```python
import jax, jax.numpy as jnp
from jax import lax
import numpy as np

D_MODEL = 1024
BATCH = 8
SEQ = 4096
DEPTH = 2
DEC_BATCH = 8
DEC_SEQ = 16
PAST_LEN = 1024

CHUNK = 64
N_EVEN = (DEPTH + 1) // 2
N_ODD = DEPTH // 2
MIX_W = D_MODEL // 2
PROJ_W = 5 * MIX_W
CONV_A_W = 31
CONV_B_W = 3
HEAD_DIM_C = 64
N_HEADS_C = MIX_W // HEAD_DIM_C
BAND_CHUNKS = 8
ATT_WINDOW = BAND_CHUNKS * CHUNK
BAND = ATT_WINDOW + CHUNK
REL_CLIP = 4 * CHUNK
SGU_CHUNK = 128
SGU_GROUPS = 4
SGU_GDIM = MIX_W // SGU_GROUPS
FFN_HIDDEN = ((8 * D_MODEL // 3 + 255) // 256) * 256
NEG_INF = -1e30

kernel_name = 'hybrid_streaming_conv_band_attn_sgu_step'


def rmsnorm(x, g, eps=1e-6):
    xf = x.astype(jnp.float32)
    y = xf * lax.rsqrt(jnp.mean(xf * xf, axis=-1, keepdims=True) + eps)
    return (y * g.astype(jnp.float32)).astype(x.dtype)


def layernorm(x, g, b, eps=1e-5):
    xf = x.astype(jnp.float32)
    mu = jnp.mean(xf, axis=-1, keepdims=True)
    xc = xf - mu
    var = jnp.mean(xc * xc, axis=-1, keepdims=True)
    y = xc * lax.rsqrt(var + eps) * g.astype(jnp.float32) + b.astype(jnp.float32)
    return y.astype(x.dtype)


def causal_dwconv(x, prev, w):
    xp = jnp.concatenate([prev.astype(x.dtype), x], axis=1)
    y = lax.conv_general_dilated(xp, w[:, None, :].astype(x.dtype), window_strides=(1,),
                                 padding='VALID', dimension_numbers=('NWC', 'WIO', 'NWC'),
                                 feature_group_count=x.shape[-1])
    return y, xp[:, -(w.shape[0] - 1):]


def conv_mixers(h, prev_a, prev_b, w_in, a_w, a_b, a_ln_g, a_ln_b, b_w, w_out):
    p = h @ w_in
    a_val, a_gate, g_b, g_c, b_h = jnp.split(p, 5, axis=-1)
    a = a_val * jax.nn.sigmoid(a_gate)
    a_conv, new_a = causal_dwconv(a, prev_a, a_w)
    a_out = jax.nn.silu(layernorm(a_conv + a_b.astype(a_conv.dtype), a_ln_g, a_ln_b))
    z = g_c * b_h
    z_conv, new_b = causal_dwconv(z, prev_b, b_w)
    b_out = g_b * z_conv
    return jnp.concatenate([a_out, b_out], axis=-1) @ w_out, new_a, new_b


def odd_project(h, w_in, q_g, k_g):
    p = h @ w_in
    q, k, v, u, sv = jnp.split(p, 5, axis=-1)
    B, T = h.shape[:2]
    q = rmsnorm(q.reshape(B, T, N_HEADS_C, HEAD_DIM_C), q_g)
    k = rmsnorm(k.reshape(B, T, N_HEADS_C, HEAD_DIM_C), k_g)
    v = v.reshape(B, T, N_HEADS_C, HEAD_DIM_C)
    return q, k, v, u, sv


def rel_bias_lookup(rel_bias, d):
    return rel_bias[:, jnp.clip(d, -REL_CLIP, REL_CLIP) + REL_CLIP].astype(jnp.float32)


def band_attention_prompt(q, k, v, rel_bias):
    B, T = q.shape[:2]
    nc = T // CHUNK
    pad = jnp.zeros((B, ATT_WINDOW, N_HEADS_C, HEAD_DIM_C), k.dtype)
    kp = jnp.concatenate([pad, k], axis=1)
    vp = jnp.concatenate([pad, v], axis=1)
    idx = jnp.arange(nc)[:, None] * CHUNK + jnp.arange(BAND)[None, :]
    kb = kp[:, idx]
    vb = vp[:, idx]
    qc = q.reshape(B, nc, CHUNK, N_HEADS_C, HEAD_DIM_C)
    s = jnp.einsum('bcqhd,bckhd->bhcqk', qc, kb).astype(jnp.float32) * (HEAD_DIM_C ** -0.5)
    d = jnp.arange(CHUNK)[:, None] + ATT_WINDOW - jnp.arange(BAND)[None, :]
    s = s + rel_bias_lookup(rel_bias, d)[None, :, None]
    valid = idx >= ATT_WINDOW
    s = jnp.where(valid[None, None, :, None, :], s, NEG_INF)
    pr = jax.nn.softmax(s, axis=-1).astype(v.dtype)
    o = jnp.einsum('bhcqk,bckhd->bcqhd', pr, vb)
    return o.reshape(B, T, MIX_W)


def band_attention_sample(q, k, v, cache_k, cache_v, rel_bias):
    B, Tn = q.shape[:2]
    L = cache_k.shape[1]
    kf = jnp.concatenate([cache_k.astype(k.dtype), k], axis=1)
    vf = jnp.concatenate([cache_v.astype(v.dtype), v], axis=1)
    s = jnp.einsum('bqhd,bkhd->bhqk', q, kf).astype(jnp.float32) * (HEAD_DIM_C ** -0.5)
    d = jnp.arange(Tn)[:, None] - (jnp.arange(L + Tn)[None, :] - L)
    s = s + rel_bias_lookup(rel_bias, d)[None]
    pr = jax.nn.softmax(s, axis=-1).astype(v.dtype)
    o = jnp.einsum('bhqk,bkhd->bqhd', pr, vf)
    return o.reshape(B, Tn, MIX_W)


def spatial_gating(u, sv, ln_g, ln_b, w_s, b_s):
    B, T = u.shape[:2]
    lc = min(T, SGU_CHUNK)
    nc = T // lc
    svn = layernorm(sv, ln_g, ln_b)
    vc = svn.reshape(B, nc, lc, SGU_GROUPS, SGU_GDIM)
    wm = jnp.tril(w_s[:, :lc, :lc]).astype(u.dtype)
    s = jnp.einsum('gij,bcjgd->bcigd', wm, vc) + jnp.transpose(b_s[:, :lc]).astype(u.dtype)[:, :, None]
    return u * s.reshape(B, T, MIX_W), svn


def swiglu(h, w_gate_up, w_down):
    g, up = jnp.split(h @ w_gate_up, 2, axis=-1)
    return (jax.nn.silu(g) * up) @ w_down


def setup_inputs(seed: int = 0) -> dict:
    key = jax.random.key(seed)
    ks = jax.random.split(key, 32)
    att_cache = min(ATT_WINDOW, PAST_LEN)

    def nrm(k, shape, scale):
        return jax.random.normal(k, shape, jnp.float32) * scale

    return {
        'x_prompt': nrm(ks[0], (BATCH, SEQ, D_MODEL), 1.0),
        'x_sample': nrm(ks[1], (DEC_BATCH, DEC_SEQ, D_MODEL), 1.0),
        'cache_conv_a': nrm(ks[2], (N_EVEN, DEC_BATCH, CONV_A_W - 1, MIX_W), 0.5),
        'cache_conv_b': nrm(ks[3], (N_EVEN, DEC_BATCH, CONV_B_W - 1, MIX_W), 0.5),
        'cache_k': nrm(ks[4], (N_ODD, DEC_BATCH, att_cache, N_HEADS_C, HEAD_DIM_C), 1.0),
        'cache_v': nrm(ks[5], (N_ODD, DEC_BATCH, att_cache, N_HEADS_C, HEAD_DIM_C), 1.0),
        'norm_mix_even': 1.0 + nrm(ks[6], (N_EVEN, D_MODEL), 0.1),
        'w_in_even': nrm(ks[7], (N_EVEN, D_MODEL, PROJ_W), D_MODEL ** -0.5),
        'conv_a_w': nrm(ks[8], (N_EVEN, CONV_A_W, MIX_W), CONV_A_W ** -0.5),
        'conv_a_b': nrm(ks[9], (N_EVEN, MIX_W), 0.01),
        'ln_a_g': 1.0 + nrm(ks[10], (N_EVEN, MIX_W), 0.1),
        'ln_a_b': nrm(ks[11], (N_EVEN, MIX_W), 0.01),
        'conv_b_w': nrm(ks[12], (N_EVEN, CONV_B_W, MIX_W), CONV_B_W ** -0.5),
        'w_out_even': nrm(ks[13], (N_EVEN, 2 * MIX_W, D_MODEL), (2 * MIX_W) ** -0.5),
        'norm_mix_odd': 1.0 + nrm(ks[14], (N_ODD, D_MODEL), 0.1),
        'w_in_odd': nrm(ks[15], (N_ODD, D_MODEL, PROJ_W), D_MODEL ** -0.5),
        'q_norm_g': 1.0 + nrm(ks[16], (N_ODD, HEAD_DIM_C), 0.1),
        'k_norm_g': 1.0 + nrm(ks[17], (N_ODD, HEAD_DIM_C), 0.1),
        'rel_bias': nrm(ks[18], (N_ODD, N_HEADS_C, 2 * REL_CLIP + 1), 0.1),
        'sgu_ln_g': 1.0 + nrm(ks[19], (N_ODD, MIX_W), 0.1),
        'sgu_ln_b': nrm(ks[20], (N_ODD, MIX_W), 0.01),
        'sgu_w': nrm(ks[21], (N_ODD, SGU_GROUPS, SGU_CHUNK, SGU_CHUNK), SGU_CHUNK ** -0.5),
        'sgu_b': 1.0 + nrm(ks[22], (N_ODD, SGU_GROUPS, SGU_CHUNK), 0.1),
        'w_out_odd': nrm(ks[23], (N_ODD, 2 * MIX_W, D_MODEL), (2 * MIX_W) ** -0.5),
        'norm_ffn': 1.0 + nrm(ks[24], (DEPTH, D_MODEL), 0.1),
        'w_gate_up': nrm(ks[25], (DEPTH, D_MODEL, 2 * FFN_HIDDEN), D_MODEL ** -0.5),
        'w_down': nrm(ks[26], (DEPTH, FFN_HIDDEN, D_MODEL), FFN_HIDDEN ** -0.5),
    }


def reference(x_prompt, x_sample, cache_conv_a, cache_conv_b, cache_k, cache_v,
              norm_mix_even, w_in_even, conv_a_w, conv_a_b, ln_a_g, ln_a_b, conv_b_w, w_out_even,
              norm_mix_odd, w_in_odd, q_norm_g, k_norm_g, rel_bias, sgu_ln_g, sgu_ln_b, sgu_w, sgu_b,
              w_out_odd, norm_ffn, w_gate_up, w_down):
    xp, xs = x_prompt, x_sample
    conv_a_p, conv_b_p, k_p, v_p = [], [], [], []
    conv_a_s, conv_b_s, k_s, v_s, sv_s = [], [], [], [], []
    for layer in range(DEPTH):
        i = layer // 2
        if layer % 2 == 0:
            params = (w_in_even[i], conv_a_w[i], conv_a_b[i], ln_a_g[i], ln_a_b[i], conv_b_w[i], w_out_even[i])
            zero_a = jnp.zeros((xp.shape[0], CONV_A_W - 1, MIX_W), xp.dtype)
            zero_b = jnp.zeros((xp.shape[0], CONV_B_W - 1, MIX_W), xp.dtype)
            mix_p, na_p, nb_p = conv_mixers(rmsnorm(xp, norm_mix_even[i]), zero_a, zero_b, *params)
            mix_s, na_s, nb_s = conv_mixers(rmsnorm(xs, norm_mix_even[i]), cache_conv_a[i], cache_conv_b[i], *params)
            conv_a_p.append(na_p)
            conv_b_p.append(nb_p)
            conv_a_s.append(na_s)
            conv_b_s.append(nb_s)
        else:
            q, k, v, u, sv = odd_project(rmsnorm(xp, norm_mix_odd[i]), w_in_odd[i], q_norm_g[i], k_norm_g[i])
            att = band_attention_prompt(q, k, v, rel_bias[i])
            sg, _ = spatial_gating(u, sv, sgu_ln_g[i], sgu_ln_b[i], sgu_w[i], sgu_b[i])
            mix_p = jnp.concatenate([att, sg], axis=-1) @ w_out_odd[i]
            keep = min(ATT_WINDOW, xp.shape[1])
            k_p.append(k[:, -keep:])
            v_p.append(v[:, -keep:])
            q, k, v, u, sv = odd_project(rmsnorm(xs, norm_mix_odd[i]), w_in_odd[i], q_norm_g[i], k_norm_g[i])
            att = band_attention_sample(q, k, v, cache_k[i], cache_v[i], rel_bias[i])
            sg, svn = spatial_gating(u, sv, sgu_ln_g[i], sgu_ln_b[i], sgu_w[i], sgu_b[i])
            mix_s = jnp.concatenate([att, sg], axis=-1) @ w_out_odd[i]
            k_s.append(k)
            v_s.append(v)
            sv_s.append(svn)
        xp = xp + mix_p
        xs = xs + mix_s
        xp = xp + swiglu(rmsnorm(xp, norm_ffn[layer]), w_gate_up[layer], w_down[layer])
        xs = xs + swiglu(rmsnorm(xs, norm_ffn[layer]), w_gate_up[layer], w_down[layer])
    return (xp, xs,
            jnp.stack(conv_a_p), jnp.stack(conv_b_p), jnp.stack(k_p), jnp.stack(v_p),
            jnp.stack(conv_a_s), jnp.stack(conv_b_s), jnp.stack(k_s), jnp.stack(v_s), jnp.stack(sv_s))
```

```cpp
#include <hip/hip_runtime.h>
#include <hip/hip_cooperative_groups.h>
#include <cstdio>
#include <cstdint>
namespace cg = cooperative_groups;

#ifndef MK_ONE_LAUNCH
#define MK_ONE_LAUNCH 1
#endif

#define LAS __attribute__((address_space(3)))
typedef unsigned short bf16_t;
typedef short bf16x8 __attribute__((ext_vector_type(8)));
typedef short s16x4 __attribute__((ext_vector_type(4)));
typedef float f32x4 __attribute__((ext_vector_type(4)));
typedef float f32x2 __attribute__((ext_vector_type(2)));
typedef float f32x16 __attribute__((ext_vector_type(16)));
typedef unsigned u32x4 __attribute__((ext_vector_type(4)));
typedef unsigned u32x2 __attribute__((ext_vector_type(2)));
typedef __bf16 bf16x2_t __attribute__((ext_vector_type(2)));

#define DI __device__ __forceinline__

constexpr int D = 1024, MP = 32768, MS = 128, MREAL = MP + MS, MT = 33024;
constexpr int SEQ = 4096, NB = 8, DSEQ = 16;
constexpr int MW = 512, PW = 2560, FH = 2816;
constexpr float LOG2E = 1.4426950408889634f;
constexpr float QSCALE = 0.125f * LOG2E;

constexpr size_t O_Y = 0;
constexpr size_t O_CAP = 33685504, O_CBP = 33808384, O_KP = 33816576, O_VP = 35913728;
constexpr size_t O_CAS = 38010880, O_CBS = 38133760, O_KS = 38141952, O_VS = 38207488, O_SVS = 38273024;

constexpr size_t MiB = 1u << 20;
constexpr size_t WS_SS = 1 * MiB;
constexpr size_t WS_SVST = 4 * MiB;
constexpr size_t WS_WIN0 = 8 * MiB, WS_WOUT0 = 13 * MiB, WS_WGU0 = 15 * MiB, WS_WDN0 = 26 * MiB;
constexpr size_t WS_WIN1 = 32 * MiB, WS_WOUT1 = 37 * MiB, WS_WGU1 = 39 * MiB, WS_WDN1 = 50 * MiB;
constexpr size_t WS_XN = 56 * MiB;
constexpr size_t WS_A = 122 * MiB;
constexpr size_t SUB = (size_t)MT * MW * 2;
constexpr size_t WS_CAT = 284 * MiB;
constexpr size_t WS_HID = 122 * MiB;
constexpr size_t WS_END = 349 * MiB;

constexpr int LDS_BYTES = 163840;

DI unsigned pk2(float lo, float hi) { f32x2 v = {lo, hi}; bf16x2_t b = __builtin_convertvector(v, bf16x2_t); return __builtin_bit_cast(unsigned, b); }
DI float bflo(unsigned u) { return __uint_as_float(u << 16); }
DI float bfhi(unsigned u) { return __uint_as_float(u & 0xffff0000u); }
DI u32x4 pk8(f32x4 a, f32x4 b) { u32x4 w; w.x = pk2(a[0], a[1]); w.y = pk2(a[2], a[3]); w.z = pk2(b[0], b[1]); w.w = pk2(b[2], b[3]); return w; }
DI void unpack8(const u32x4 w, float (&f)[8]) { f[0] = bflo(w.x); f[1] = bfhi(w.x); f[2] = bflo(w.y); f[3] = bfhi(w.y); f[4] = bflo(w.z); f[5] = bfhi(w.z); f[6] = bflo(w.w); f[7] = bfhi(w.w); }
DI float sigmoidf_(float x) { return __builtin_amdgcn_rcpf(1.0f + __expf(-x)); }
DI float wave_sum(float v) {
#pragma unroll
    for (int o = 1; o < 64; o <<= 1) v += __shfl_xor(v, o);
    return v;
}

namespace pg8 {
constexpr int BM = 256, BK = 64, HALF = 128, HTB = HALF * BK * 2, STAGE_BYTES = 8 * HTB, NXCD = 8, WGM = 8;
__host__ __device__ __forceinline__ int lds_byte(int r, int c) { const int st = (r >> 4) * 2 + (c >> 5), rr = r & 15, cc = c & 31, ob = rr * 64 + cc * 2; return st * 1024 + (ob ^ (((ob >> 9) & 1) << 5)); }
__host__ __device__ __forceinline__ void stage_rc(int b, int& R, int& C) { const int st = b / 1024, sb = b % 1024, swz = sb ^ (((sb >> 9) & 1) << 5); R = (st >> 1) * 16 + swz / 64; C = (st & 1) * 32 + (swz % 64) / 2; }
__host__ __device__ __forceinline__ int perm32(int rho) { const int n = rho >> 4, i = rho & 15; return 8 * (i >> 2) + 4 * n + (i & 3); }

struct Unit { int pm, pn; };
struct Gemm { const bf16_t* A; const bf16_t* Bt; int M, N, K; };

struct StaticOrder {
    int nM, nN, nwg, G, c;
    __device__ void init(int M, int N, int G_, int c_) { nM = M / BM; nN = N / BM; nwg = nM * nN; G = G_; c = c_; }
    __device__ bool next(int i, Unit& u) const {
        const long L = (long)i * G + c; if (L >= nwg) return false;
        int wgid = (int)L; { const int q = nwg / NXCD, r = nwg % NXCD, xcd = wgid % NXCD, off = wgid / NXCD; wgid = (xcd < r ? xcd * (q + 1) : r * (q + 1) + (xcd - r) * q) + off; }
        const int nig = WGM * nN, gid = wgid / nig, fm = gid * WGM, gsz = (nM - fm) < WGM ? (nM - fm) : WGM;
        u.pm = fm + ((wgid % nig) % gsz); u.pn = (wgid % nig) / gsz; return true;
    }
};

template <class Epi, bool ALIGN_EPI>
__device__ __forceinline__ void gemm_phase(LAS unsigned char* lds, const Gemm g, const StaticOrder& S, const Epi& E) {
    const int tid = threadIdx.x, wid = __builtin_amdgcn_readfirstlane(tid >> 6), lane = tid & 63, wr = wid >> 2, wc = wid & 3, fr = lane & 15, fq = lane >> 4;
    const int K = g.K, nt = K / BK;
    unsigned voffA[2], voffB[2];
#pragma unroll
    for (int i = 0; i < 2; ++i) { int R, C; stage_rc(tid * 16 + i * 8192, R, C); const int Rb = Epi::PERM ? ((R & ~31) + perm32(R & 31)) : R;
        voffA[i] = (unsigned)(R * K + C) * 2u; voffB[i] = (unsigned)(Rb * K + C) * 2u; }
    const size_t kstep = (size_t)(BK * 2);
    const size_t hstep = (size_t)HALF * K * 2;
    const size_t tstep = 2 * hstep;
    const unsigned ldsw = (unsigned)wid * 1024u;
    const int aoff = lds_byte(wr * 64 + fr, fq * 8), boff = lds_byte(wc * 32 + fr, fq * 8);
#define PG8_SA(b, h) (((b) * 2 + (h)) * HTB)
#define PG8_SB(b, h) ((4 + (b) * 2 + (h)) * HTB)
#define PG8_STAGE(bufoff, gbase, voff) do { _Pragma("unroll") for (int _i = 0; _i < 2; ++_i) \
        __builtin_amdgcn_global_load_lds((const unsigned*)((const char*)(gbase) + (voff)[_i]), (LAS unsigned*)(lds + (bufoff) + ldsw + _i * 8192), 16, 0, 0); } while (0)
#define PG8_LDA(dst, b, h) do { _Pragma("unroll") for (int m = 0; m < 4; ++m) _Pragma("unroll") for (int k = 0; k < 2; ++k) dst[m][k] = *(const LAS bf16x8*)(lds + PG8_SA(b, h) + aoff + m * 2048 + k * 1024); } while (0)
#define PG8_LDB(dst, b, h) do { _Pragma("unroll") for (int n = 0; n < 2; ++n) _Pragma("unroll") for (int k = 0; k < 2; ++k) dst[n][k] = *(const LAS bf16x8*)(lds + PG8_SB(b, h) + boff + n * 2048 + k * 1024); } while (0)
#define PG8_MMA(ai, bj, At, Bt) do { __builtin_amdgcn_s_setprio(1); _Pragma("unroll") for (int m = 0; m < 4; ++m) _Pragma("unroll") for (int n = 0; n < 2; ++n) _Pragma("unroll") for (int k = 0; k < 2; ++k) \
        acc[ai][bj][m][n] = __builtin_amdgcn_mfma_f32_16x16x32_bf16(Bt[n][k], At[m][k], acc[ai][bj][m][n], 0, 0, 0); __builtin_amdgcn_s_setprio(0); } while (0)
#define PG8_WAIT_V(n) asm volatile("s_waitcnt vmcnt(" #n ")" ::: "memory")
#define PG8_WAIT_L(n) asm volatile("s_waitcnt lgkmcnt(" #n ")" ::: "memory")
#define PG8_BAR __builtin_amdgcn_s_barrier()
#define PG8_SCHED __builtin_amdgcn_sched_barrier(0)
    Unit cur, nxt; int ui = 0;
    if (!S.next(0, cur)) return;
    f32x4 acc[2][2][4][2];
#pragma unroll
    for (int a = 0; a < 2; ++a)
#pragma unroll
        for (int b = 0; b < 2; ++b)
#pragma unroll
            for (int m = 0; m < 4; ++m)
#pragma unroll
                for (int n = 0; n < 2; ++n) acc[a][b][m][n] = (f32x4){0.f, 0.f, 0.f, 0.f};
    bf16x8 At[4][2], B0[2][2], B1[2][2];
    const char* cA = (const char*)g.A + (size_t)cur.pm * tstep; const char* cB = (const char*)g.Bt + (size_t)cur.pn * tstep;
    PG8_STAGE(PG8_SB(0, 0), cB, voffB); PG8_STAGE(PG8_SB(0, 1), cB + hstep, voffB); PG8_STAGE(PG8_SA(0, 0), cA, voffA); PG8_STAGE(PG8_SA(0, 1), cA + hstep, voffA);
    if (wr == 1) PG8_BAR;
    PG8_WAIT_V(2); PG8_BAR;
    PG8_STAGE(PG8_SB(1, 0), cB + kstep, voffB); PG8_STAGE(PG8_SA(1, 0), cA + kstep, voffA); PG8_STAGE(PG8_SB(1, 1), cB + hstep + kstep, voffB);
    PG8_WAIT_V(6); PG8_BAR;
    for (;;) {
        const bool has_next = S.next(ui + 1, nxt);
        const char* nA = has_next ? (const char*)g.A + (size_t)nxt.pm * tstep : cA; const char* nB = has_next ? (const char*)g.Bt + (size_t)nxt.pn * tstep : cB;
        for (int t = 0; t < nt; t += 2) {
            const bool last = (t == nt - 2);
            const char* a1 = cA + (size_t)(t + 1) * kstep;
            const char* a2 = last ? nA : cA + (size_t)(t + 2) * kstep; const char* b2 = last ? nB : cB + (size_t)(t + 2) * kstep;
            const char* a3 = a2 + kstep; const char* b3 = b2 + kstep;
            PG8_LDB(B0, 0, 0); PG8_LDB(B1, 0, 1); PG8_SCHED; PG8_LDA(At, 0, 0); PG8_STAGE(PG8_SA(1, 1), a1 + hstep, voffA);
            PG8_WAIT_V(8); PG8_WAIT_L(0); PG8_BAR; PG8_MMA(0, 0, At, B0); PG8_MMA(0, 1, At, B1); PG8_BAR; PG8_SCHED;
            PG8_LDA(At, 0, 1); PG8_STAGE(PG8_SB(0, 0), b2, voffB); PG8_STAGE(PG8_SB(0, 1), b2 + hstep, voffB); PG8_STAGE(PG8_SA(0, 0), a2, voffA);
            PG8_WAIT_V(8); PG8_WAIT_L(0); PG8_BAR; PG8_MMA(1, 0, At, B0); PG8_MMA(1, 1, At, B1); PG8_BAR; PG8_SCHED;
            PG8_LDB(B0, 1, 0); PG8_LDB(B1, 1, 1); PG8_SCHED; PG8_LDA(At, 1, 0); PG8_STAGE(PG8_SA(0, 1), a2 + hstep, voffA);
            PG8_WAIT_V(8); PG8_WAIT_L(0); PG8_BAR; PG8_MMA(0, 0, At, B0); PG8_MMA(0, 1, At, B1); PG8_BAR; PG8_SCHED;
            PG8_LDA(At, 1, 1); PG8_STAGE(PG8_SB(1, 0), b3, voffB); PG8_STAGE(PG8_SB(1, 1), b3 + hstep, voffB); PG8_STAGE(PG8_SA(1, 0), a3, voffA);
            PG8_WAIT_V(8); PG8_WAIT_L(0); PG8_BAR; PG8_MMA(1, 0, At, B0); PG8_MMA(1, 1, At, B1); PG8_BAR; PG8_SCHED;
        }
        if constexpr (ALIGN_EPI) { if (wr == 0) PG8_BAR; }
        E(acc, cur, wr, wc, fr, fq);
        if (!has_next) break;
#pragma unroll
        for (int a = 0; a < 2; ++a)
#pragma unroll
            for (int b = 0; b < 2; ++b)
#pragma unroll
                for (int m = 0; m < 4; ++m)
#pragma unroll
                    for (int n = 0; n < 2; ++n) acc[a][b][m][n] = (f32x4){0.f, 0.f, 0.f, 0.f};
        cur = nxt; cA = nA; cB = nB; ++ui;
        if constexpr (ALIGN_EPI) { if (wr == 1) PG8_BAR; }
    }
    PG8_WAIT_V(0);
    if constexpr (!ALIGN_EPI) { if (wr == 0) PG8_BAR; }
    PG8_BAR;
#undef PG8_SA
#undef PG8_SB
#undef PG8_STAGE
#undef PG8_LDA
#undef PG8_LDB
#undef PG8_MMA
#undef PG8_WAIT_V
#undef PG8_WAIT_L
#undef PG8_BAR
#undef PG8_SCHED
}
}

typedef f32x4 Acc[2][2][4][2];

DI float row_rstd(const float* SS, int row) { return rsqrtf(SS[row] * (1.0f / 1024.0f) + 1e-6f); }

struct EpiInEven {
    static constexpr bool PERM = true;
    const float* SS; bf16_t *A0, *Z0, *GB0;
    DI void operator()(const Acc& acc, const pg8::Unit& u, int wr, int wc, int fr, int fq) const {
        const int row0 = u.pm * 256 + wr * 64 + fr, cl = wc * 32 + fq * 8;
        float rsv[2][4];
#pragma unroll
        for (int ai = 0; ai < 2; ++ai)
#pragma unroll
            for (int m = 0; m < 4; ++m) rsv[ai][m] = row_rstd(SS, row0 + ai * 128 + m * 16);
        if (u.pn < 8) {
            bf16_t* O = (u.pn < 4) ? A0 : Z0; const int colb = (u.pn & 3) * 128 + cl; const bool glu = u.pn < 4;
#pragma unroll
            for (int ai = 0; ai < 2; ++ai)
#pragma unroll
                for (int m = 0; m < 4; ++m) {
                    const int row = row0 + ai * 128 + m * 16;
                    const float rs = rsv[ai][m];
                    f32x4 x0 = acc[ai][0][m][0] * rs, x1 = acc[ai][0][m][1] * rs, y0 = acc[ai][1][m][0] * rs, y1 = acc[ai][1][m][1] * rs;
                    if (glu) {
#pragma unroll
                        for (int i = 0; i < 4; ++i) { y0[i] = sigmoidf_(y0[i]); y1[i] = sigmoidf_(y1[i]); }
                    }
                    *(u32x4*)(O + (size_t)row * MW + colb) = pk8(x0 * y0, x1 * y1);
                }
        } else {
            const int colb = (u.pn - 8) * 256 + cl;
#pragma unroll
            for (int ai = 0; ai < 2; ++ai)
#pragma unroll
                for (int m = 0; m < 4; ++m) {
                    const int row = row0 + ai * 128 + m * 16;
                    const float rs = rsv[ai][m];
#pragma unroll
                    for (int bj = 0; bj < 2; ++bj) *(u32x4*)(GB0 + (size_t)row * MW + colb + bj * 128) = pk8(acc[ai][bj][m][0] * rs, acc[ai][bj][m][1] * rs);
                }
        }
    }
};

template <int MODE> struct EpiResid {
    static constexpr bool PERM = true;
    const float* xin; float* out; bf16_t* XN; float* SS;
    DI void operator()(const Acc& acc, const pg8::Unit& u, int wr, int wc, int fr, int fq) const {
        const int colb = u.pn * 256 + wc * 32 + fq * 8;
        const int row0 = u.pm * 256 + wr * 64 + fr;
        if (MODE == 0) {
#pragma unroll
            for (int ai = 0; ai < 2; ++ai) {
                f32x4 rx[4][2][2];
#pragma unroll
                for (int m = 0; m < 4; ++m)
#pragma unroll
                    for (int bj = 0; bj < 2; ++bj) { const float* s = xin + (size_t)(row0 + ai * 128 + m * 16) * D + colb + bj * 128; rx[m][bj][0] = *(const f32x4*)s; rx[m][bj][1] = *(const f32x4*)(s + 4); }
#pragma unroll
                for (int m = 0; m < 4; ++m) {
                    const int row = row0 + ai * 128 + m * 16;
                    float ssq = 0.f;
#pragma unroll
                    for (int bj = 0; bj < 2; ++bj) {
                        const f32x4 v0 = rx[m][bj][0] + acc[ai][bj][m][0], v1 = rx[m][bj][1] + acc[ai][bj][m][1];
                        ssq += (v0[0] * v0[0] + v0[1] * v0[1]) + (v0[2] * v0[2] + v0[3] * v0[3]) + (v1[0] * v1[0] + v1[1] * v1[1]) + (v1[2] * v1[2] + v1[3] * v1[3]);
                        *(u32x4*)(XN + (size_t)row * D + colb + bj * 128) = pk8(v0, v1);
                    }
                    ssq += __shfl_xor(ssq, 16); ssq += __shfl_xor(ssq, 32);
                    if (fq == 0) atomicAdd(SS + row, ssq);
                }
            }
        } else {
#pragma unroll
            for (int ai = 0; ai < 2; ++ai) {
                u32x4 rx[4][2];
#pragma unroll
                for (int m = 0; m < 4; ++m)
#pragma unroll
                    for (int bj = 0; bj < 2; ++bj) rx[m][bj] = *(const u32x4*)(XN + (size_t)(row0 + ai * 128 + m * 16) * D + colb + bj * 128);
#pragma unroll
                for (int m = 0; m < 4; ++m) {
                    const int row = row0 + ai * 128 + m * 16;
                    float ssq = 0.f;
#pragma unroll
                    for (int bj = 0; bj < 2; ++bj) {
                        const int col = colb + bj * 128;
                        float f[8]; unpack8(rx[m][bj], f);
                        const f32x4 v0 = (f32x4){f[0], f[1], f[2], f[3]} + acc[ai][bj][m][0], v1 = (f32x4){f[4], f[5], f[6], f[7]} + acc[ai][bj][m][1];
                        if (MODE == 2) { *(f32x4*)(out + (size_t)row * D + col) = v0; *(f32x4*)(out + (size_t)row * D + col + 4) = v1; }
                        else {
                            ssq += (v0[0] * v0[0] + v0[1] * v0[1]) + (v0[2] * v0[2] + v0[3] * v0[3]) + (v1[0] * v1[0] + v1[1] * v1[1]) + (v1[2] * v1[2] + v1[3] * v1[3]);
                            *(u32x4*)(XN + (size_t)row * D + col) = pk8(v0, v1);
                        }
                    }
                    if (MODE != 2) {
                        ssq += __shfl_xor(ssq, 16); ssq += __shfl_xor(ssq, 32);
                        if (fq == 0) atomicAdd(SS + row, ssq);
                    }
                }
            }
        }
    }
};

struct EpiGateUp {
    static constexpr bool PERM = true;
    const float* SS; bf16_t* HID;
    DI void operator()(const Acc& acc, const pg8::Unit& u, int wr, int wc, int fr, int fq) const {
        const int colb = u.pn * 128 + wc * 32 + fq * 8;
        float rsv[2][4];
#pragma unroll
        for (int ai = 0; ai < 2; ++ai)
#pragma unroll
            for (int m = 0; m < 4; ++m) rsv[ai][m] = row_rstd(SS, u.pm * 256 + ai * 128 + wr * 64 + m * 16 + fr);
#pragma unroll
        for (int ai = 0; ai < 2; ++ai)
#pragma unroll
            for (int m = 0; m < 4; ++m) {
                const int row = u.pm * 256 + ai * 128 + wr * 64 + m * 16 + fr;
                const float rs = rsv[ai][m];
                f32x4 h0, h1;
#pragma unroll
                for (int i = 0; i < 4; ++i) {
                    const float g0 = acc[ai][0][m][0][i] * rs, g1 = acc[ai][0][m][1][i] * rs;
                    h0[i] = g0 * sigmoidf_(g0) * (acc[ai][1][m][0][i] * rs);
                    h1[i] = g1 * sigmoidf_(g1) * (acc[ai][1][m][1][i] * rs);
                }
                *(u32x4*)(HID + (size_t)row * FH + colb) = pk8(h0, h1);
            }
    }
};

struct EpiInOdd {
    static constexpr bool PERM = true;
    const float* SS; bf16_t* QKVUS; const float* qg; const float* kg; float* SVST; float* out;
    DI void operator()(const Acc& acc, const pg8::Unit& u, int wr, int wc, int fr, int fq) const {
        const int typ = u.pn >> 1, ph = u.pn & 1;
        bf16_t* O = QKVUS + (size_t)typ * ((size_t)MT * MW);
        const bool samp = (u.pm == 128);
        const bool keep = samp || ((u.pm & 15) >= 14);
        float rsv[2][4];
#pragma unroll
        for (int ai = 0; ai < 2; ++ai)
#pragma unroll
            for (int m = 0; m < 4; ++m) rsv[ai][m] = row_rstd(SS, u.pm * 256 + ai * 128 + wr * 64 + m * 16 + fr);
        if (typ < 2) {
            const float* gsrc = typ == 0 ? qg : kg;
            f32x4 gv[2][2];
#pragma unroll
            for (int bj = 0; bj < 2; ++bj)
#pragma unroll
                for (int n = 0; n < 2; ++n) gv[bj][n] = *(const f32x4*)(gsrc + 32 * bj + 8 * fq + 4 * n);
            const float osc = typ == 0 ? QSCALE : 1.0f;
            const int head = ph * 4 + wc;
#pragma unroll
            for (int ai = 0; ai < 2; ++ai)
#pragma unroll
                for (int m = 0; m < 4; ++m) {
                    const int row = u.pm * 256 + ai * 128 + wr * 64 + m * 16 + fr;
                    const float rs = rsv[ai][m];
                    f32x4 v[2][2]; float ssq = 0.f;
#pragma unroll
                    for (int bj = 0; bj < 2; ++bj)
#pragma unroll
                        for (int n = 0; n < 2; ++n) { v[bj][n] = acc[ai][bj][m][n] * rs; const f32x4 t = v[bj][n]; ssq += (t[0] * t[0] + t[1] * t[1]) + (t[2] * t[2] + t[3] * t[3]); }
                    ssq += __shfl_xor(ssq, 16); ssq += __shfl_xor(ssq, 32);
                    const float r = rsqrtf(ssq * (1.0f / 64.0f) + 1e-6f);
#pragma unroll
                    for (int bj = 0; bj < 2; ++bj) {
                        const f32x4 o0 = v[bj][0] * r * gv[bj][0], o1 = v[bj][1] * r * gv[bj][1];
                        *(u32x4*)(O + (size_t)row * MW + head * 64 + 32 * bj + 8 * fq) = pk8(o0 * osc, o1 * osc);
                        if (typ == 1 && keep && !(samp && ai == 1)) {
                            float* dst;
                            if (samp) dst = out + O_KS + (size_t)(row - MP) * 512;
                            else { const int b = u.pm >> 4, t = (u.pm & 15) * 256 + ai * 128 + wr * 64 + m * 16 + fr - 3584; dst = out + O_KP + ((size_t)b * 512 + t) * 512; }
                            dst += head * 64 + 32 * bj + 8 * fq;
                            *(f32x4*)dst = o0; *(f32x4*)(dst + 4) = o1;
                        }
                    }
                }
        } else {
#pragma unroll
            for (int ai = 0; ai < 2; ++ai)
#pragma unroll
                for (int m = 0; m < 4; ++m) {
                    const int row = u.pm * 256 + ai * 128 + wr * 64 + m * 16 + fr;
                    const float rs = rsv[ai][m];
                    float s1 = 0.f, s2 = 0.f;
#pragma unroll
                    for (int bj = 0; bj < 2; ++bj) {
                        const f32x4 o0 = acc[ai][bj][m][0] * rs, o1 = acc[ai][bj][m][1] * rs;
                        const int col = ph * 256 + bj * 128 + wc * 32 + fq * 8;
                        *(u32x4*)(O + (size_t)row * MW + col) = pk8(o0, o1);
                        if (typ == 4) {
                            s1 += (o0[0] + o0[1]) + (o0[2] + o0[3]) + (o1[0] + o1[1]) + (o1[2] + o1[3]);
                            s2 += (o0[0] * o0[0] + o0[1] * o0[1]) + (o0[2] * o0[2] + o0[3] * o0[3]) + (o1[0] * o1[0] + o1[1] * o1[1]) + (o1[2] * o1[2] + o1[3] * o1[3]);
                        }
                        if (typ == 2 && keep && !(samp && ai == 1)) {
                            float* dst;
                            if (samp) dst = out + O_VS + (size_t)(row - MP) * 512;
                            else { const int b = u.pm >> 4, t = (u.pm & 15) * 256 + ai * 128 + wr * 64 + m * 16 + fr - 3584; dst = out + O_VP + ((size_t)b * 512 + t) * 512; }
                            dst += col;
                            *(f32x4*)dst = o0; *(f32x4*)(dst + 4) = o1;
                        }
                    }
                    if (typ == 4) {
                        s1 += __shfl_xor(s1, 16); s1 += __shfl_xor(s1, 32); s2 += __shfl_xor(s2, 16); s2 += __shfl_xor(s2, 32);
                        if (fq == 0) *(f32x2*)(SVST + ((size_t)row * 8 + ph * 4 + wc) * 2) = (f32x2){s1, s2};
                    }
                }
        }
    }
};


DI float red16(float v) { v += __shfl_xor(v, 1); v += __shfl_xor(v, 2); v += __shfl_xor(v, 4); v += __shfl_xor(v, 8); return v; }
DI f32x4 shx8(const f32x4 v) { f32x4 o; o[0] = __shfl_xor(v[0], 8); o[1] = __shfl_xor(v[1], 8); o[2] = __shfl_xor(v[2], 8); o[3] = __shfl_xor(v[3], 8); return o; }
DI u32x2 pk4(const f32x4 a) { return (u32x2){pk2(a[0], a[1]), pk2(a[2], a[3])}; }

struct SEpiInEven {
    const float* SS; bf16_t *A0, *Z0, *GB0;
    DI void operator()(const f32x4 vraw, int row, int pn, int wc, int bj, int cl) const {
        const f32x4 v = vraw * row_rstd(SS, row);
        const f32x4 o = shx8(v);
        if (pn < 8) {
            if (bj == 0) {
                f32x4 y = o;
                if (pn < 4) {
#pragma unroll
                    for (int i = 0; i < 4; ++i) y[i] = sigmoidf_(y[i]);
                }
                bf16_t* O = (pn < 4) ? A0 : Z0;
                *(u32x2*)(O + (size_t)row * MW + (pn & 3) * 128 + wc * 32 + cl) = pk4(v * y);
            }
        } else *(u32x2*)(GB0 + (size_t)row * MW + (pn - 8) * 256 + bj * 128 + wc * 32 + cl) = pk4(v);
    }
};
template <int MODE> struct SEpiResid {
    const float* xin; float* out; bf16_t* XN; float* SS;
    DI void operator()(const f32x4 v, int row, int pn, int wc, int bj, int cl) const {
        const int col = pn * 256 + bj * 128 + wc * 32 + cl;
        f32x4 x;
        if (MODE == 0) x = *(const f32x4*)(xin + (size_t)row * D + col);
        else { const u32x2 w = *(const u32x2*)(XN + (size_t)row * D + col); x = (f32x4){bflo(w.x), bfhi(w.x), bflo(w.y), bfhi(w.y)}; }
        x += v;
        if (MODE == 2) *(f32x4*)(out + (size_t)row * D + col) = x;
        else {
            *(u32x2*)(XN + (size_t)row * D + col) = pk4(x);
            const float ssq = red16((x[0] * x[0] + x[1] * x[1]) + (x[2] * x[2] + x[3] * x[3]));
            if ((threadIdx.x & 15) == 0) atomicAdd(SS + row, ssq);
        }
    }
};
struct SEpiGateUp {
    const float* SS; bf16_t* HID;
    DI void operator()(const f32x4 v, int row, int pn, int wc, int bj, int cl) const {
        const float rs = row_rstd(SS, row);
        const f32x4 o = shx8(v);
        if (bj == 0) {
            f32x4 hv;
#pragma unroll
            for (int i = 0; i < 4; ++i) { const float g0 = v[i] * rs; hv[i] = g0 * sigmoidf_(g0) * (o[i] * rs); }
            *(u32x2*)(HID + (size_t)row * FH + pn * 128 + wc * 32 + cl) = pk4(hv);
        }
    }
};
struct SEpiInOdd {
    const float* SS; bf16_t* QKVUS; const float* qg; const float* kg; float* SVST; float* out;
    DI void operator()(const f32x4 v, int row, int pn, int wc, int bj, int cl) const {
        const int typ = pn >> 1, ph = pn & 1;
        bf16_t* O = QKVUS + (size_t)typ * ((size_t)MT * MW);
        const float rs = row_rstd(SS, row);
        const f32x4 x = v * rs;
        if (typ < 2) {
            const int head = ph * 4 + wc, dd = 32 * bj + cl;
            const float ssq = red16((x[0] * x[0] + x[1] * x[1]) + (x[2] * x[2] + x[3] * x[3]));
            const float r = rsqrtf(ssq * (1.0f / 64.0f) + 1e-6f);
            const f32x4 gv = *(const f32x4*)((typ == 0 ? qg : kg) + dd);
            const f32x4 o = x * r * gv;
            *(u32x2*)(O + (size_t)row * MW + head * 64 + dd) = pk4(o * (typ == 0 ? QSCALE : 1.0f));
            if (typ == 1) *(f32x4*)(out + O_KS + (size_t)(row - MP) * 512 + head * 64 + dd) = o;
        } else {
            const int col = ph * 256 + bj * 128 + wc * 32 + cl;
            *(u32x2*)(O + (size_t)row * MW + col) = pk4(x);
            if (typ == 2) *(f32x4*)(out + O_VS + (size_t)(row - MP) * 512 + col) = x;
            if (typ == 4) {
                const float s1 = red16((x[0] + x[1]) + (x[2] + x[3])), s2 = red16((x[0] * x[0] + x[1] * x[1]) + (x[2] * x[2] + x[3] * x[3]));
                if ((threadIdx.x & 15) == 0) *(f32x2*)(SVST + ((size_t)row * 8 + ph * 4 + wc) * 2) = (f32x2){s1, s2};
            }
        }
    }
};

template <class EpiS>
DI void sample_gemm(LAS unsigned char* lds, const bf16_t* A, const bf16_t* Bt, int nN, int K, const EpiS& E) {
    const int tid = threadIdx.x, lane = tid & 63, w = __builtin_amdgcn_readfirstlane(tid >> 6), r32 = lane & 31, h = lane >> 5;
    const int nunits = 16 * nN, kw = K >> 3, nk = kw >> 4;
    for (int un = (int)blockIdx.x; un < nunits; un += (int)gridDim.x) {
        const int rb = un & 3, wc = (un >> 2) & 3, pn = un >> 4;
        const bf16_t* ap = A + (size_t)(MP + rb * 32 + r32) * K + w * kw + h * 8;
        const bf16_t* b0p = Bt + (size_t)(pn * 256 + wc * 32 + r32) * K + w * kw + h * 8;
        const bf16_t* b1p = b0p + (size_t)128 * K;
        f32x16 c0, c1;
#pragma unroll
        for (int r = 0; r < 16; ++r) { c0[r] = 0.f; c1[r] = 0.f; }
#pragma unroll 8
        for (int ks = 0; ks < nk; ++ks) {
            const bf16x8 a = *(const bf16x8*)(ap + ks * 16), b0 = *(const bf16x8*)(b0p + ks * 16), b1 = *(const bf16x8*)(b1p + ks * 16);
            c0 = __builtin_amdgcn_mfma_f32_32x32x16_bf16(a, b0, c0, 0, 0, 0);
            c1 = __builtin_amdgcn_mfma_f32_32x32x16_bf16(a, b1, c1, 0, 0, 0);
        }
        __syncthreads();
        LAS float* part = (LAS float*)(lds + w * 8192);
#pragma unroll
        for (int r = 0; r < 16; ++r) { const int row = (r & 3) + 8 * (r >> 2) + 4 * h; part[row * 64 + r32] = c0[r]; part[row * 64 + 32 + r32] = c1[r]; }
        __syncthreads();
        f32x4 v = (f32x4){0.f, 0.f, 0.f, 0.f};
#pragma unroll
        for (int ww = 0; ww < 8; ++ww) v += *(const LAS f32x4*)(lds + ww * 8192 + (tid >> 4) * 256 + (tid & 15) * 16);
        E(v, MP + rb * 32 + (tid >> 4), pn, wc, (tid >> 3) & 1, 4 * (tid & 7));
    }
    __syncthreads();
}

struct Params {
    const float* in[27];
    float* out;
    unsigned char* ws;
    int ph_lo, ph_hi;
};

DI int map_col(int kind, int n) {
    if (kind == 1) { const int seg = n >> 9, o = n & 511, t = o >> 7, r = o & 127;
        if (seg == 0) return t * 256 + r; if (seg == 1) return t * 256 + 128 + r; if (seg == 2) return 2048 + o;
        if (seg == 3) return 1024 + t * 256 + r; return 1024 + t * 256 + 128 + r; }
    if (kind == 2) { const int up = n >= FH ? 1 : 0, o = up ? n - FH : n; return (o >> 7) * 256 + up * 128 + (o & 127); }
    if (kind == 3) { if (n >= 1024) return n; const int t = n >> 8, hl = (n >> 6) & 3, dd = n & 63; return t * 256 + (dd >> 5) * 128 + hl * 32 + (dd & 31); }
    return n;
}
DI void transpose_item(const float* W, int K, int N, bf16_t* WT, int kind, const float* gain, LAS float* scr, int item, int lane) {
    const int nblk = N / 64, kb = item / nblk, nb = item % nblk, k0 = 64 * kb, n0 = 64 * nb;
    const int lr = lane >> 4, lc = (lane & 15) * 4;
    f32x4 v[16];
#pragma unroll
    for (int i = 0; i < 16; ++i) v[i] = *(const f32x4*)(W + (size_t)(k0 + 4 * i + lr) * N + n0 + lc);
    if (gain) {
        float gk[16];
#pragma unroll
        for (int i = 0; i < 16; ++i) gk[i] = gain[k0 + 4 * i + lr];
#pragma unroll
        for (int i = 0; i < 16; ++i) v[i] *= gk[i];
    }
#pragma unroll
    for (int i = 0; i < 16; ++i) { LAS float* d = scr + (4 * i + lr) * 65 + lc; d[0] = v[i][0]; d[1] = v[i][1]; d[2] = v[i][2]; d[3] = v[i][3]; }
    asm volatile("s_waitcnt lgkmcnt(0)" ::: "memory");
    const int c = lane & 7;
#pragma unroll
    for (int j = 0; j < 8; ++j) { const int n = (lane >> 3) + 8 * j; const LAS float* s = scr + (8 * c) * 65 + n;
        u32x4 o; o.x = pk2(s[0 * 65], s[1 * 65]); o.y = pk2(s[2 * 65], s[3 * 65]); o.z = pk2(s[4 * 65], s[5 * 65]); o.w = pk2(s[6 * 65], s[7 * 65]);
        *(u32x4*)(WT + (size_t)map_col(kind, n0 + n) * K + k0 + 8 * c) = o; }
    asm volatile("s_waitcnt lgkmcnt(0)" ::: "memory");
}

DI void phase_prologue(const Params& p, LAS unsigned char* lds) {
    const int tid = threadIdx.x, lane = tid & 63, wave = tid >> 6;
    LAS float* scr = (LAS float*)(lds + wave * 16896);
    const int gw = blockIdx.x * 8 + wave, NGW = gridDim.x * 8;
    unsigned char* ws = p.ws;
    bf16_t* XN = (bf16_t*)(ws + WS_XN);
    float* SS = (float*)(ws + WS_SS);
    for (int q = gw; q < MT / 4; q += NGW) {
        const int row0 = q * 4;
        if (row0 < MREAL) {
            f32x4 v[4][4];
#pragma unroll
            for (int r = 0; r < 4; ++r) {
                const int row = row0 + r;
                const float* src = row < MP ? p.in[0] + (size_t)row * D : p.in[1] + (size_t)(row - MP) * D;
                const f32x4* xr = (const f32x4*)src + lane;
#pragma unroll
                for (int j = 0; j < 4; ++j) v[r][j] = xr[64 * j];
            }
#pragma unroll
            for (int r = 0; r < 4; ++r) {
                const int row = row0 + r;
                float s = 0.f;
#pragma unroll
                for (int j = 0; j < 4; ++j) s += (v[r][j][0] * v[r][j][0] + v[r][j][1] * v[r][j][1]) + (v[r][j][2] * v[r][j][2] + v[r][j][3] * v[r][j][3]);
                s = wave_sum(s);
                u32x2* o8 = (u32x2*)(XN + (size_t)row * D) + lane;
#pragma unroll
                for (int j = 0; j < 4; ++j) o8[64 * j] = (u32x2){pk2(v[r][j][0], v[r][j][1]), pk2(v[r][j][2], v[r][j][3])};
                if (lane < 4) SS[(size_t)lane * MT + row] = lane == 0 ? s : 0.f;
            }
        } else {
#pragma unroll
            for (int r = 0; r < 4; ++r) { u32x2* o8 = (u32x2*)(XN + (size_t)(row0 + r) * D) + lane;
#pragma unroll
                for (int j = 0; j < 4; ++j) o8[64 * j] = (u32x2){0u, 0u}; }
        }
    }
    constexpr int I_IN = 16 * 40, I_OUT = 16 * 16, I_GU = 16 * 88, I_DN = 44 * 16, I_L = I_IN + I_OUT + I_GU + I_DN;
    for (int it = gw; it < 2 * I_L; it += NGW) {
        const int L = it >= I_L ? 1 : 0; int r = it - L * I_L;
        if (r < I_IN) { transpose_item(L ? p.in[15] : p.in[7], D, PW, (bf16_t*)(ws + (L ? WS_WIN1 : WS_WIN0)), L ? 3 : 1, L ? p.in[14] : p.in[6], scr, r, lane); continue; } r -= I_IN;
        if (r < I_OUT) { transpose_item(L ? p.in[23] : p.in[13], D, D, (bf16_t*)(ws + (L ? WS_WOUT1 : WS_WOUT0)), 0, nullptr, scr, r, lane); continue; } r -= I_OUT;
        if (r < I_GU) { transpose_item(p.in[25] + (size_t)L * D * 2 * FH, D, 2 * FH, (bf16_t*)(ws + (L ? WS_WGU1 : WS_WGU0)), 2, p.in[24] + L * D, scr, r, lane); continue; } r -= I_GU;
        transpose_item(p.in[26] + (size_t)L * FH * D, FH, D, (bf16_t*)(ws + (L ? WS_WDN1 : WS_WDN0)), 0, nullptr, scr, r, lane);
    }
}


DI float dot2bf(unsigned a, unsigned b, float c) { return __builtin_amdgcn_fdot2_f32_bf16(__builtin_bit_cast(bf16x2_t, a), __builtin_bit_cast(bf16x2_t, b), c, false); }
DI void st8f(float* dst, const u32x4 w) { float f[8]; unpack8(w, f); *(f32x4*)dst = (f32x4){f[0], f[1], f[2], f[3]}; *(f32x4*)(dst + 4) = (f32x4){f[4], f[5], f[6], f[7]}; }

constexpr int CV_PAR = 98304;
DI void phase_conv(const Params& p, LAS unsigned char* lds) {
    const int tid = threadIdx.x, lane = tid & 63, wid = __builtin_amdgcn_readfirstlane(tid >> 6);
    unsigned char* ws = p.ws;
    const bf16_t* A0 = (const bf16_t*)(ws + WS_A); const bf16_t* Z0 = (const bf16_t*)(ws + WS_A + SUB); const bf16_t* GB0 = (const bf16_t*)(ws + WS_A + 2 * SUB);
    bf16_t* CAT = (bf16_t*)(ws + WS_CAT);
    const float* cache_a = p.in[2]; const float* cache_b = p.in[3];
    const float* caw = p.in[8];
    float* out = p.out;
    const int c0 = lane * 8, par = wid >> 2;
    __syncthreads();
    {
        LAS float* pr = (LAS float*)(lds + CV_PAR);
        for (int i = tid; i < 512; i += 512) { pr[i] = p.in[9][i]; pr[512 + i] = p.in[10][i]; pr[1024 + i] = p.in[11][i]; pr[1536 + i] = p.in[12][i]; pr[2048 + i] = p.in[12][512 + i]; pr[2560 + i] = p.in[12][1024 + i]; }
    }
    unsigned wp[16][8];
#pragma unroll
    for (int i = 0; i < 16; ++i) {
        const int ja = par ? 2 * i - 1 : 2 * i, jb = ja + 1;
        f32x4 a0 = (f32x4){0.f, 0.f, 0.f, 0.f}, a1 = a0, b0 = a0, b1 = a0;
        if (ja >= 0) { a0 = *(const f32x4*)(caw + ja * MW + c0); a1 = *(const f32x4*)(caw + ja * MW + c0 + 4); }
        if (jb <= 30) { b0 = *(const f32x4*)(caw + jb * MW + c0); b1 = *(const f32x4*)(caw + jb * MW + c0 + 4); }
#pragma unroll
        for (int k = 0; k < 4; ++k) { asm volatile("v_cvt_pk_bf16_f32 %0, %1, %2" : "=v"(wp[i][k]) : "v"(a0[k]), "v"(b0[k])); asm volatile("v_cvt_pk_bf16_f32 %0, %1, %2" : "=v"(wp[i][4 + k]) : "v"(a1[k]), "v"(b1[k])); }
    }
    for (int un = blockIdx.x; un < 520; un += gridDim.x) {
        const bool samp = un >= 512;
        const int b = samp ? un - 512 : un >> 6, t0 = samp ? 0 : (un & 63) * 64, R = samp ? 16 : 64;
        const size_t rowbase = samp ? (size_t)MP + b * 16 : (size_t)b * SEQ;
        __syncthreads();
        for (int pr_ = wid; pr_ < (R + 30) / 2; pr_ += 8) {
            u32x4 v0 = (u32x4){0u, 0u, 0u, 0u}, v1 = v0;
            const int ta = t0 - 30 + 2 * pr_;
            if (ta >= 0) { v0 = *(const u32x4*)(A0 + (rowbase + ta) * MW + c0); v1 = *(const u32x4*)(A0 + (rowbase + ta + 1) * MW + c0); }
            else if (samp) { const f32x4* s0 = (const f32x4*)(cache_a + ((size_t)b * 30 + (30 + ta)) * MW + c0); const f32x4* s1 = s0 + MW / 4; v0 = pk8(s0[0], s0[1]); v1 = pk8(s1[0], s1[1]); }
            u32x4 e0, e1;
            e0.x = (v0.x & 0xffffu) | (v1.x << 16); e0.y = (v0.x >> 16) | (v1.x & 0xffff0000u); e0.z = (v0.y & 0xffffu) | (v1.y << 16); e0.w = (v0.y >> 16) | (v1.y & 0xffff0000u);
            e1.x = (v0.z & 0xffffu) | (v1.z << 16); e1.y = (v0.z >> 16) | (v1.z & 0xffff0000u); e1.z = (v0.w & 0xffffu) | (v1.w << 16); e1.w = (v0.w >> 16) | (v1.w & 0xffff0000u);
            *(LAS u32x4*)(lds + pr_ * 2048 + lane * 16) = e0; *(LAS u32x4*)(lds + pr_ * 2048 + 1024 + lane * 16) = e1;
        }
        __syncthreads();
        const int nrow = R >> 3;
        for (int i = 0; i < nrow; ++i) {
            const int r = par + 2 * ((wid & 3) + 4 * i);
            const int t = t0 + r; const size_t row = rowbase + t;
            const u32x4 zz = *(const u32x4*)(Z0 + row * MW + c0), gbv = *(const u32x4*)(GB0 + row * MW + c0);
            u32x4 z1 = (u32x4){0u, 0u, 0u, 0u}, z2 = z1;
            if (t >= 1) z1 = *(const u32x4*)(Z0 + (row - 1) * MW + c0);
            else if (samp) { const f32x4* s = (const f32x4*)(cache_b + ((size_t)b * 2 + 1) * MW + c0); z1 = pk8(s[0], s[1]); }
            if (t >= 2) z2 = *(const u32x4*)(Z0 + (row - 2) * MW + c0);
            else if (samp) { const f32x4* s = (const f32x4*)(cache_b + ((size_t)b * 2 + t) * MW + c0); z2 = pk8(s[0], s[1]); }
            const LAS float* pr = (const LAS float*)(lds + CV_PAR) + c0;
            f32x4 ac0 = *(const LAS f32x4*)pr, ac1 = *(const LAS f32x4*)(pr + 4);
            const LAS unsigned char* eb = lds + (r >> 1) * 2048 + lane * 16;
#pragma unroll
            for (int q = 0; q < 16; ++q) {
                const u32x4 e0 = *(const LAS u32x4*)(eb + q * 2048), e1 = *(const LAS u32x4*)(eb + q * 2048 + 1024);
                ac0[0] = dot2bf(e0.x, wp[q][0], ac0[0]); ac0[1] = dot2bf(e0.y, wp[q][1], ac0[1]); ac0[2] = dot2bf(e0.z, wp[q][2], ac0[2]); ac0[3] = dot2bf(e0.w, wp[q][3], ac0[3]);
                ac1[0] = dot2bf(e1.x, wp[q][4], ac1[0]); ac1[1] = dot2bf(e1.y, wp[q][5], ac1[1]); ac1[2] = dot2bf(e1.z, wp[q][6], ac1[2]); ac1[3] = dot2bf(e1.w, wp[q][7], ac1[3]);
                if ((q & 1) == 1) __builtin_amdgcn_sched_barrier(0);
            }
            const float mean = wave_sum((ac0[0] + ac0[1]) + (ac0[2] + ac0[3]) + (ac1[0] + ac1[1]) + (ac1[2] + ac1[3])) * (1.0f / 512.0f);
            ac0 -= mean; ac1 -= mean;
            const float rstd = rsqrtf(wave_sum((ac0[0] * ac0[0] + ac0[1] * ac0[1]) + (ac0[2] * ac0[2] + ac0[3] * ac0[3]) + (ac1[0] * ac1[0] + ac1[1] * ac1[1]) + (ac1[2] * ac1[2] + ac1[3] * ac1[3])) * (1.0f / 512.0f) + 1e-5f);
            const f32x4 g0 = *(const LAS f32x4*)(pr + 512), g1 = *(const LAS f32x4*)(pr + 516), b0 = *(const LAS f32x4*)(pr + 1024), b1 = *(const LAS f32x4*)(pr + 1028);
            f32x4 y0 = ac0 * rstd * g0 + b0, y1 = ac1 * rstd * g1 + b1;
#pragma unroll
            for (int k = 0; k < 4; ++k) { y0[k] *= sigmoidf_(y0[k]); y1[k] *= sigmoidf_(y1[k]); }
            *(u32x4*)(CAT + row * D + c0) = pk8(y0, y1);
            float fz[8], f1[8], f2[8], fg[8];
            unpack8(zz, fz); unpack8(z1, f1); unpack8(z2, f2); unpack8(gbv, fg);
            const f32x4 w00 = *(const LAS f32x4*)(pr + 1536), w01 = *(const LAS f32x4*)(pr + 1540), w10 = *(const LAS f32x4*)(pr + 2048), w11 = *(const LAS f32x4*)(pr + 2052), w20 = *(const LAS f32x4*)(pr + 2560), w21 = *(const LAS f32x4*)(pr + 2564);
            f32x4 o0, o1;
#pragma unroll
            for (int k = 0; k < 4; ++k) { o0[k] = fg[k] * (w00[k] * f2[k] + w10[k] * f1[k] + w20[k] * fz[k]); o1[k] = fg[4 + k] * (w01[k] * f2[4 + k] + w11[k] * f1[4 + k] + w21[k] * fz[4 + k]); }
            *(u32x4*)(CAT + row * D + MW + c0) = pk8(o0, o1);
        }
        if (!samp && (un & 63) == 63) {
            for (int i = wid; i < 30; i += 8) st8f(out + O_CAP + ((size_t)b * 30 + i) * MW + c0, *(const u32x4*)(A0 + (rowbase + 4066 + i) * MW + c0));
            if (wid < 2) st8f(out + O_CBP + ((size_t)b * 2 + wid) * MW + c0, *(const u32x4*)(Z0 + (rowbase + 4094 + wid) * MW + c0));
        }
        if (samp) {
            for (int i = wid; i < 30; i += 8) {
                float* dst = out + O_CAS + ((size_t)b * 30 + i) * MW + c0;
                if (i < 14) { const f32x4* s = (const f32x4*)(cache_a + ((size_t)b * 30 + 16 + i) * MW + c0); *(f32x4*)dst = s[0]; *(f32x4*)(dst + 4) = s[1]; }
                else st8f(dst, *(const u32x4*)(A0 + (rowbase + i - 14) * MW + c0));
            }
            if (wid < 2) st8f(out + O_CBS + ((size_t)b * 2 + wid) * MW + c0, *(const u32x4*)(Z0 + (rowbase + 14 + wid) * MW + c0));
        }
    }
    __syncthreads();
}

typedef short v4i16_t __attribute__((ext_vector_type(4)));
DI s16x4 tr_read(const LAS unsigned char* p) { return __builtin_bit_cast(s16x4, __builtin_amdgcn_ds_read_tr16_b64_v4i16((LAS v4i16_t*)p)); }
#define VFR(lo, hi) ((bf16x8){lo[0], lo[1], lo[2], lo[3], hi[0], hi[1], hi[2], hi[3]})
constexpr int KSTR = 272, VSTR = 320, AT_V = 64 * KSTR, AT_BUF = AT_V + 64 * VSTR, AT_B = 2 * AT_BUF;

template <bool SAMPLE>
DI void attn_load_tile(const Params& p, int b, int cp, int hp, int j, u32x4 (&kr)[2], u32x4 (&vr)[2]) {
    const int tid = threadIdx.x, chunk = tid & 15, k0 = tid >> 4;
    const bf16_t* Kb = (const bf16_t*)(p.ws + WS_A + SUB); const bf16_t* Vb = (const bf16_t*)(p.ws + WS_A + 2 * SUB);
#pragma unroll
    for (int i = 0; i < 2; ++i) {
        const int key = i * 32 + k0;
        if (!SAMPLE) {
            const size_t row = (size_t)b * SEQ + (size_t)(2 * cp - 8 + j) * 64 + key;
            kr[i] = *(const u32x4*)(Kb + row * MW + hp * 128 + chunk * 8);
            vr[i] = *(const u32x4*)(Vb + row * MW + hp * 128 + chunk * 8);
        } else {
            if (j < 8) {
                const size_t off = ((size_t)b * 512 + 64 * j + key) * 512 + hp * 128 + chunk * 8;
                const f32x4* ks = (const f32x4*)(p.in[4] + off); const f32x4* vs = (const f32x4*)(p.in[5] + off);
                kr[i] = pk8(ks[0], ks[1]); vr[i] = pk8(vs[0], vs[1]);
            } else if (key < 16) {
                const size_t row = (size_t)MP + b * 16 + key;
                kr[i] = *(const u32x4*)(Kb + row * MW + hp * 128 + chunk * 8);
                vr[i] = *(const u32x4*)(Vb + row * MW + hp * 128 + chunk * 8);
            } else { kr[i] = (u32x4){0u, 0u, 0u, 0u}; vr[i] = (u32x4){0u, 0u, 0u, 0u}; }
        }
    }
}
DI void attn_store_tile(LAS unsigned char* buf, const u32x4 (&kr)[2], const u32x4 (&vr)[2]) {
    const int tid = threadIdx.x, chunk = tid & 15, k0 = tid >> 4;
#pragma unroll
    for (int i = 0; i < 2; ++i) { const int key = i * 32 + k0;
        *(LAS u32x4*)(buf + key * KSTR + chunk * 16) = kr[i];
        *(LAS u32x4*)(buf + AT_V + key * VSTR + chunk * 16) = vr[i]; }
}

template <int BM, bool SMASK>
DI void attn_tile(const LAS unsigned char* kbase, const LAS unsigned char* vbase, const LAS float* bth, int ibase, int h, const bf16x8 (&qf)[4], f32x16& o0, f32x16& o1, float& lsum) {
#pragma unroll
    for (int kb = 0; kb < 2; ++kb) {
        f32x16 pa;
#pragma unroll
        for (int r = 0; r < 16; ++r) pa[r] = 0.f;
#pragma unroll
        for (int d0 = 0; d0 < 4; ++d0) { const bf16x8 a = *(const LAS bf16x8*)(kbase + kb * 32 * KSTR + d0 * 32); pa = __builtin_amdgcn_mfma_f32_32x32x16_bf16(a, qf[d0], pa, 0, 0, 0); }
        if (BM == 0) {
            const float cb = bth[512];
#pragma unroll
            for (int r = 0; r < 16; ++r) pa[r] += cb;
        } else if (BM == 1) {
#pragma unroll
            for (int r = 0; r < 16; ++r) { int idx = ibase - 32 * kb - ((r & 3) + 8 * (r >> 2)); idx = idx > 512 ? 512 : idx; pa[r] += bth[idx]; }
        } else {
            const LAS float* bp = bth + (ibase - 32 * kb - 27);
#pragma unroll
            for (int r = 0; r < 16; ++r) pa[r] += bp[27 - ((r & 3) + 8 * (r >> 2))];
        }
#pragma unroll
        for (int r = 0; r < 16; ++r) pa[r] = __builtin_amdgcn_exp2f(pa[r]);
        if (SMASK) {
#pragma unroll
            for (int r = 0; r < 16; ++r) { const int key = 32 * kb + (r & 3) + 8 * (r >> 2) + 4 * h; if (key >= 16) pa[r] = 0.f; }
        }
#pragma unroll
        for (int r = 0; r < 16; ++r) lsum += pa[r];
#pragma unroll
        for (int s = 0; s < 2; ++s) {
            u32x4 pw; pw.x = pk2(pa[8 * s], pa[8 * s + 1]); pw.y = pk2(pa[8 * s + 2], pa[8 * s + 3]); pw.z = pk2(pa[8 * s + 4], pa[8 * s + 5]); pw.w = pk2(pa[8 * s + 6], pa[8 * s + 7]);
            const bf16x8 pb = __builtin_bit_cast(bf16x8, pw);
            const LAS unsigned char* va = vbase + (kb * 32 + 16 * s) * VSTR;
            { const s16x4 lo = tr_read(va), hi = tr_read(va + 8 * VSTR); o0 = __builtin_amdgcn_mfma_f32_32x32x16_bf16(VFR(lo, hi), pb, o0, 0, 0, 0); }
            { const s16x4 lo = tr_read(va + 64), hi = tr_read(va + 64 + 8 * VSTR); o1 = __builtin_amdgcn_mfma_f32_32x32x16_bf16(VFR(lo, hi), pb, o1, 0, 0, 0); }
        }
    }
}

template <bool SAMPLE>
DI void attn_unit(const Params& p, LAS unsigned char* lds, int b, int cp, int hp) {
    int tid_ = threadIdx.x; asm volatile("" : "+v"(tid_));
    const int tid = tid_, lane = tid & 63, w = __builtin_amdgcn_readfirstlane(tid >> 6), r32 = lane & 31, h = lane >> 5;
    const int cl = SAMPLE ? 0 : (w >> 2), hl = (w >> 1) & 1, head = hp * 2 + hl, qoff = SAMPLE ? 0 : 32 * (w & 1);
    const bf16_t* Qb = (const bf16_t*)(p.ws + WS_A);
    bf16_t* CAT = (bf16_t*)(p.ws + WS_CAT);
    const size_t qrow = SAMPLE ? (size_t)MP + b * 16 + (r32 & 15) : (size_t)b * SEQ + (2 * cp + cl) * 64 + qoff + r32;
    bf16x8 qf[4];
#pragma unroll
    for (int d0 = 0; d0 < 4; ++d0) qf[d0] = *(const bf16x8*)(Qb + qrow * MW + head * 64 + d0 * 16 + h * 8);
    LAS float* bt = (LAS float*)(lds + AT_B);
    const float* relb = p.in[18];
    const int j_first = SAMPLE ? 0 : (cp >= 4 ? 0 : 8 - 2 * cp), j_last = SAMPLE ? 8 : 9;
    u32x4 ka[2], va_[2], kb_[2], vb_[2];
    attn_load_tile<SAMPLE>(p, b, cp, hp, j_first, ka, va_);
    __syncthreads();
    for (int i = tid; i < 2 * 513; i += 512) { const int hh = i >= 513 ? 1 : 0, j = i - hh * 513; bt[hh * 516 + j] = relb[(hp * 2 + hh) * 513 + j] * LOG2E; }
    attn_store_tile(lds + (j_first & 1) * AT_BUF, ka, va_);
    attn_load_tile<SAMPLE>(p, b, cp, hp, j_first + 1, ka, va_);
    if (j_first + 2 <= j_last) attn_load_tile<SAMPLE>(p, b, cp, hp, j_first + 2, kb_, vb_);
    f32x16 o0, o1;
#pragma unroll
    for (int r = 0; r < 16; ++r) { o0[r] = 0.f; o1[r] = 0.f; }
    float lsum = 0.f;
    const int i16 = lane & 15, qd = i16 >> 2, pp = i16 & 3, g16 = (lane >> 4) & 1;
    const int koff = r32 * KSTR + hl * 128 + h * 16;
    const int voff = AT_V + (4 * h + qd) * VSTR + hl * 128 + (16 * g16 + 4 * pp) * 2;
    const LAS float* bth = bt + hl * 516;
#define ATT_STEP(j, KR, VR) do { \
        __syncthreads();                                        \
        if ((j) < j_last) { attn_store_tile(lds + (((j) + 1) & 1) * AT_BUF, KR, VR); if ((j) + 3 <= j_last) attn_load_tile<SAMPLE>(p, b, cp, hp, (j) + 3, KR, VR); } \
        const int t = (j) - cl; \
        if (t >= 0 && t <= 8) { \
            const LAS unsigned char* bufp = lds + ((j) & 1) * AT_BUF; \
            const int ibase = 768 - 64 * t + qoff + r32 - 4 * h; \
            if (t <= 3) attn_tile<0, false>(bufp + koff, bufp + voff, bth, ibase, h, qf, o0, o1, lsum); \
            else if (t == 4) attn_tile<1, false>(bufp + koff, bufp + voff, bth, ibase, h, qf, o0, o1, lsum); \
            else if (SAMPLE && t == 8) attn_tile<2, true>(bufp + koff, bufp + voff, bth, ibase, h, qf, o0, o1, lsum); \
            else attn_tile<2, false>(bufp + koff, bufp + voff, bth, ibase, h, qf, o0, o1, lsum); \
        } } while (0)
    for (int j = j_first; j <= j_last; j += 2) {
        ATT_STEP(j, ka, va_);
        if (j + 1 <= j_last) ATT_STEP(j + 1, kb_, vb_);
    }
#undef ATT_STEP
    lsum += __shfl_xor(lsum, 32);
    const float inv = 1.0f / lsum;
    const bool do_store = SAMPLE ? (w < 4 && (w & 1) == 0 && r32 < 16) : true;
    if (do_store) {
        bf16_t* dst = CAT + qrow * D + head * 64 + 4 * h;
#pragma unroll
        for (int gq = 0; gq < 4; ++gq) {
            *(u32x2*)(dst + 8 * gq) = (u32x2){pk2(o0[4 * gq] * inv, o0[4 * gq + 1] * inv), pk2(o0[4 * gq + 2] * inv, o0[4 * gq + 3] * inv)};
            *(u32x2*)(dst + 32 + 8 * gq) = (u32x2){pk2(o1[4 * gq] * inv, o1[4 * gq + 1] * inv), pk2(o1[4 * gq + 2] * inv, o1[4 * gq + 3] * inv)};
        }
    }
}

constexpr int SG_STR = 320, SG_LN = 49152;
struct SguRegs { f32x4 st[4]; u32x4 sv[4]; float bsv; };
DI void sgu_load(const Params& p, int uid, int tid, SguRegs& R) {
    const int b = uid >> 7, ch = (uid >> 2) & 31, g = uid & 3;
    const int lane = tid & 63, w = tid >> 6, r32 = lane & 31;
    const bf16_t* SVb = (const bf16_t*)(p.ws + WS_A + 4 * SUB);
    const float* SVST = (const float*)(p.ws + WS_SVST);
    const size_t r0 = (size_t)b * SEQ + ch * 128;
    const int srow = tid >> 2, qt = tid & 3;
    const f32x4* st = (const f32x4*)(SVST + (r0 + srow) * 16);
#pragma unroll
    for (int i = 0; i < 4; ++i) { R.st[i] = st[i]; R.sv[i] = *(const u32x4*)(SVb + (r0 + srow) * MW + g * 128 + qt * 32 + i * 8); }
    const int ib = w & 3, iloc = 32 * ib + r32;
    R.bsv = p.in[22][g * 128 + iloc];
}
DI void sgu_unit(const Params& p, LAS unsigned char* lds, int uid, int tid, const SguRegs& C, bool has_next, int uid_next, SguRegs& R) {
    const int b = uid >> 7, ch = (uid >> 2) & 31, g = uid & 3;
    const int lane = tid & 63, w = __builtin_amdgcn_readfirstlane(tid >> 6), r32 = lane & 31, h = lane >> 5;
    bf16_t* CAT = (bf16_t*)(p.ws + WS_CAT);
    const float* sw = p.in[21];
    const size_t r0 = (size_t)b * SEQ + ch * 128;
    const int ib = w & 3, dh = w >> 2, iloc = 32 * ib + r32;
    const size_t row = r0 + iloc;
    const float* Wrow = sw + ((size_t)g * 128 + iloc) * 128 + 8 * h;
    f32x4 wv[8][2];
#pragma unroll
    for (int js = 0; js < 8; ++js) { if (js <= 2 * ib + 1) { wv[js][0] = *(const f32x4*)(Wrow + 16 * js); wv[js][1] = *(const f32x4*)(Wrow + 16 * js + 4); } else { wv[js][0] = (f32x4){0.f, 0.f, 0.f, 0.f}; wv[js][1] = wv[js][0]; } }
    const bf16_t* Ub = (const bf16_t*)(p.ws + WS_A + 3 * SUB);
    u32x2 uu[2][4];
#pragma unroll
    for (int db = 0; db < 2; ++db)
#pragma unroll
        for (int gq = 0; gq < 4; ++gq) uu[db][gq] = *(const u32x2*)(Ub + row * MW + g * 128 + 64 * dh + 32 * db + 8 * gq + 4 * h);
    if (has_next) sgu_load(p, uid_next, tid, R);
    __syncthreads();
    {
        const int srow = tid >> 2, qt = tid & 3;
        const f32x4 a0 = C.st[0], a1 = C.st[1], a2 = C.st[2], a3 = C.st[3];
        const float s1 = (a0[0] + a0[2]) + (a1[0] + a1[2]) + (a2[0] + a2[2]) + (a3[0] + a3[2]);
        const float s2 = (a0[1] + a0[3]) + (a1[1] + a1[3]) + (a2[1] + a2[3]) + (a3[1] + a3[3]);
        const float mean = s1 * (1.0f / 512.0f), var = s2 * (1.0f / 512.0f) - mean * mean, rstd = rsqrtf(fmaxf(var, 0.f) + 1e-5f);
        const LAS float* lnp = (const LAS float*)(lds + SG_LN);
#pragma unroll
        for (int i = 0; i < 4; ++i) {
            const int c8 = qt * 32 + i * 8, ca = g * 128 + c8;
            float f[8]; unpack8(C.sv[i], f);
            const f32x4 g0 = *(const LAS f32x4*)(lnp + ca), g1 = *(const LAS f32x4*)(lnp + ca + 4), b0 = *(const LAS f32x4*)(lnp + 512 + ca), b1 = *(const LAS f32x4*)(lnp + 512 + ca + 4);
            f32x4 x0, x1;
#pragma unroll
            for (int k = 0; k < 4; ++k) { x0[k] = (f[k] - mean) * rstd * g0[k] + b0[k]; x1[k] = (f[4 + k] - mean) * rstd * g1[k] + b1[k]; }
            *(LAS u32x4*)(lds + srow * SG_STR + c8 * 2) = pk8(x0, x1);
        }
    }
    __syncthreads();
    const int i16 = lane & 15, qd = i16 >> 2, pp = i16 & 3, g16 = (lane >> 4) & 1;
    f32x16 acc0, acc1;
#pragma unroll
    for (int r = 0; r < 16; ++r) { acc0[r] = 0.f; acc1[r] = 0.f; }
    const LAS unsigned char* vb = lds + (8 * h + qd) * SG_STR + (64 * dh + 16 * g16 + 4 * pp) * 2;
#pragma unroll
    for (int js = 0; js < 8; ++js) {
        if (js <= 2 * ib + 1) {
            const int jb = 16 * js + 8 * h;
            f32x4 w0 = wv[js][0], w1 = wv[js][1];
#pragma unroll
            for (int k = 0; k < 4; ++k) { w0[k] = (jb + k <= iloc) ? w0[k] : 0.f; w1[k] = (jb + 4 + k <= iloc) ? w1[k] : 0.f; }
            const bf16x8 bw = __builtin_bit_cast(bf16x8, pk8(w0, w1));
            const LAS unsigned char* va = vb + js * 16 * SG_STR;
            { const s16x4 lo = tr_read(va), hi = tr_read(va + 4 * SG_STR); acc0 = __builtin_amdgcn_mfma_f32_32x32x16_bf16(VFR(lo, hi), bw, acc0, 0, 0, 0); }
            { const s16x4 lo = tr_read(va + 64), hi = tr_read(va + 64 + 4 * SG_STR); acc1 = __builtin_amdgcn_mfma_f32_32x32x16_bf16(VFR(lo, hi), bw, acc1, 0, 0, 0); }
        }
    }
    const float bsv = C.bsv;
#pragma unroll
    for (int gq = 0; gq < 4; ++gq) {
        const int d4 = 64 * dh + 8 * gq + 4 * h;
        { const u32x2 u2 = uu[0][gq];
          *(u32x2*)(CAT + row * D + MW + g * 128 + d4) = (u32x2){pk2(bflo(u2.x) * (acc0[4 * gq] + bsv), bfhi(u2.x) * (acc0[4 * gq + 1] + bsv)), pk2(bflo(u2.y) * (acc0[4 * gq + 2] + bsv), bfhi(u2.y) * (acc0[4 * gq + 3] + bsv))}; }
        { const u32x2 u2 = uu[1][gq];
          *(u32x2*)(CAT + row * D + MW + g * 128 + d4 + 32) = (u32x2){pk2(bflo(u2.x) * (acc1[4 * gq] + bsv), bfhi(u2.x) * (acc1[4 * gq + 1] + bsv)), pk2(bflo(u2.y) * (acc1[4 * gq + 2] + bsv), bfhi(u2.y) * (acc1[4 * gq + 3] + bsv))}; }
    }
}
DI void sgu_all(const Params& p, LAS unsigned char* lds, int first, int stride) {
    int tid_ = threadIdx.x; asm volatile("" : "+v"(tid_));
    const int tid = tid_;
    __syncthreads();
    { LAS float* lnp = (LAS float*)(lds + SG_LN); lnp[tid] = p.in[19][tid]; lnp[512 + tid] = p.in[20][tid]; }
    if (first >= 1024) { __syncthreads(); return; }
    SguRegs R; sgu_load(p, first, tid, R);
    for (int uid = first; uid < 1024; uid += stride) {
        const SguRegs C = R;
        sgu_unit(p, lds, uid, tid, C, uid + stride < 1024, uid + stride, R);
    }
    __syncthreads();
}

DI void sgu_sample_unit(const Params& p, LAS unsigned char* lds, int b) {
    int tid_ = threadIdx.x; asm volatile("" : "+v"(tid_));
    const int tid = tid_, lane = tid & 63, wid = tid >> 6;
    const bf16_t* Ub = (const bf16_t*)(p.ws + WS_A + 3 * SUB); const bf16_t* SVb = (const bf16_t*)(p.ws + WS_A + 4 * SUB);
    bf16_t* CAT = (bf16_t*)(p.ws + WS_CAT);
    const float* lng = p.in[19]; const float* lnb = p.in[20]; const float* sw = p.in[21]; const float* sb = p.in[22];
    LAS float* vn = (LAS float*)lds;
    const size_t r0 = (size_t)MP + b * 16;
    __syncthreads();
    for (int i = wid; i < 16; i += 8) {
        const int c0 = lane * 8;
        float f[8]; unpack8(*(const u32x4*)(SVb + (r0 + i) * MW + c0), f);
        float s = 0.f;
#pragma unroll
        for (int k = 0; k < 8; ++k) s += f[k];
        const float mean = wave_sum(s) * (1.0f / 512.0f);
        float q = 0.f;
#pragma unroll
        for (int k = 0; k < 8; ++k) { f[k] -= mean; q += f[k] * f[k]; }
        const float rstd = rsqrtf(wave_sum(q) * (1.0f / 512.0f) + 1e-5f);
        float* dst = p.out + O_SVS + ((size_t)b * 16 + i) * MW + c0;
#pragma unroll
        for (int k = 0; k < 8; ++k) { const float y = f[k] * rstd * lng[c0 + k] + lnb[c0 + k]; vn[i * 512 + c0 + k] = y; dst[k] = y; }
    }
    LAS float* wl = (LAS float*)(lds + 32768); LAS float* bl = wl + 1024;
    for (int i = tid; i < 1024; i += 512) wl[i] = sw[((size_t)(i >> 8) * 128 + ((i >> 4) & 15)) * 128 + (i & 15)];
    if (tid < 64) bl[tid] = sb[(tid >> 4) * 128 + (tid & 15)];
    const int cch = tid, g = cch >> 7;
    float uvv[16];
#pragma unroll
    for (int i = 0; i < 16; ++i) uvv[i] = bflo((unsigned)Ub[(r0 + i) * MW + cch]);
    __syncthreads();
    {
        float vv[16];
#pragma unroll
        for (int j = 0; j < 16; ++j) vv[j] = vn[j * 512 + cch];
#pragma unroll
        for (int i = 0; i < 16; ++i) {
            float s = bl[g * 16 + i];
#pragma unroll
            for (int j = 0; j <= i; ++j) s += wl[g * 256 + i * 16 + j] * vv[j];
            const unsigned o = pk2(uvv[i] * s, 0.f);
            CAT[(r0 + i) * D + MW + cch] = (bf16_t)(o & 0xffffu);
        }
    }
}

DI void phase_mix_odd(const Params& p, LAS unsigned char* lds) {
    const int blk = blockIdx.x;
    if (gridDim.x == 256) {
        if (blk < 32) attn_unit<true>(p, lds, blk >> 2, 0, blk & 3);
        for (int uid = blk; uid < 1024; uid += 256) attn_unit<false>(p, lds, (uid & 31) >> 2, uid >> 5, uid & 3);
        if (blk >= 32 && blk < 40) sgu_sample_unit(p, lds, blk - 32);
        sgu_all(p, lds, blk, 256);
    } else {
        for (int uid = blk; uid < 1056; uid += gridDim.x) {
            if (uid < 1024) attn_unit<false>(p, lds, (uid & 31) >> 2, uid >> 5, uid & 3);
            else { const int s_ = uid - 1024; attn_unit<true>(p, lds, s_ >> 2, 0, s_ & 3); }
        }
        sgu_all(p, lds, blk, gridDim.x);
        for (int uid = 1024 + blk; uid < 1032; uid += gridDim.x) sgu_sample_unit(p, lds, uid - 1024);
    }
    __syncthreads();
}

#define XB_TMO      128
#define XB_XCNT(j)  (256  + 64 * (j))
#define XB_XSUB(j)  (1280 + 64 * (j))
#define XB_XGEN(j)  (2304 + 64 * (j))
#define XB_TOP      3328
#define XB_TOPGEN   3392
#define XCD_BAR_WORDS 3456
#define XB_SPIN_CAP (1u << 18)
DI unsigned xb_ld(unsigned* p)              { return __hip_atomic_load(p, __ATOMIC_RELAXED, __HIP_MEMORY_SCOPE_AGENT); }
DI unsigned xb_add(unsigned* p, unsigned v) { return __hip_atomic_fetch_add(p, v, __ATOMIC_RELAXED, __HIP_MEMORY_SCOPE_AGENT); }
DI unsigned xb_xcc_id() { return (unsigned)__builtin_amdgcn_s_getreg((3 << 11) | 20) & 0xFu; }
#define XB_SPIN(cond, bar) do { unsigned _sp = 0; while (cond) { __builtin_amdgcn_s_sleep(1); \
    if ((++_sp & 255u) == 0u) { if (xb_ld(&(bar)[XB_TMO])) break; if (_sp > XB_SPIN_CAP) { atomicAdd(&(bar)[XB_TMO], 1u); break; } } } } while (0)
struct XcdBarrier { unsigned* bar; unsigned x; volatile LAS unsigned* st; };
DI XcdBarrier xcd_barrier_post(unsigned* bar, volatile LAS unsigned* st) {
    XcdBarrier b; b.bar = bar; b.x = xb_xcc_id(); b.st = st;
    if (threadIdx.x == 0) (void)xb_add(&bar[XB_XCNT(b.x)], 1u);
    return b;
}
DI void xcd_barrier_complete(unsigned* bar, unsigned x, unsigned& nloc, unsigned& nx) {
    const unsigned G = gridDim.x * gridDim.y * gridDim.z;
    unsigned sum, cnt, mine, sp = 0u;
    for (;;) {
        sum = 0u; cnt = 0u; mine = 0u;
#pragma unroll
        for (unsigned j = 0; j < 16; ++j) { const unsigned c = xb_ld(&bar[XB_XCNT(j)]); sum += c; cnt += (c > 0u) ? 1u : 0u; mine = (j == x) ? c : mine; }
        if (sum == G) break;
        __builtin_amdgcn_s_sleep(1);
        if ((++sp & 255u) == 0u) { if (xb_ld(&bar[XB_TMO])) break; if (sp > XB_SPIN_CAP) { atomicAdd(&bar[XB_TMO], 1u); break; } }
    }
    nloc = mine > 0u ? mine : 1u; nx = cnt > 0u ? cnt : 1u;
}
DI void xcd_barrier(const XcdBarrier& b) {
    asm volatile("s_waitcnt vmcnt(0)" ::: "memory");
    __syncthreads();
    if (threadIdx.x == 0) {
        unsigned* bar = b.bar;
        __builtin_amdgcn_s_waitcnt(0);
        unsigned nloc = b.st[0], nx = b.st[1];
        if (nloc == 0u) { xcd_barrier_complete(bar, b.x, nloc, nx); b.st[0] = nloc; b.st[1] = nx; }
        const unsigned old = xb_add(&bar[XB_XSUB(b.x)], 1u);
        const unsigned gen = old / nloc;
        if (old + 1u == (gen + 1u) * nloc) {
            __builtin_amdgcn_fence(__ATOMIC_RELEASE, "agent");
            asm volatile("s_waitcnt vmcnt(0)" ::: "memory");
            const unsigned og = xb_add(&bar[XB_TOP], 1u);
            const unsigned tg = og / nx;
            if (og + 1u == (tg + 1u) * nx) xb_add(&bar[XB_TOPGEN], 1u);
            else XB_SPIN(xb_ld(&bar[XB_TOPGEN]) == tg, bar);
            __builtin_amdgcn_fence(__ATOMIC_ACQUIRE, "agent");
            xb_add(&bar[XB_XGEN(b.x)], 1u);
            asm volatile("s_waitcnt vmcnt(0)" ::: "memory");
        } else {
            XB_SPIN(xb_ld(&bar[XB_XGEN(b.x)]) == gen, bar);
            __builtin_amdgcn_fence(__ATOMIC_ACQUIRE, "agent");
            asm volatile("s_waitcnt vmcnt(0)" ::: "memory");
        }
    }
    __syncthreads();
}

__global__ void __launch_bounds__(512, 2) fwd_kernel(Params p) {
    extern __shared__ __attribute__((aligned(16))) unsigned char lds_raw[];
    LAS unsigned char* lds = (LAS unsigned char*)lds_raw;
    const int lo = p.ph_lo, hi = p.ph_hi;
    unsigned char* ws = p.ws;
    bf16_t* XN = (bf16_t*)(ws + WS_XN); bf16_t* CAT = (bf16_t*)(ws + WS_CAT); bf16_t* HID = (bf16_t*)(ws + WS_HID);
    bf16_t* AREG = (bf16_t*)(ws + WS_A);
    float* SS = (float*)(ws + WS_SS); float* SVST = (float*)(ws + WS_SVST);
    float* out = p.out;
    const int G = gridDim.x, cid = blockIdx.x;
    volatile LAS unsigned* bst = (volatile LAS unsigned*)(lds + LDS_BYTES - 64);
    XcdBarrier xbar; xbar.bar = (unsigned*)ws; xbar.x = 0; xbar.st = bst;
    if (hi - lo > 1) {
        if (threadIdx.x < 16) bst[threadIdx.x] = 0u;
        __syncthreads();
        xbar = xcd_barrier_post((unsigned*)ws, bst);
    }
#ifndef PHASE_MASK
#define PHASE_MASK 0x7ff
#endif
#define IN(k) (((PHASE_MASK >> (k)) & 1) && lo <= (k) && (k) < hi)
#ifndef PROBE_DUP
#define PROBE_DUP 0
#endif
#define REPS(k) for (int rep_ = 0; rep_ < ((((PROBE_DUP) >> (k)) & 1) ? 2 : 1); ++rep_)
#define RSYNC() do { if (rep_) cg::this_grid().sync(); } while (0)
#define SEAM(k) do { if (IN(k) && IN((k) + 1)) { xcd_barrier(xbar); } } while (0)
    if (hi > 64) cg::this_grid().sync();
    if (IN(0)) REPS(0) { RSYNC(); phase_prologue(p, lds); __syncthreads(); }
    SEAM(0);
    if (IN(1)) REPS(1) {   RSYNC();
        pg8::Gemm g{XN, (const bf16_t*)(ws + WS_WIN0), MP, PW, D}; pg8::StaticOrder S; S.init(MP, PW, G, cid);
        EpiInEven E{SS + 0 * MT, AREG, (bf16_t*)(ws + WS_A + SUB), (bf16_t*)(ws + WS_A + 2 * SUB)};
        pg8::gemm_phase<EpiInEven, true>(lds, g, S, E);
        SEpiInEven ES{SS + 0 * MT, AREG, (bf16_t*)(ws + WS_A + SUB), (bf16_t*)(ws + WS_A + 2 * SUB)};
        sample_gemm(lds, XN, (const bf16_t*)(ws + WS_WIN0), PW / 256, D, ES);
    }
    SEAM(1);
    if (IN(2)) REPS(2) { RSYNC(); phase_conv(p, lds); }
    SEAM(2);
    if (IN(3)) REPS(3) {   RSYNC();
        pg8::Gemm g{CAT, (const bf16_t*)(ws + WS_WOUT0), MP, D, D}; pg8::StaticOrder S; S.init(MP, D, G, cid);
        EpiResid<0> E{p.in[0], out, XN, SS + 1 * MT};
        pg8::gemm_phase<EpiResid<0>, true>(lds, g, S, E);
        SEpiResid<0> ES{p.in[1] - (size_t)MP * D, out, XN, SS + 1 * MT};
        sample_gemm(lds, CAT, (const bf16_t*)(ws + WS_WOUT0), D / 256, D, ES);
    }
    SEAM(3);
    if (IN(4)) REPS(4) {   RSYNC();
        pg8::Gemm g{XN, (const bf16_t*)(ws + WS_WGU0), MP, 2 * FH, D}; pg8::StaticOrder S; S.init(MP, 2 * FH, G, cid);
        EpiGateUp E{SS + 1 * MT, HID};
        pg8::gemm_phase<EpiGateUp, true>(lds, g, S, E);
        SEpiGateUp ES{SS + 1 * MT, HID};
        sample_gemm(lds, XN, (const bf16_t*)(ws + WS_WGU0), 2 * FH / 256, D, ES);
    }
    SEAM(4);
    if (IN(5)) {
        pg8::Gemm g{HID, (const bf16_t*)(ws + WS_WDN0), MP, D, FH}; pg8::StaticOrder S; S.init(MP, D, G, cid);
        EpiResid<1> E{nullptr, out, XN, SS + 2 * MT};
        pg8::gemm_phase<EpiResid<1>, true>(lds, g, S, E);
        SEpiResid<1> ES{nullptr, out, XN, SS + 2 * MT};
        sample_gemm(lds, HID, (const bf16_t*)(ws + WS_WDN0), D / 256, FH, ES);
    }
    SEAM(5);
    if (IN(6)) REPS(6) {   RSYNC();
        pg8::Gemm g{XN, (const bf16_t*)(ws + WS_WIN1), MP, PW, D}; pg8::StaticOrder S; S.init(MP, PW, G, cid);
        EpiInOdd E{SS + 2 * MT, AREG, p.in[16], p.in[17], SVST, out};
        pg8::gemm_phase<EpiInOdd, true>(lds, g, S, E);
        SEpiInOdd ES{SS + 2 * MT, AREG, p.in[16], p.in[17], SVST, out};
        sample_gemm(lds, XN, (const bf16_t*)(ws + WS_WIN1), PW / 256, D, ES);
    }
    SEAM(6);
    if (IN(7)) REPS(7) { RSYNC(); phase_mix_odd(p, lds); }
    SEAM(7);
    if (IN(8)) {
        pg8::Gemm g{CAT, (const bf16_t*)(ws + WS_WOUT1), MP, D, D}; pg8::StaticOrder S; S.init(MP, D, G, cid);
        EpiResid<1> E{nullptr, out, XN, SS + 3 * MT};
        pg8::gemm_phase<EpiResid<1>, true>(lds, g, S, E);
        SEpiResid<1> ES{nullptr, out, XN, SS + 3 * MT};
        sample_gemm(lds, CAT, (const bf16_t*)(ws + WS_WOUT1), D / 256, D, ES);
    }
    SEAM(8);
    if (IN(9)) REPS(9) {   RSYNC();
        pg8::Gemm g{XN, (const bf16_t*)(ws + WS_WGU1), MP, 2 * FH, D}; pg8::StaticOrder S; S.init(MP, 2 * FH, G, cid);
        EpiGateUp E{SS + 3 * MT, HID};
        pg8::gemm_phase<EpiGateUp, true>(lds, g, S, E);
        SEpiGateUp ES{SS + 3 * MT, HID};
        sample_gemm(lds, XN, (const bf16_t*)(ws + WS_WGU1), 2 * FH / 256, D, ES);
    }
    SEAM(9);
    if (IN(10)) {
        pg8::Gemm g{HID, (const bf16_t*)(ws + WS_WDN1), MP, D, FH}; pg8::StaticOrder S; S.init(MP, D, G, cid);
        EpiResid<2> E{nullptr, out, XN, SS};
        pg8::gemm_phase<EpiResid<2>, true>(lds, g, S, E);
        SEpiResid<2> ES{nullptr, out, XN, SS};
        sample_gemm(lds, HID, (const bf16_t*)(ws + WS_WDN1), D / 256, FH, ES);
    }
#undef IN
#undef SEAM
}

constexpr int N_PHASES = 11;

extern "C" void kernel_launch(void* const* d_in, const int* in_sizes, int n_in, void* d_out, int out_size, void* d_ws, size_t ws_size, hipStream_t stream) {
    static int grid = 0;
    if (grid == 0) {
        if (n_in != 27 || ws_size < WS_END) { fprintf(stderr, "kernel_launch: unexpected n_in %d / ws %zu\n", n_in, ws_size); grid = -1; return; }
        int dev = 0, cus = 0, per_cu = 0;
        hipGetDevice(&dev);
        hipDeviceGetAttribute(&cus, hipDeviceAttributeMultiprocessorCount, dev);
        if (hipFuncSetAttribute((const void*)fwd_kernel, hipFuncAttributeMaxDynamicSharedMemorySize, LDS_BYTES) != hipSuccess) { fprintf(stderr, "kernel_launch: hipFuncSetAttribute failed\n"); grid = -1; return; }
        if (hipOccupancyMaxActiveBlocksPerMultiprocessor(&per_cu, (const void*)fwd_kernel, 512, LDS_BYTES) != hipSuccess || per_cu < 1) { fprintf(stderr, "kernel_launch: occupancy query says %d\n", per_cu); per_cu = 1; }
        (void)hipGetLastError();
        grid = cus;
    }
    if (grid < 0) return;
    Params a{};
    for (int i = 0; i < 27; ++i) a.in[i] = (const float*)d_in[i];
    a.out = (float*)d_out; a.ws = (unsigned char*)d_ws;
#if MK_ONE_LAUNCH
    if (hipMemsetAsync(d_ws, 0, 16384, stream) != hipSuccess) { fprintf(stderr, "kernel_launch: memset failed\n"); return; }
    a.ph_lo = 0; a.ph_hi = N_PHASES;
    void* args[] = {&a};
    hipError_t e = hipLaunchCooperativeKernel((const void*)fwd_kernel, dim3(grid), dim3(512), args, LDS_BYTES, stream);
    if (e != hipSuccess) fprintf(stderr, "cooperative launch failed: %s (grid %d)\n", hipGetErrorString(e), grid);
#else
    for (int ph = 0; ph < N_PHASES; ++ph) {
        a.ph_lo = ph; a.ph_hi = ph + 1;
        hipLaunchKernelGGL(fwd_kernel, dim3(grid), dim3(512), LDS_BYTES, stream, a);
    }
#endif
}
```

```cpp
#include <hip/hip_runtime.h>
#include <hip/hip_cooperative_groups.h>
#include <cstdio>
#include <cstdint>
namespace cg = cooperative_groups;

#ifndef MK_ONE_LAUNCH
#define MK_ONE_LAUNCH 1
#endif

#define LAS __attribute__((address_space(3)))
typedef unsigned short bf16_t;
typedef short bf16x8 __attribute__((ext_vector_type(8)));
typedef short s16x4 __attribute__((ext_vector_type(4)));
typedef float f32x4 __attribute__((ext_vector_type(4)));
typedef float f32x2 __attribute__((ext_vector_type(2)));
typedef float f32x16 __attribute__((ext_vector_type(16)));
typedef unsigned u32x4 __attribute__((ext_vector_type(4)));
typedef unsigned u32x2 __attribute__((ext_vector_type(2)));
typedef __bf16 bf16x2_t __attribute__((ext_vector_type(2)));

#define DI __device__ __forceinline__

constexpr int D = 1024, MP = 32768, MS = 128, MREAL = MP + MS, MT = 33024;
constexpr int SEQ = 4096, NB = 8, DSEQ = 16;
constexpr int MW = 512, PW = 2560, FH = 2816;
constexpr float LOG2E = 1.4426950408889634f;
constexpr float QSCALE = 0.125f * LOG2E;

constexpr size_t O_Y = 0;
constexpr size_t O_CAP = 33685504, O_CBP = 33808384, O_KP = 33816576, O_VP = 35913728;
constexpr size_t O_CAS = 38010880, O_CBS = 38133760, O_KS = 38141952, O_VS = 38207488, O_SVS = 38273024;

constexpr size_t MiB = 1u << 20;
constexpr size_t WS_SS = 1 * MiB;
constexpr size_t WS_SVST = 4 * MiB;
constexpr size_t WS_WIN0 = 8 * MiB, WS_WOUT0 = 13 * MiB, WS_WGU0 = 15 * MiB, WS_WDN0 = 26 * MiB;
constexpr size_t WS_WIN1 = 32 * MiB, WS_WOUT1 = 37 * MiB, WS_WGU1 = 39 * MiB, WS_WDN1 = 50 * MiB;
constexpr size_t WS_XN = 56 * MiB;
constexpr size_t WS_A = 122 * MiB;
constexpr size_t SUB = (size_t)MT * MW * 2;
constexpr size_t WS_CAT = 284 * MiB;
constexpr size_t WS_HID = 122 * MiB;
constexpr size_t WS_END = 349 * MiB;

constexpr int LDS_BYTES = 163840;

DI unsigned pk2(float lo, float hi) { f32x2 v = {lo, hi}; bf16x2_t b = __builtin_convertvector(v, bf16x2_t); return __builtin_bit_cast(unsigned, b); }
DI float bflo(unsigned u) { return __uint_as_float(u << 16); }
DI float bfhi(unsigned u) { return __uint_as_float(u & 0xffff0000u); }
DI u32x4 pk8(f32x4 a, f32x4 b) { u32x4 w; w.x = pk2(a[0], a[1]); w.y = pk2(a[2], a[3]); w.z = pk2(b[0], b[1]); w.w = pk2(b[2], b[3]); return w; }
DI void unpack8(const u32x4 w, float (&f)[8]) { f[0] = bflo(w.x); f[1] = bfhi(w.x); f[2] = bflo(w.y); f[3] = bfhi(w.y); f[4] = bflo(w.z); f[5] = bfhi(w.z); f[6] = bflo(w.w); f[7] = bfhi(w.w); }
DI float sigmoidf_(float x) { return __builtin_amdgcn_rcpf(1.0f + __expf(-x)); }
DI float wave_sum(float v) {
#pragma unroll
    for (int o = 1; o < 64; o <<= 1) v += __shfl_xor(v, o);
    return v;
}

namespace pg8 {
constexpr int BM = 256, BK = 64, HALF = 128, HTB = HALF * BK * 2, STAGE_BYTES = 8 * HTB, NXCD = 8, WGM = 8;
__host__ __device__ __forceinline__ int lds_byte(int r, int c) { const int st = (r >> 4) * 2 + (c >> 5), rr = r & 15, cc = c & 31, ob = rr * 64 + cc * 2; return st * 1024 + (ob ^ (((ob >> 9) & 1) << 5)); }
__host__ __device__ __forceinline__ void stage_rc(int b, int& R, int& C) { const int st = b / 1024, sb = b % 1024, swz = sb ^ (((sb >> 9) & 1) << 5); R = (st >> 1) * 16 + swz / 64; C = (st & 1) * 32 + (swz % 64) / 2; }
__host__ __device__ __forceinline__ int perm32(int rho) { const int n = rho >> 4, i = rho & 15; return 8 * (i >> 2) + 4 * n + (i & 3); }

struct Unit { int pm, pn; };
struct Gemm { const bf16_t* A; const bf16_t* Bt; int M, N, K; };

struct StaticOrder {
    int nM, nN, nwg, G, c;
    __device__ void init(int M, int N, int G_, int c_) { nM = M / BM; nN = N / BM; nwg = nM * nN; G = G_; c = c_; }
    __device__ bool next(int i, Unit& u) const {
        const long L = (long)i * G + c; if (L >= nwg) return false;
        int wgid = (int)L; { const int q = nwg / NXCD, r = nwg % NXCD, xcd = wgid % NXCD, off = wgid / NXCD; wgid = (xcd < r ? xcd * (q + 1) : r * (q + 1) + (xcd - r) * q) + off; }
        const int nig = WGM * nN, gid = wgid / nig, fm = gid * WGM, gsz = (nM - fm) < WGM ? (nM - fm) : WGM;
        u.pm = fm + ((wgid % nig) % gsz); u.pn = (wgid % nig) / gsz; return true;
    }
};

template <class Epi, bool ALIGN_EPI>
__device__ __forceinline__ void gemm_phase(LAS unsigned char* lds, const Gemm g, const StaticOrder& S, const Epi& E) {
    const int tid = threadIdx.x, wid = __builtin_amdgcn_readfirstlane(tid >> 6), lane = tid & 63, wr = wid >> 2, wc = wid & 3, fr = lane & 15, fq = lane >> 4;
    const int K = g.K, nt = K / BK;
    unsigned voffA[2], voffB[2];
#pragma unroll
    for (int i = 0; i < 2; ++i) { int R, C; stage_rc(tid * 16 + i * 8192, R, C); const int Rb = Epi::PERM ? ((R & ~31) + perm32(R & 31)) : R;
        voffA[i] = (unsigned)(R * K + C) * 2u; voffB[i] = (unsigned)(Rb * K + C) * 2u; }
    const size_t kstep = (size_t)(BK * 2);
    const size_t hstep = (size_t)HALF * K * 2;
    const size_t tstep = 2 * hstep;
    const unsigned ldsw = (unsigned)wid * 1024u;
    const int aoff = lds_byte(wr * 64 + fr, fq * 8), boff = lds_byte(wc * 32 + fr, fq * 8);
#define PG8_SA(b, h) (((b) * 2 + (h)) * HTB)
#define PG8_SB(b, h) ((4 + (b) * 2 + (h)) * HTB)
#define PG8_STAGE(bufoff, gbase, voff) do { _Pragma("unroll") for (int _i = 0; _i < 2; ++_i) \
        __builtin_amdgcn_global_load_lds((const unsigned*)((const char*)(gbase) + (voff)[_i]), (LAS unsigned*)(lds + (bufoff) + ldsw + _i * 8192), 16, 0, 0); } while (0)
#define PG8_LDA(dst, b, h) do { _Pragma("unroll") for (int m = 0; m < 4; ++m) _Pragma("unroll") for (int k = 0; k < 2; ++k) dst[m][k] = *(const LAS bf16x8*)(lds + PG8_SA(b, h) + aoff + m * 2048 + k * 1024); } while (0)
#define PG8_LDB(dst, b, h) do { _Pragma("unroll") for (int n = 0; n < 2; ++n) _Pragma("unroll") for (int k = 0; k < 2; ++k) dst[n][k] = *(const LAS bf16x8*)(lds + PG8_SB(b, h) + boff + n * 2048 + k * 1024); } while (0)
#define PG8_MMA(ai, bj, At, Bt) do { __builtin_amdgcn_s_setprio(1); _Pragma("unroll") for (int m = 0; m < 4; ++m) _Pragma("unroll") for (int n = 0; n < 2; ++n) _Pragma("unroll") for (int k = 0; k < 2; ++k) \
        acc[ai][bj][m][n] = __builtin_amdgcn_mfma_f32_16x16x32_bf16(Bt[n][k], At[m][k], acc[ai][bj][m][n], 0, 0, 0); __builtin_amdgcn_s_setprio(0); } while (0)
#define PG8_WAIT_V(n) asm volatile("s_waitcnt vmcnt(" #n ")" ::: "memory")
#define PG8_WAIT_L(n) asm volatile("s_waitcnt lgkmcnt(" #n ")" ::: "memory")
#define PG8_BAR __builtin_amdgcn_s_barrier()
#define PG8_SCHED __builtin_amdgcn_sched_barrier(0)
    Unit cur, nxt; int ui = 0;
    if (!S.next(0, cur)) return;
    f32x4 acc[2][2][4][2];
#pragma unroll
    for (int a = 0; a < 2; ++a)
#pragma unroll
        for (int b = 0; b < 2; ++b)
#pragma unroll
            for (int m = 0; m < 4; ++m)
#pragma unroll
                for (int n = 0; n < 2; ++n) acc[a][b][m][n] = (f32x4){0.f, 0.f, 0.f, 0.f};
    bf16x8 At[4][2], B0[2][2], B1[2][2];
    const char* cA = (const char*)g.A + (size_t)cur.pm * tstep; const char* cB = (const char*)g.Bt + (size_t)cur.pn * tstep;
    PG8_STAGE(PG8_SB(0, 0), cB, voffB); PG8_STAGE(PG8_SB(0, 1), cB + hstep, voffB); PG8_STAGE(PG8_SA(0, 0), cA, voffA); PG8_STAGE(PG8_SA(0, 1), cA + hstep, voffA);
    if (wr == 1) PG8_BAR;
    PG8_WAIT_V(2); PG8_BAR;
    PG8_STAGE(PG8_SB(1, 0), cB + kstep, voffB); PG8_STAGE(PG8_SA(1, 0), cA + kstep, voffA); PG8_STAGE(PG8_SB(1, 1), cB + hstep + kstep, voffB);
    PG8_WAIT_V(6); PG8_BAR;
    for (;;) {
        const bool has_next = S.next(ui + 1, nxt);
        const char* nA = has_next ? (const char*)g.A + (size_t)nxt.pm * tstep : cA; const char* nB = has_next ? (const char*)g.Bt + (size_t)nxt.pn * tstep : cB;
        for (int t = 0; t < nt; t += 2) {
            const bool last = (t == nt - 2);
            const char* a1 = cA + (size_t)(t + 1) * kstep;
            const char* a2 = last ? nA : cA + (size_t)(t + 2) * kstep; const char* b2 = last ? nB : cB + (size_t)(t + 2) * kstep;
            const char* a3 = a2 + kstep; const char* b3 = b2 + kstep;
            PG8_LDB(B0, 0, 0); PG8_LDB(B1, 0, 1); PG8_SCHED; PG8_LDA(At, 0, 0); PG8_STAGE(PG8_SA(1, 1), a1 + hstep, voffA);
            PG8_WAIT_V(8); PG8_WAIT_L(0); PG8_BAR; PG8_MMA(0, 0, At, B0); PG8_MMA(0, 1, At, B1); PG8_BAR; PG8_SCHED;
            PG8_LDA(At, 0, 1); PG8_STAGE(PG8_SB(0, 0), b2, voffB); PG8_STAGE(PG8_SB(0, 1), b2 + hstep, voffB); PG8_STAGE(PG8_SA(0, 0), a2, voffA);
            PG8_WAIT_V(8); PG8_WAIT_L(0); PG8_BAR; PG8_MMA(1, 0, At, B0); PG8_MMA(1, 1, At, B1); PG8_BAR; PG8_SCHED;
            PG8_LDB(B0, 1, 0); PG8_LDB(B1, 1, 1); PG8_SCHED; PG8_LDA(At, 1, 0); PG8_STAGE(PG8_SA(0, 1), a2 + hstep, voffA);
            PG8_WAIT_V(8); PG8_WAIT_L(0); PG8_BAR; PG8_MMA(0, 0, At, B0); PG8_MMA(0, 1, At, B1); PG8_BAR; PG8_SCHED;
            PG8_LDA(At, 1, 1); PG8_STAGE(PG8_SB(1, 0), b3, voffB); PG8_STAGE(PG8_SB(1, 1), b3 + hstep, voffB); PG8_STAGE(PG8_SA(1, 0), a3, voffA);
            PG8_WAIT_V(8); PG8_WAIT_L(0); PG8_BAR; PG8_MMA(1, 0, At, B0); PG8_MMA(1, 1, At, B1); PG8_BAR; PG8_SCHED;
        }
        if constexpr (ALIGN_EPI) { if (wr == 0) PG8_BAR; }
        E(acc, cur, wr, wc, fr, fq);
        if (!has_next) break;
#pragma unroll
        for (int a = 0; a < 2; ++a)
#pragma unroll
            for (int b = 0; b < 2; ++b)
#pragma unroll
                for (int m = 0; m < 4; ++m)
#pragma unroll
                    for (int n = 0; n < 2; ++n) acc[a][b][m][n] = (f32x4){0.f, 0.f, 0.f, 0.f};
        cur = nxt; cA = nA; cB = nB; ++ui;
        if constexpr (ALIGN_EPI) { if (wr == 1) PG8_BAR; }
    }
    PG8_WAIT_V(0);
    if constexpr (!ALIGN_EPI) { if (wr == 0) PG8_BAR; }
    PG8_BAR;
#undef PG8_SA
#undef PG8_SB
#undef PG8_STAGE
#undef PG8_LDA
#undef PG8_LDB
#undef PG8_MMA
#undef PG8_WAIT_V
#undef PG8_WAIT_L
#undef PG8_BAR
#undef PG8_SCHED
}
}

typedef f32x4 Acc[2][2][4][2];

DI float row_rstd(const float* SS, int row) { return rsqrtf(SS[row] * (1.0f / 1024.0f) + 1e-6f); }

struct EpiInEven {
    static constexpr bool PERM = true;
    const float* SS; bf16_t *A0, *Z0, *GB0;
    DI void operator()(const Acc& acc, const pg8::Unit& u, int wr, int wc, int fr, int fq) const {
        const int row0 = u.pm * 256 + wr * 64 + fr, cl = wc * 32 + fq * 8;
        float rsv[2][4];
#pragma unroll
        for (int ai = 0; ai < 2; ++ai)
#pragma unroll
            for (int m = 0; m < 4; ++m) rsv[ai][m] = row_rstd(SS, row0 + ai * 128 + m * 16);
        if (u.pn < 8) {
            bf16_t* O = (u.pn < 4) ? A0 : Z0; const int colb = (u.pn & 3) * 128 + cl; const bool glu = u.pn < 4;
#pragma unroll
            for (int ai = 0; ai < 2; ++ai)
#pragma unroll
                for (int m = 0; m < 4; ++m) {
                    const int row = row0 + ai * 128 + m * 16;
                    const float rs = rsv[ai][m];
                    f32x4 x0 = acc[ai][0][m][0] * rs, x1 = acc[ai][0][m][1] * rs, y0 = acc[ai][1][m][0] * rs, y1 = acc[ai][1][m][1] * rs;
                    if (glu) {
#pragma unroll
                        for (int i = 0; i < 4; ++i) { y0[i] = sigmoidf_(y0[i]); y1[i] = sigmoidf_(y1[i]); }
                    }
                    *(u32x4*)(O + (size_t)row * MW + colb) = pk8(x0 * y0, x1 * y1);
                }
        } else {
            const int colb = (u.pn - 8) * 256 + cl;
#pragma unroll
            for (int ai = 0; ai < 2; ++ai)
#pragma unroll
                for (int m = 0; m < 4; ++m) {
                    const int row = row0 + ai * 128 + m * 16;
                    const float rs = rsv[ai][m];
#pragma unroll
                    for (int bj = 0; bj < 2; ++bj) *(u32x4*)(GB0 + (size_t)row * MW + colb + bj * 128) = pk8(acc[ai][bj][m][0] * rs, acc[ai][bj][m][1] * rs);
                }
        }
    }
};

template <int MODE> struct EpiResid {
    static constexpr bool PERM = true;
    const float* xin; float* out; bf16_t* XN; float* SS;
    DI void operator()(const Acc& acc, const pg8::Unit& u, int wr, int wc, int fr, int fq) const {
        const int colb = u.pn * 256 + wc * 32 + fq * 8;
        const int row0 = u.pm * 256 + wr * 64 + fr;
        if (MODE == 0) {
#pragma unroll
            for (int ai = 0; ai < 2; ++ai) {
                f32x4 rx[4][2][2];
#pragma unroll
                for (int m = 0; m < 4; ++m)
#pragma unroll
                    for (int bj = 0; bj < 2; ++bj) { const float* s = xin + (size_t)(row0 + ai * 128 + m * 16) * D + colb + bj * 128; rx[m][bj][0] = *(const f32x4*)s; rx[m][bj][1] = *(const f32x4*)(s + 4); }
#pragma unroll
                for (int m = 0; m < 4; ++m) {
                    const int row = row0 + ai * 128 + m * 16;
                    float ssq = 0.f;
#pragma unroll
                    for (int bj = 0; bj < 2; ++bj) {
                        const f32x4 v0 = rx[m][bj][0] + acc[ai][bj][m][0], v1 = rx[m][bj][1] + acc[ai][bj][m][1];
                        ssq += (v0[0] * v0[0] + v0[1] * v0[1]) + (v0[2] * v0[2] + v0[3] * v0[3]) + (v1[0] * v1[0] + v1[1] * v1[1]) + (v1[2] * v1[2] + v1[3] * v1[3]);
                        *(u32x4*)(XN + (size_t)row * D + colb + bj * 128) = pk8(v0, v1);
                    }
                    ssq += __shfl_xor(ssq, 16); ssq += __shfl_xor(ssq, 32);
                    if (fq == 0) atomicAdd(SS + row, ssq);
                }
            }
        } else {
#pragma unroll
            for (int ai = 0; ai < 2; ++ai) {
                u32x4 rx[4][2];
#pragma unroll
                for (int m = 0; m < 4; ++m)
#pragma unroll
                    for (int bj = 0; bj < 2; ++bj) rx[m][bj] = *(const u32x4*)(XN + (size_t)(row0 + ai * 128 + m * 16) * D + colb + bj * 128);
#pragma unroll
                for (int m = 0; m < 4; ++m) {
                    const int row = row0 + ai * 128 + m * 16;
                    float ssq = 0.f;
#pragma unroll
                    for (int bj = 0; bj < 2; ++bj) {
                        const int col = colb + bj * 128;
                        float f[8]; unpack8(rx[m][bj], f);
                        const f32x4 v0 = (f32x4){f[0], f[1], f[2], f[3]} + acc[ai][bj][m][0], v1 = (f32x4){f[4], f[5], f[6], f[7]} + acc[ai][bj][m][1];
                        if (MODE == 2) { *(f32x4*)(out + (size_t)row * D + col) = v0; *(f32x4*)(out + (size_t)row * D + col + 4) = v1; }
                        else {
                            ssq += (v0[0] * v0[0] + v0[1] * v0[1]) + (v0[2] * v0[2] + v0[3] * v0[3]) + (v1[0] * v1[0] + v1[1] * v1[1]) + (v1[2] * v1[2] + v1[3] * v1[3]);
                            *(u32x4*)(XN + (size_t)row * D + col) = pk8(v0, v1);
                        }
                    }
                    if (MODE != 2) {
                        ssq += __shfl_xor(ssq, 16); ssq += __shfl_xor(ssq, 32);
                        if (fq == 0) atomicAdd(SS + row, ssq);
                    }
                }
            }
        }
    }
};

struct EpiGateUp {
    static constexpr bool PERM = true;
    const float* SS; bf16_t* HID;
    DI void operator()(const Acc& acc, const pg8::Unit& u, int wr, int wc, int fr, int fq) const {
        const int colb = u.pn * 128 + wc * 32 + fq * 8;
        float rsv[2][4];
#pragma unroll
        for (int ai = 0; ai < 2; ++ai)
#pragma unroll
            for (int m = 0; m < 4; ++m) rsv[ai][m] = row_rstd(SS, u.pm * 256 + ai * 128 + wr * 64 + m * 16 + fr);
#pragma unroll
        for (int ai = 0; ai < 2; ++ai)
#pragma unroll
            for (int m = 0; m < 4; ++m) {
                const int row = u.pm * 256 + ai * 128 + wr * 64 + m * 16 + fr;
                const float rs = rsv[ai][m];
                f32x4 h0, h1;
                const float rs2 = rs * rs, nrl = -rs * LOG2E;
#pragma unroll
                for (int i = 0; i < 4; ++i) {
                    const float a0 = acc[ai][0][m][0][i], a1 = acc[ai][0][m][1][i];
                    h0[i] = (a0 * acc[ai][1][m][0][i]) * rs2 * __builtin_amdgcn_rcpf(1.0f + __builtin_amdgcn_exp2f(a0 * nrl));
                    h1[i] = (a1 * acc[ai][1][m][1][i]) * rs2 * __builtin_amdgcn_rcpf(1.0f + __builtin_amdgcn_exp2f(a1 * nrl));
                }
                *(u32x4*)(HID + (size_t)row * FH + colb) = pk8(h0, h1);
            }
    }
};

struct EpiInOdd {
    static constexpr bool PERM = true;
    const float* SS; bf16_t* QKVUS; const float* qg; const float* kg; float* SVST; float* out;
    DI void operator()(const Acc& acc, const pg8::Unit& u, int wr, int wc, int fr, int fq) const {
        const int typ = u.pn >> 1, ph = u.pn & 1;
        bf16_t* O = QKVUS + (size_t)typ * ((size_t)MT * MW);
        const bool samp = (u.pm == 128);
        const bool keep = samp || ((u.pm & 15) >= 14);
        float rsv[2][4];
#pragma unroll
        for (int ai = 0; ai < 2; ++ai)
#pragma unroll
            for (int m = 0; m < 4; ++m) rsv[ai][m] = row_rstd(SS, u.pm * 256 + ai * 128 + wr * 64 + m * 16 + fr);
        if (typ < 2) {
            const float* gsrc = typ == 0 ? qg : kg;
            f32x4 gv[2][2];
#pragma unroll
            for (int bj = 0; bj < 2; ++bj)
#pragma unroll
                for (int n = 0; n < 2; ++n) gv[bj][n] = *(const f32x4*)(gsrc + 32 * bj + 8 * fq + 4 * n);
            const float osc = typ == 0 ? QSCALE : 1.0f;
            const int head = ph * 4 + wc;
#pragma unroll
            for (int ai = 0; ai < 2; ++ai)
#pragma unroll
                for (int m = 0; m < 4; ++m) {
                    const int row = u.pm * 256 + ai * 128 + wr * 64 + m * 16 + fr;
                    const float rs = rsv[ai][m];
                    f32x4 v[2][2]; float ssq = 0.f;
#pragma unroll
                    for (int bj = 0; bj < 2; ++bj)
#pragma unroll
                        for (int n = 0; n < 2; ++n) { v[bj][n] = acc[ai][bj][m][n] * rs; const f32x4 t = v[bj][n]; ssq += (t[0] * t[0] + t[1] * t[1]) + (t[2] * t[2] + t[3] * t[3]); }
                    ssq += __shfl_xor(ssq, 16); ssq += __shfl_xor(ssq, 32);
                    const float r = rsqrtf(ssq * (1.0f / 64.0f) + 1e-6f);
#pragma unroll
                    for (int bj = 0; bj < 2; ++bj) {
                        const f32x4 o0 = v[bj][0] * r * gv[bj][0], o1 = v[bj][1] * r * gv[bj][1];
                        *(u32x4*)(O + (size_t)row * MW + head * 64 + 32 * bj + 8 * fq) = pk8(o0 * osc, o1 * osc);
                        if (typ == 1 && keep && !(samp && ai == 1)) {
                            float* dst;
                            if (samp) dst = out + O_KS + (size_t)(row - MP) * 512;
                            else { const int b = u.pm >> 4, t = (u.pm & 15) * 256 + ai * 128 + wr * 64 + m * 16 + fr - 3584; dst = out + O_KP + ((size_t)b * 512 + t) * 512; }
                            dst += head * 64 + 32 * bj + 8 * fq;
                            *(f32x4*)dst = o0; *(f32x4*)(dst + 4) = o1;
                        }
                    }
                }
        } else {
#pragma unroll
            for (int ai = 0; ai < 2; ++ai)
#pragma unroll
                for (int m = 0; m < 4; ++m) {
                    const int row = u.pm * 256 + ai * 128 + wr * 64 + m * 16 + fr;
                    const float rs = rsv[ai][m];
                    float s1 = 0.f, s2 = 0.f;
#pragma unroll
                    for (int bj = 0; bj < 2; ++bj) {
                        const f32x4 o0 = acc[ai][bj][m][0] * rs, o1 = acc[ai][bj][m][1] * rs;
                        const int col = ph * 256 + bj * 128 + wc * 32 + fq * 8;
                        *(u32x4*)(O + (size_t)row * MW + col) = pk8(o0, o1);
                        if (typ == 4) {
                            s1 += (o0[0] + o0[1]) + (o0[2] + o0[3]) + (o1[0] + o1[1]) + (o1[2] + o1[3]);
                            s2 += (o0[0] * o0[0] + o0[1] * o0[1]) + (o0[2] * o0[2] + o0[3] * o0[3]) + (o1[0] * o1[0] + o1[1] * o1[1]) + (o1[2] * o1[2] + o1[3] * o1[3]);
                        }
                        if (typ == 2 && keep && !(samp && ai == 1)) {
                            float* dst;
                            if (samp) dst = out + O_VS + (size_t)(row - MP) * 512;
                            else { const int b = u.pm >> 4, t = (u.pm & 15) * 256 + ai * 128 + wr * 64 + m * 16 + fr - 3584; dst = out + O_VP + ((size_t)b * 512 + t) * 512; }
                            dst += col;
                            *(f32x4*)dst = o0; *(f32x4*)(dst + 4) = o1;
                        }
                    }
                    if (typ == 4) {
                        s1 += __shfl_xor(s1, 16); s1 += __shfl_xor(s1, 32); s2 += __shfl_xor(s2, 16); s2 += __shfl_xor(s2, 32);
                        if (fq == 0) *(f32x2*)(SVST + ((size_t)row * 8 + ph * 4 + wc) * 2) = (f32x2){s1, s2};
                    }
                }
        }
    }
};


DI float red16(float v) { v += __shfl_xor(v, 1); v += __shfl_xor(v, 2); v += __shfl_xor(v, 4); v += __shfl_xor(v, 8); return v; }
DI f32x4 shx8(const f32x4 v) { f32x4 o; o[0] = __shfl_xor(v[0], 8); o[1] = __shfl_xor(v[1], 8); o[2] = __shfl_xor(v[2], 8); o[3] = __shfl_xor(v[3], 8); return o; }
DI u32x2 pk4(const f32x4 a) { return (u32x2){pk2(a[0], a[1]), pk2(a[2], a[3])}; }

struct SEpiInEven {
    const float* SS; bf16_t *A0, *Z0, *GB0;
    DI void operator()(const f32x4 vraw, int row, int pn, int wc, int bj, int cl) const {
        const f32x4 v = vraw * row_rstd(SS, row);
        const f32x4 o = shx8(v);
        if (pn < 8) {
            if (bj == 0) {
                f32x4 y = o;
                if (pn < 4) {
#pragma unroll
                    for (int i = 0; i < 4; ++i) y[i] = sigmoidf_(y[i]);
                }
                bf16_t* O = (pn < 4) ? A0 : Z0;
                *(u32x2*)(O + (size_t)row * MW + (pn & 3) * 128 + wc * 32 + cl) = pk4(v * y);
            }
        } else *(u32x2*)(GB0 + (size_t)row * MW + (pn - 8) * 256 + bj * 128 + wc * 32 + cl) = pk4(v);
    }
};
template <int MODE> struct SEpiResid {
    const float* xin; float* out; bf16_t* XN; float* SS;
    DI void operator()(const f32x4 v, int row, int pn, int wc, int bj, int cl) const {
        const int col = pn * 256 + bj * 128 + wc * 32 + cl;
        f32x4 x;
        if (MODE == 0) x = *(const f32x4*)(xin + (size_t)row * D + col);
        else { const u32x2 w = *(const u32x2*)(XN + (size_t)row * D + col); x = (f32x4){bflo(w.x), bfhi(w.x), bflo(w.y), bfhi(w.y)}; }
        x += v;
        if (MODE == 2) *(f32x4*)(out + (size_t)row * D + col) = x;
        else {
            *(u32x2*)(XN + (size_t)row * D + col) = pk4(x);
            const float ssq = red16((x[0] * x[0] + x[1] * x[1]) + (x[2] * x[2] + x[3] * x[3]));
            if ((threadIdx.x & 15) == 0) atomicAdd(SS + row, ssq);
        }
    }
};
struct SEpiGateUp {
    const float* SS; bf16_t* HID;
    DI void operator()(const f32x4 v, int row, int pn, int wc, int bj, int cl) const {
        const float rs = row_rstd(SS, row);
        const f32x4 o = shx8(v);
        if (bj == 0) {
            f32x4 hv;
#pragma unroll
            for (int i = 0; i < 4; ++i) { const float g0 = v[i] * rs; hv[i] = g0 * sigmoidf_(g0) * (o[i] * rs); }
            *(u32x2*)(HID + (size_t)row * FH + pn * 128 + wc * 32 + cl) = pk4(hv);
        }
    }
};
struct SEpiInOdd {
    const float* SS; bf16_t* QKVUS; const float* qg; const float* kg; float* SVST; float* out;
    DI void operator()(const f32x4 v, int row, int pn, int wc, int bj, int cl) const {
        const int typ = pn >> 1, ph = pn & 1;
        bf16_t* O = QKVUS + (size_t)typ * ((size_t)MT * MW);
        const float rs = row_rstd(SS, row);
        const f32x4 x = v * rs;
        if (typ < 2) {
            const int head = ph * 4 + wc, dd = 32 * bj + cl;
            const float ssq = red16((x[0] * x[0] + x[1] * x[1]) + (x[2] * x[2] + x[3] * x[3]));
            const float r = rsqrtf(ssq * (1.0f / 64.0f) + 1e-6f);
            const f32x4 gv = *(const f32x4*)((typ == 0 ? qg : kg) + dd);
            const f32x4 o = x * r * gv;
            *(u32x2*)(O + (size_t)row * MW + head * 64 + dd) = pk4(o * (typ == 0 ? QSCALE : 1.0f));
            if (typ == 1) *(f32x4*)(out + O_KS + (size_t)(row - MP) * 512 + head * 64 + dd) = o;
        } else {
            const int col = ph * 256 + bj * 128 + wc * 32 + cl;
            *(u32x2*)(O + (size_t)row * MW + col) = pk4(x);
            if (typ == 2) *(f32x4*)(out + O_VS + (size_t)(row - MP) * 512 + col) = x;
            if (typ == 4) {
                const float s1 = red16((x[0] + x[1]) + (x[2] + x[3])), s2 = red16((x[0] * x[0] + x[1] * x[1]) + (x[2] * x[2] + x[3] * x[3]));
                if ((threadIdx.x & 15) == 0) *(f32x2*)(SVST + ((size_t)row * 8 + ph * 4 + wc) * 2) = (f32x2){s1, s2};
            }
        }
    }
};

template <class EpiS>
DI void sample_gemm(LAS unsigned char* lds, const bf16_t* A, const bf16_t* Bt, int nN, int K, const EpiS& E) {
    const int tid = threadIdx.x, lane = tid & 63, w = __builtin_amdgcn_readfirstlane(tid >> 6), r32 = lane & 31, h = lane >> 5;
    const int nunits = 16 * nN, kw = K >> 3, nk = kw >> 4;
    for (int un = (int)blockIdx.x; un < nunits; un += (int)gridDim.x) {
        const int rb = un & 3, wc = (un >> 2) & 3, pn = un >> 4;
        const bf16_t* ap = A + (size_t)(MP + rb * 32 + r32) * K + w * kw + h * 8;
        const bf16_t* b0p = Bt + (size_t)(pn * 256 + wc * 32 + r32) * K + w * kw + h * 8;
        const bf16_t* b1p = b0p + (size_t)128 * K;
        f32x16 c0, c1;
#pragma unroll
        for (int r = 0; r < 16; ++r) { c0[r] = 0.f; c1[r] = 0.f; }
#pragma unroll 8
        for (int ks = 0; ks < nk; ++ks) {
            const bf16x8 a = *(const bf16x8*)(ap + ks * 16), b0 = *(const bf16x8*)(b0p + ks * 16), b1 = *(const bf16x8*)(b1p + ks * 16);
            c0 = __builtin_amdgcn_mfma_f32_32x32x16_bf16(a, b0, c0, 0, 0, 0);
            c1 = __builtin_amdgcn_mfma_f32_32x32x16_bf16(a, b1, c1, 0, 0, 0);
        }
        __syncthreads();
        LAS float* part = (LAS float*)(lds + w * 8192);
#pragma unroll
        for (int r = 0; r < 16; ++r) { const int row = (r & 3) + 8 * (r >> 2) + 4 * h; part[row * 64 + r32] = c0[r]; part[row * 64 + 32 + r32] = c1[r]; }
        __syncthreads();
        f32x4 v = (f32x4){0.f, 0.f, 0.f, 0.f};
#pragma unroll
        for (int ww = 0; ww < 8; ++ww) v += *(const LAS f32x4*)(lds + ww * 8192 + (tid >> 4) * 256 + (tid & 15) * 16);
        E(v, MP + rb * 32 + (tid >> 4), pn, wc, (tid >> 3) & 1, 4 * (tid & 7));
    }
    __syncthreads();
}

struct Params {
    const float* in[27];
    float* out;
    unsigned char* ws;
    int ph_lo, ph_hi;
};

DI int map_col(int kind, int n) {
    if (kind == 1) { const int seg = n >> 9, o = n & 511, t = o >> 7, r = o & 127;
        if (seg == 0) return t * 256 + r; if (seg == 1) return t * 256 + 128 + r; if (seg == 2) return 2048 + o;
        if (seg == 3) return 1024 + t * 256 + r; return 1024 + t * 256 + 128 + r; }
    if (kind == 2) { const int up = n >= FH ? 1 : 0, o = up ? n - FH : n; return (o >> 7) * 256 + up * 128 + (o & 127); }
    if (kind == 3) { if (n >= 1024) return n; const int t = n >> 8, hl = (n >> 6) & 3, dd = n & 63; return t * 256 + (dd >> 5) * 128 + hl * 32 + (dd & 31); }
    return n;
}
DI void transpose_item(const float* W, int K, int N, bf16_t* WT, int kind, const float* gain, LAS float* scr, int item, int lane) {
    const int nblk = N / 64, kb = item / nblk, nb = item % nblk, k0 = 64 * kb, n0 = 64 * nb;
    const int lr = lane >> 4, lc = (lane & 15) * 4;
    f32x4 v[16];
#pragma unroll
    for (int i = 0; i < 16; ++i) v[i] = *(const f32x4*)(W + (size_t)(k0 + 4 * i + lr) * N + n0 + lc);
    if (gain) {
        float gk[16];
#pragma unroll
        for (int i = 0; i < 16; ++i) gk[i] = gain[k0 + 4 * i + lr];
#pragma unroll
        for (int i = 0; i < 16; ++i) v[i] *= gk[i];
    }
#pragma unroll
    for (int i = 0; i < 16; ++i) { LAS float* d = scr + (4 * i + lr) * 65 + lc; d[0] = v[i][0]; d[1] = v[i][1]; d[2] = v[i][2]; d[3] = v[i][3]; }
    asm volatile("s_waitcnt lgkmcnt(0)" ::: "memory");
    const int c = lane & 7;
#pragma unroll
    for (int j = 0; j < 8; ++j) { const int n = (lane >> 3) + 8 * j; const LAS float* s = scr + (8 * c) * 65 + n;
        u32x4 o; o.x = pk2(s[0 * 65], s[1 * 65]); o.y = pk2(s[2 * 65], s[3 * 65]); o.z = pk2(s[4 * 65], s[5 * 65]); o.w = pk2(s[6 * 65], s[7 * 65]);
        *(u32x4*)(WT + (size_t)map_col(kind, n0 + n) * K + k0 + 8 * c) = o; }
    asm volatile("s_waitcnt lgkmcnt(0)" ::: "memory");
}

DI void phase_prologue(const Params& p, LAS unsigned char* lds) {
    const int tid = threadIdx.x, lane = tid & 63, wave = tid >> 6;
    LAS float* scr = (LAS float*)(lds + wave * 16896);
    const int gw = blockIdx.x * 8 + wave, NGW = gridDim.x * 8;
    unsigned char* ws = p.ws;
    bf16_t* XN = (bf16_t*)(ws + WS_XN);
    float* SS = (float*)(ws + WS_SS);
    for (int q = gw; q < MT / 4; q += NGW) {
        const int row0 = q * 4;
        if (row0 < MREAL) {
            f32x4 v[4][4];
#pragma unroll
            for (int r = 0; r < 4; ++r) {
                const int row = row0 + r;
                const float* src = row < MP ? p.in[0] + (size_t)row * D : p.in[1] + (size_t)(row - MP) * D;
                const f32x4* xr = (const f32x4*)src + lane;
#pragma unroll
                for (int j = 0; j < 4; ++j) v[r][j] = xr[64 * j];
            }
#pragma unroll
            for (int r = 0; r < 4; ++r) {
                const int row = row0 + r;
                float s = 0.f;
#pragma unroll
                for (int j = 0; j < 4; ++j) s += (v[r][j][0] * v[r][j][0] + v[r][j][1] * v[r][j][1]) + (v[r][j][2] * v[r][j][2] + v[r][j][3] * v[r][j][3]);
                s = wave_sum(s);
                u32x2* o8 = (u32x2*)(XN + (size_t)row * D) + lane;
#pragma unroll
                for (int j = 0; j < 4; ++j) o8[64 * j] = (u32x2){pk2(v[r][j][0], v[r][j][1]), pk2(v[r][j][2], v[r][j][3])};
                if (lane < 4) SS[(size_t)lane * MT + row] = lane == 0 ? s : 0.f;
            }
        } else {
#pragma unroll
            for (int r = 0; r < 4; ++r) { u32x2* o8 = (u32x2*)(XN + (size_t)(row0 + r) * D) + lane;
#pragma unroll
                for (int j = 0; j < 4; ++j) o8[64 * j] = (u32x2){0u, 0u}; }
        }
    }
    constexpr int I_IN = 16 * 40, I_OUT = 16 * 16, I_GU = 16 * 88, I_DN = 44 * 16, I_L = I_IN + I_OUT + I_GU + I_DN;
    for (int it = gw; it < 2 * I_L; it += NGW) {
        const int L = it >= I_L ? 1 : 0; int r = it - L * I_L;
        if (r < I_IN) { transpose_item(L ? p.in[15] : p.in[7], D, PW, (bf16_t*)(ws + (L ? WS_WIN1 : WS_WIN0)), L ? 3 : 1, L ? p.in[14] : p.in[6], scr, r, lane); continue; } r -= I_IN;
        if (r < I_OUT) { transpose_item(L ? p.in[23] : p.in[13], D, D, (bf16_t*)(ws + (L ? WS_WOUT1 : WS_WOUT0)), 0, nullptr, scr, r, lane); continue; } r -= I_OUT;
        if (r < I_GU) { transpose_item(p.in[25] + (size_t)L * D * 2 * FH, D, 2 * FH, (bf16_t*)(ws + (L ? WS_WGU1 : WS_WGU0)), 2, p.in[24] + L * D, scr, r, lane); continue; } r -= I_GU;
        transpose_item(p.in[26] + (size_t)L * FH * D, FH, D, (bf16_t*)(ws + (L ? WS_WDN1 : WS_WDN0)), 0, nullptr, scr, r, lane);
    }
}


DI float dot2bf(unsigned a, unsigned b, float c) { return __builtin_amdgcn_fdot2_f32_bf16(__builtin_bit_cast(bf16x2_t, a), __builtin_bit_cast(bf16x2_t, b), c, false); }
DI void st8f(float* dst, const u32x4 w) { float f[8]; unpack8(w, f); *(f32x4*)dst = (f32x4){f[0], f[1], f[2], f[3]}; *(f32x4*)(dst + 4) = (f32x4){f[4], f[5], f[6], f[7]}; }

constexpr int CV_PAR = 98304;
DI void phase_conv(const Params& p, LAS unsigned char* lds) {
    const int tid = threadIdx.x, lane = tid & 63, wid = __builtin_amdgcn_readfirstlane(tid >> 6);
    unsigned char* ws = p.ws;
    const bf16_t* A0 = (const bf16_t*)(ws + WS_A); const bf16_t* Z0 = (const bf16_t*)(ws + WS_A + SUB); const bf16_t* GB0 = (const bf16_t*)(ws + WS_A + 2 * SUB);
    bf16_t* CAT = (bf16_t*)(ws + WS_CAT);
    const float* cache_a = p.in[2]; const float* cache_b = p.in[3];
    const float* caw = p.in[8];
    float* out = p.out;
    const int c0 = lane * 8, par = wid >> 2;
    __syncthreads();
    {
        LAS float* pr = (LAS float*)(lds + CV_PAR);
        for (int i = tid; i < 512; i += 512) { pr[i] = p.in[9][i]; pr[512 + i] = p.in[10][i]; pr[1024 + i] = p.in[11][i]; pr[1536 + i] = p.in[12][i]; pr[2048 + i] = p.in[12][512 + i]; pr[2560 + i] = p.in[12][1024 + i]; }
    }
    unsigned wp[16][8];
#pragma unroll
    for (int i = 0; i < 16; ++i) {
        const int ja = par ? 2 * i - 1 : 2 * i, jb = ja + 1;
        f32x4 a0 = (f32x4){0.f, 0.f, 0.f, 0.f}, a1 = a0, b0 = a0, b1 = a0;
        if (ja >= 0) { a0 = *(const f32x4*)(caw + ja * MW + c0); a1 = *(const f32x4*)(caw + ja * MW + c0 + 4); }
        if (jb <= 30) { b0 = *(const f32x4*)(caw + jb * MW + c0); b1 = *(const f32x4*)(caw + jb * MW + c0 + 4); }
#pragma unroll
        for (int k = 0; k < 4; ++k) { asm volatile("v_cvt_pk_bf16_f32 %0, %1, %2" : "=v"(wp[i][k]) : "v"(a0[k]), "v"(b0[k])); asm volatile("v_cvt_pk_bf16_f32 %0, %1, %2" : "=v"(wp[i][4 + k]) : "v"(a1[k]), "v"(b1[k])); }
    }
    for (int un = blockIdx.x; un < 520; un += gridDim.x) {
        const bool samp = un >= 512;
        const int b = samp ? un - 512 : un >> 6, t0 = samp ? 0 : (un & 63) * 64, R = samp ? 16 : 64;
        const size_t rowbase = samp ? (size_t)MP + b * 16 : (size_t)b * SEQ;
        __syncthreads();
        for (int pr_ = wid; pr_ < (R + 30) / 2; pr_ += 8) {
            u32x4 v0 = (u32x4){0u, 0u, 0u, 0u}, v1 = v0;
            const int ta = t0 - 30 + 2 * pr_;
            if (ta >= 0) { v0 = *(const u32x4*)(A0 + (rowbase + ta) * MW + c0); v1 = *(const u32x4*)(A0 + (rowbase + ta + 1) * MW + c0); }
            else if (samp) { const f32x4* s0 = (const f32x4*)(cache_a + ((size_t)b * 30 + (30 + ta)) * MW + c0); const f32x4* s1 = s0 + MW / 4; v0 = pk8(s0[0], s0[1]); v1 = pk8(s1[0], s1[1]); }
            u32x4 e0, e1;
            e0.x = (v0.x & 0xffffu) | (v1.x << 16); e0.y = (v0.x >> 16) | (v1.x & 0xffff0000u); e0.z = (v0.y & 0xffffu) | (v1.y << 16); e0.w = (v0.y >> 16) | (v1.y & 0xffff0000u);
            e1.x = (v0.z & 0xffffu) | (v1.z << 16); e1.y = (v0.z >> 16) | (v1.z & 0xffff0000u); e1.z = (v0.w & 0xffffu) | (v1.w << 16); e1.w = (v0.w >> 16) | (v1.w & 0xffff0000u);
            *(LAS u32x4*)(lds + pr_ * 2048 + lane * 16) = e0; *(LAS u32x4*)(lds + pr_ * 2048 + 1024 + lane * 16) = e1;
        }
        __syncthreads();
        const int nrow = R >> 3;
        for (int i = 0; i < nrow; ++i) {
            const int r = par + 2 * ((wid & 3) + 4 * i);
            const int t = t0 + r; const size_t row = rowbase + t;
            const u32x4 zz = *(const u32x4*)(Z0 + row * MW + c0), gbv = *(const u32x4*)(GB0 + row * MW + c0);
            u32x4 z1 = (u32x4){0u, 0u, 0u, 0u}, z2 = z1;
            if (t >= 1) z1 = *(const u32x4*)(Z0 + (row - 1) * MW + c0);
            else if (samp) { const f32x4* s = (const f32x4*)(cache_b + ((size_t)b * 2 + 1) * MW + c0); z1 = pk8(s[0], s[1]); }
            if (t >= 2) z2 = *(const u32x4*)(Z0 + (row - 2) * MW + c0);
            else if (samp) { const f32x4* s = (const f32x4*)(cache_b + ((size_t)b * 2 + t) * MW + c0); z2 = pk8(s[0], s[1]); }
            const LAS float* pr = (const LAS float*)(lds + CV_PAR) + c0;
            f32x4 ac0 = *(const LAS f32x4*)pr, ac1 = *(const LAS f32x4*)(pr + 4);
            const LAS unsigned char* eb = lds + (r >> 1) * 2048 + lane * 16;
#pragma unroll
            for (int q = 0; q < 16; ++q) {
                const u32x4 e0 = *(const LAS u32x4*)(eb + q * 2048), e1 = *(const LAS u32x4*)(eb + q * 2048 + 1024);
                ac0[0] = dot2bf(e0.x, wp[q][0], ac0[0]); ac0[1] = dot2bf(e0.y, wp[q][1], ac0[1]); ac0[2] = dot2bf(e0.z, wp[q][2], ac0[2]); ac0[3] = dot2bf(e0.w, wp[q][3], ac0[3]);
                ac1[0] = dot2bf(e1.x, wp[q][4], ac1[0]); ac1[1] = dot2bf(e1.y, wp[q][5], ac1[1]); ac1[2] = dot2bf(e1.z, wp[q][6], ac1[2]); ac1[3] = dot2bf(e1.w, wp[q][7], ac1[3]);
                if ((q & 1) == 1) __builtin_amdgcn_sched_barrier(0);
            }
            const float mean = wave_sum((ac0[0] + ac0[1]) + (ac0[2] + ac0[3]) + (ac1[0] + ac1[1]) + (ac1[2] + ac1[3])) * (1.0f / 512.0f);
            ac0 -= mean; ac1 -= mean;
            const float rstd = rsqrtf(wave_sum((ac0[0] * ac0[0] + ac0[1] * ac0[1]) + (ac0[2] * ac0[2] + ac0[3] * ac0[3]) + (ac1[0] * ac1[0] + ac1[1] * ac1[1]) + (ac1[2] * ac1[2] + ac1[3] * ac1[3])) * (1.0f / 512.0f) + 1e-5f);
            const f32x4 g0 = *(const LAS f32x4*)(pr + 512), g1 = *(const LAS f32x4*)(pr + 516), b0 = *(const LAS f32x4*)(pr + 1024), b1 = *(const LAS f32x4*)(pr + 1028);
            f32x4 y0 = ac0 * rstd * g0 + b0, y1 = ac1 * rstd * g1 + b1;
#pragma unroll
            for (int k = 0; k < 4; ++k) { y0[k] *= sigmoidf_(y0[k]); y1[k] *= sigmoidf_(y1[k]); }
            *(u32x4*)(CAT + row * D + c0) = pk8(y0, y1);
            float fz[8], f1[8], f2[8], fg[8];
            unpack8(zz, fz); unpack8(z1, f1); unpack8(z2, f2); unpack8(gbv, fg);
            const f32x4 w00 = *(const LAS f32x4*)(pr + 1536), w01 = *(const LAS f32x4*)(pr + 1540), w10 = *(const LAS f32x4*)(pr + 2048), w11 = *(const LAS f32x4*)(pr + 2052), w20 = *(const LAS f32x4*)(pr + 2560), w21 = *(const LAS f32x4*)(pr + 2564);
            f32x4 o0, o1;
#pragma unroll
            for (int k = 0; k < 4; ++k) { o0[k] = fg[k] * (w00[k] * f2[k] + w10[k] * f1[k] + w20[k] * fz[k]); o1[k] = fg[4 + k] * (w01[k] * f2[4 + k] + w11[k] * f1[4 + k] + w21[k] * fz[4 + k]); }
            *(u32x4*)(CAT + row * D + MW + c0) = pk8(o0, o1);
        }
        if (!samp && (un & 63) == 63) {
            for (int i = wid; i < 30; i += 8) st8f(out + O_CAP + ((size_t)b * 30 + i) * MW + c0, *(const u32x4*)(A0 + (rowbase + 4066 + i) * MW + c0));
            if (wid < 2) st8f(out + O_CBP + ((size_t)b * 2 + wid) * MW + c0, *(const u32x4*)(Z0 + (rowbase + 4094 + wid) * MW + c0));
        }
        if (samp) {
            for (int i = wid; i < 30; i += 8) {
                float* dst = out + O_CAS + ((size_t)b * 30 + i) * MW + c0;
                if (i < 14) { const f32x4* s = (const f32x4*)(cache_a + ((size_t)b * 30 + 16 + i) * MW + c0); *(f32x4*)dst = s[0]; *(f32x4*)(dst + 4) = s[1]; }
                else st8f(dst, *(const u32x4*)(A0 + (rowbase + i - 14) * MW + c0));
            }
            if (wid < 2) st8f(out + O_CBS + ((size_t)b * 2 + wid) * MW + c0, *(const u32x4*)(Z0 + (rowbase + 14 + wid) * MW + c0));
        }
    }
    __syncthreads();
}

typedef short v4i16_t __attribute__((ext_vector_type(4)));
DI s16x4 tr_read(const LAS unsigned char* p) { return __builtin_bit_cast(s16x4, __builtin_amdgcn_ds_read_tr16_b64_v4i16((LAS v4i16_t*)p)); }
#define VFR(lo, hi) ((bf16x8){lo[0], lo[1], lo[2], lo[3], hi[0], hi[1], hi[2], hi[3]})
constexpr int KSTR = 272, VSTR = 320, AT_V = 64 * KSTR, AT_BUF = AT_V + 64 * VSTR, AT_B = 2 * AT_BUF;

template <bool SAMPLE>
DI void attn_load_tile(const Params& p, int b, int cp, int hp, int j, u32x4 (&kr)[2], u32x4 (&vr)[2]) {
    const int tid = threadIdx.x, chunk = tid & 15, k0 = tid >> 4;
    const bf16_t* Kb = (const bf16_t*)(p.ws + WS_A + SUB); const bf16_t* Vb = (const bf16_t*)(p.ws + WS_A + 2 * SUB);
#pragma unroll
    for (int i = 0; i < 2; ++i) {
        const int key = i * 32 + k0;
        if (!SAMPLE) {
            const size_t row = (size_t)b * SEQ + (size_t)(2 * cp - 8 + j) * 64 + key;
            kr[i] = *(const u32x4*)(Kb + row * MW + hp * 128 + chunk * 8);
            vr[i] = *(const u32x4*)(Vb + row * MW + hp * 128 + chunk * 8);
        } else {
            if (j < 8) {
                const size_t off = ((size_t)b * 512 + 64 * j + key) * 512 + hp * 128 + chunk * 8;
                const f32x4* ks = (const f32x4*)(p.in[4] + off); const f32x4* vs = (const f32x4*)(p.in[5] + off);
                kr[i] = pk8(ks[0], ks[1]); vr[i] = pk8(vs[0], vs[1]);
            } else if (key < 16) {
                const size_t row = (size_t)MP + b * 16 + key;
                kr[i] = *(const u32x4*)(Kb + row * MW + hp * 128 + chunk * 8);
                vr[i] = *(const u32x4*)(Vb + row * MW + hp * 128 + chunk * 8);
            } else { kr[i] = (u32x4){0u, 0u, 0u, 0u}; vr[i] = (u32x4){0u, 0u, 0u, 0u}; }
        }
    }
}
DI void attn_store_tile(LAS unsigned char* buf, const u32x4 (&kr)[2], const u32x4 (&vr)[2]) {
    const int tid = threadIdx.x, chunk = tid & 15, k0 = tid >> 4;
#pragma unroll
    for (int i = 0; i < 2; ++i) { const int key = i * 32 + k0;
        *(LAS u32x4*)(buf + key * KSTR + chunk * 16) = kr[i];
        *(LAS u32x4*)(buf + AT_V + key * VSTR + chunk * 16) = vr[i]; }
}

template <int BM, bool SMASK>
DI void attn_tile(const LAS unsigned char* kbase, const LAS unsigned char* vbase, const LAS float* bth, int ibase, int h, const bf16x8 (&qf)[4], f32x16& o0, f32x16& o1, float& lsum) {
#pragma unroll
    for (int kb = 0; kb < 2; ++kb) {
        f32x16 pa;
#pragma unroll
        for (int r = 0; r < 16; ++r) pa[r] = 0.f;
#pragma unroll
        for (int d0 = 0; d0 < 4; ++d0) { const bf16x8 a = *(const LAS bf16x8*)(kbase + kb * 32 * KSTR + d0 * 32); pa = __builtin_amdgcn_mfma_f32_32x32x16_bf16(a, qf[d0], pa, 0, 0, 0); }
        if (BM == 0) {
            const float cb = bth[512];
#pragma unroll
            for (int r = 0; r < 16; ++r) pa[r] += cb;
        } else if (BM == 1) {
#pragma unroll
            for (int r = 0; r < 16; ++r) { int idx = ibase - 32 * kb - ((r & 3) + 8 * (r >> 2)); idx = idx > 512 ? 512 : idx; pa[r] += bth[idx]; }
        } else {
            const LAS float* bp = bth + (ibase - 32 * kb - 27);
#pragma unroll
            for (int r = 0; r < 16; ++r) pa[r] += bp[27 - ((r & 3) + 8 * (r >> 2))];
        }
#pragma unroll
        for (int r = 0; r < 16; ++r) pa[r] = __builtin_amdgcn_exp2f(pa[r]);
        if (SMASK) {
#pragma unroll
            for (int r = 0; r < 16; ++r) { const int key = 32 * kb + (r & 3) + 8 * (r >> 2) + 4 * h; if (key >= 16) pa[r] = 0.f; }
        }
#pragma unroll
        for (int r = 0; r < 16; ++r) lsum += pa[r];
#pragma unroll
        for (int s = 0; s < 2; ++s) {
            u32x4 pw; pw.x = pk2(pa[8 * s], pa[8 * s + 1]); pw.y = pk2(pa[8 * s + 2], pa[8 * s + 3]); pw.z = pk2(pa[8 * s + 4], pa[8 * s + 5]); pw.w = pk2(pa[8 * s + 6], pa[8 * s + 7]);
            const bf16x8 pb = __builtin_bit_cast(bf16x8, pw);
            const LAS unsigned char* va = vbase + (kb * 32 + 16 * s) * VSTR;
            { const s16x4 lo = tr_read(va), hi = tr_read(va + 8 * VSTR); o0 = __builtin_amdgcn_mfma_f32_32x32x16_bf16(VFR(lo, hi), pb, o0, 0, 0, 0); }
            { const s16x4 lo = tr_read(va + 64), hi = tr_read(va + 64 + 8 * VSTR); o1 = __builtin_amdgcn_mfma_f32_32x32x16_bf16(VFR(lo, hi), pb, o1, 0, 0, 0); }
        }
    }
}

template <bool SAMPLE>
DI void attn_unit(const Params& p, LAS unsigned char* lds, int b, int cp, int hp) {
    int tid_ = threadIdx.x; asm volatile("" : "+v"(tid_));
    const int tid = tid_, lane = tid & 63, w = __builtin_amdgcn_readfirstlane(tid >> 6), r32 = lane & 31, h = lane >> 5;
    const int cl = SAMPLE ? 0 : (w >> 2), hl = (w >> 1) & 1, head = hp * 2 + hl, qoff = SAMPLE ? 0 : 32 * (w & 1);
    const bf16_t* Qb = (const bf16_t*)(p.ws + WS_A);
    bf16_t* CAT = (bf16_t*)(p.ws + WS_CAT);
    const size_t qrow = SAMPLE ? (size_t)MP + b * 16 + (r32 & 15) : (size_t)b * SEQ + (2 * cp + cl) * 64 + qoff + r32;
    bf16x8 qf[4];
#pragma unroll
    for (int d0 = 0; d0 < 4; ++d0) qf[d0] = *(const bf16x8*)(Qb + qrow * MW + head * 64 + d0 * 16 + h * 8);
    LAS float* bt = (LAS float*)(lds + AT_B);
    const int j_first = SAMPLE ? 0 : (cp >= 4 ? 0 : 8 - 2 * cp), j_last = SAMPLE ? 8 : 9;
    u32x4 ka[2], va_[2], kb_[2], vb_[2];
    attn_load_tile<SAMPLE>(p, b, cp, hp, j_first, ka, va_);
    __syncthreads();
    attn_store_tile(lds + (j_first & 1) * AT_BUF, ka, va_);
    attn_load_tile<SAMPLE>(p, b, cp, hp, j_first + 1, ka, va_);
    if (j_first + 2 <= j_last) attn_load_tile<SAMPLE>(p, b, cp, hp, j_first + 2, kb_, vb_);
    f32x16 o0, o1;
#pragma unroll
    for (int r = 0; r < 16; ++r) { o0[r] = 0.f; o1[r] = 0.f; }
    float lsum = 0.f;
    const int i16 = lane & 15, qd = i16 >> 2, pp = i16 & 3, g16 = (lane >> 4) & 1;
    const int koff = r32 * KSTR + hl * 128 + h * 16;
    const int voff = AT_V + (4 * h + qd) * VSTR + hl * 128 + (16 * g16 + 4 * pp) * 2;
    const LAS float* bth = bt + hl * 516;
#define ATT_STEP(j, KR, VR) do { \
        __syncthreads();                                        \
        if ((j) < j_last) { attn_store_tile(lds + (((j) + 1) & 1) * AT_BUF, KR, VR); if ((j) + 3 <= j_last) attn_load_tile<SAMPLE>(p, b, cp, hp, (j) + 3, KR, VR); } \
        const int t = (j) - cl; \
        if (t >= 0 && t <= 8) { \
            const LAS unsigned char* bufp = lds + ((j) & 1) * AT_BUF; \
            const int ibase = 768 - 64 * t + qoff + r32 - 4 * h; \
            if (t <= 3) attn_tile<0, false>(bufp + koff, bufp + voff, bth, ibase, h, qf, o0, o1, lsum); \
            else if (t == 4) attn_tile<1, false>(bufp + koff, bufp + voff, bth, ibase, h, qf, o0, o1, lsum); \
            else if (SAMPLE && t == 8) attn_tile<2, true>(bufp + koff, bufp + voff, bth, ibase, h, qf, o0, o1, lsum); \
            else attn_tile<2, false>(bufp + koff, bufp + voff, bth, ibase, h, qf, o0, o1, lsum); \
        } } while (0)
    for (int j = j_first; j <= j_last; j += 2) {
        ATT_STEP(j, ka, va_);
        if (j + 1 <= j_last) ATT_STEP(j + 1, kb_, vb_);
    }
#undef ATT_STEP
    lsum += __shfl_xor(lsum, 32);
    const float inv = 1.0f / lsum;
    const bool do_store = SAMPLE ? (w < 4 && (w & 1) == 0 && r32 < 16) : true;
    if (do_store) {
        bf16_t* dst = CAT + qrow * D + head * 64 + 4 * h;
#pragma unroll
        for (int gq = 0; gq < 4; ++gq) {
            *(u32x2*)(dst + 8 * gq) = (u32x2){pk2(o0[4 * gq] * inv, o0[4 * gq + 1] * inv), pk2(o0[4 * gq + 2] * inv, o0[4 * gq + 3] * inv)};
            *(u32x2*)(dst + 32 + 8 * gq) = (u32x2){pk2(o1[4 * gq] * inv, o1[4 * gq + 1] * inv), pk2(o1[4 * gq + 2] * inv, o1[4 * gq + 3] * inv)};
        }
    }
}

constexpr int SG_STR = 320, SG_LN = 49152;
struct SguRegs { f32x4 st[4]; u32x4 sv[4]; float bsv; };
DI void sgu_load(const Params& p, int uid, int tid, SguRegs& R) {
    const int b = uid >> 7, ch = (uid >> 2) & 31, g = uid & 3;
    const int lane = tid & 63, w = tid >> 6, r32 = lane & 31;
    const bf16_t* SVb = (const bf16_t*)(p.ws + WS_A + 4 * SUB);
    const float* SVST = (const float*)(p.ws + WS_SVST);
    const size_t r0 = (size_t)b * SEQ + ch * 128;
    const int srow = tid >> 2, qt = tid & 3;
    const f32x4* st = (const f32x4*)(SVST + (r0 + srow) * 16);
#pragma unroll
    for (int i = 0; i < 4; ++i) { R.st[i] = st[i]; R.sv[i] = *(const u32x4*)(SVb + (r0 + srow) * MW + g * 128 + qt * 32 + i * 8); }
    const int ib = w & 3, iloc = 32 * ib + r32;
    R.bsv = p.in[22][g * 128 + iloc];
}
DI void sgu_unit(const Params& p, LAS unsigned char* lds, int uid, int tid, const SguRegs& C, bool has_next, int uid_next, SguRegs& R) {
    const int b = uid >> 7, ch = (uid >> 2) & 31, g = uid & 3;
    const int lane = tid & 63, w = __builtin_amdgcn_readfirstlane(tid >> 6), r32 = lane & 31, h = lane >> 5;
    bf16_t* CAT = (bf16_t*)(p.ws + WS_CAT);
    const float* sw = p.in[21];
    const size_t r0 = (size_t)b * SEQ + ch * 128;
    const int ib = w & 3, dh = w >> 2, iloc = 32 * ib + r32;
    const size_t row = r0 + iloc;
    const float* Wrow = sw + ((size_t)g * 128 + iloc) * 128 + 8 * h;
    f32x4 wv[8][2];
#pragma unroll
    for (int js = 0; js < 8; ++js) { if (js <= 2 * ib + 1) { wv[js][0] = *(const f32x4*)(Wrow + 16 * js); wv[js][1] = *(const f32x4*)(Wrow + 16 * js + 4); } else { wv[js][0] = (f32x4){0.f, 0.f, 0.f, 0.f}; wv[js][1] = wv[js][0]; } }
    const bf16_t* Ub = (const bf16_t*)(p.ws + WS_A + 3 * SUB);
    u32x2 uu[2][4];
#pragma unroll
    for (int db = 0; db < 2; ++db)
#pragma unroll
        for (int gq = 0; gq < 4; ++gq) uu[db][gq] = *(const u32x2*)(Ub + row * MW + g * 128 + 64 * dh + 32 * db + 8 * gq + 4 * h);
    if (has_next) sgu_load(p, uid_next, tid, R);
    __syncthreads();
    {
        const int srow = tid >> 2, qt = tid & 3;
        const f32x4 a0 = C.st[0], a1 = C.st[1], a2 = C.st[2], a3 = C.st[3];
        const float s1 = (a0[0] + a0[2]) + (a1[0] + a1[2]) + (a2[0] + a2[2]) + (a3[0] + a3[2]);
        const float s2 = (a0[1] + a0[3]) + (a1[1] + a1[3]) + (a2[1] + a2[3]) + (a3[1] + a3[3]);
        const float mean = s1 * (1.0f / 512.0f), var = s2 * (1.0f / 512.0f) - mean * mean, rstd = rsqrtf(fmaxf(var, 0.f) + 1e-5f);
        const LAS float* lnp = (const LAS float*)(lds + SG_LN);
#pragma unroll
        for (int i = 0; i < 4; ++i) {
            const int c8 = qt * 32 + i * 8, ca = g * 128 + c8;
            float f[8]; unpack8(C.sv[i], f);
            const f32x4 g0 = *(const LAS f32x4*)(lnp + ca), g1 = *(const LAS f32x4*)(lnp + ca + 4), b0 = *(const LAS f32x4*)(lnp + 512 + ca), b1 = *(const LAS f32x4*)(lnp + 512 + ca + 4);
            f32x4 x0, x1;
#pragma unroll
            for (int k = 0; k < 4; ++k) { x0[k] = (f[k] - mean) * rstd * g0[k] + b0[k]; x1[k] = (f[4 + k] - mean) * rstd * g1[k] + b1[k]; }
            *(LAS u32x4*)(lds + srow * SG_STR + c8 * 2) = pk8(x0, x1);
        }
    }
    __syncthreads();
    const int i16 = lane & 15, qd = i16 >> 2, pp = i16 & 3, g16 = (lane >> 4) & 1;
    f32x16 acc0, acc1;
#pragma unroll
    for (int r = 0; r < 16; ++r) { acc0[r] = 0.f; acc1[r] = 0.f; }
    const LAS unsigned char* vb = lds + (8 * h + qd) * SG_STR + (64 * dh + 16 * g16 + 4 * pp) * 2;
#pragma unroll
    for (int js = 0; js < 8; ++js) {
        if (js <= 2 * ib + 1) {
            const int jb = 16 * js + 8 * h;
            f32x4 w0 = wv[js][0], w1 = wv[js][1];
#pragma unroll
            for (int k = 0; k < 4; ++k) { w0[k] = (jb + k <= iloc) ? w0[k] : 0.f; w1[k] = (jb + 4 + k <= iloc) ? w1[k] : 0.f; }
            const bf16x8 bw = __builtin_bit_cast(bf16x8, pk8(w0, w1));
            const LAS unsigned char* va = vb + js * 16 * SG_STR;
            { const s16x4 lo = tr_read(va), hi = tr_read(va + 4 * SG_STR); acc0 = __builtin_amdgcn_mfma_f32_32x32x16_bf16(VFR(lo, hi), bw, acc0, 0, 0, 0); }
            { const s16x4 lo = tr_read(va + 64), hi = tr_read(va + 64 + 4 * SG_STR); acc1 = __builtin_amdgcn_mfma_f32_32x32x16_bf16(VFR(lo, hi), bw, acc1, 0, 0, 0); }
        }
    }
    const float bsv = C.bsv;
#pragma unroll
    for (int gq = 0; gq < 4; ++gq) {
        const int d4 = 64 * dh + 8 * gq + 4 * h;
        { const u32x2 u2 = uu[0][gq];
          *(u32x2*)(CAT + row * D + MW + g * 128 + d4) = (u32x2){pk2(bflo(u2.x) * (acc0[4 * gq] + bsv), bfhi(u2.x) * (acc0[4 * gq + 1] + bsv)), pk2(bflo(u2.y) * (acc0[4 * gq + 2] + bsv), bfhi(u2.y) * (acc0[4 * gq + 3] + bsv))}; }
        { const u32x2 u2 = uu[1][gq];
          *(u32x2*)(CAT + row * D + MW + g * 128 + d4 + 32) = (u32x2){pk2(bflo(u2.x) * (acc1[4 * gq] + bsv), bfhi(u2.x) * (acc1[4 * gq + 1] + bsv)), pk2(bflo(u2.y) * (acc1[4 * gq + 2] + bsv), bfhi(u2.y) * (acc1[4 * gq + 3] + bsv))}; }
    }
}
DI void sgu_all(const Params& p, LAS unsigned char* lds, int first, int stride) {
    int tid_ = threadIdx.x; asm volatile("" : "+v"(tid_));
    const int tid = tid_;
    __syncthreads();
    { LAS float* lnp = (LAS float*)(lds + SG_LN); lnp[tid] = p.in[19][tid]; lnp[512 + tid] = p.in[20][tid]; }
    if (first >= 1024) { __syncthreads(); return; }
    SguRegs R; sgu_load(p, first, tid, R);
    for (int uid = first; uid < 1024; uid += stride) {
        const SguRegs C = R;
        sgu_unit(p, lds, uid, tid, C, uid + stride < 1024, uid + stride, R);
    }
    __syncthreads();
}

DI void sgu_sample_unit(const Params& p, LAS unsigned char* lds, int b) {
    int tid_ = threadIdx.x; asm volatile("" : "+v"(tid_));
    const int tid = tid_, lane = tid & 63, wid = tid >> 6;
    const bf16_t* Ub = (const bf16_t*)(p.ws + WS_A + 3 * SUB); const bf16_t* SVb = (const bf16_t*)(p.ws + WS_A + 4 * SUB);
    bf16_t* CAT = (bf16_t*)(p.ws + WS_CAT);
    const float* lng = p.in[19]; const float* lnb = p.in[20]; const float* sw = p.in[21]; const float* sb = p.in[22];
    LAS float* vn = (LAS float*)lds;
    const size_t r0 = (size_t)MP + b * 16;
    __syncthreads();
    for (int i = wid; i < 16; i += 8) {
        const int c0 = lane * 8;
        float f[8]; unpack8(*(const u32x4*)(SVb + (r0 + i) * MW + c0), f);
        float s = 0.f;
#pragma unroll
        for (int k = 0; k < 8; ++k) s += f[k];
        const float mean = wave_sum(s) * (1.0f / 512.0f);
        float q = 0.f;
#pragma unroll
        for (int k = 0; k < 8; ++k) { f[k] -= mean; q += f[k] * f[k]; }
        const float rstd = rsqrtf(wave_sum(q) * (1.0f / 512.0f) + 1e-5f);
        float* dst = p.out + O_SVS + ((size_t)b * 16 + i) * MW + c0;
#pragma unroll
        for (int k = 0; k < 8; ++k) { const float y = f[k] * rstd * lng[c0 + k] + lnb[c0 + k]; vn[i * 512 + c0 + k] = y; dst[k] = y; }
    }
    LAS float* wl = (LAS float*)(lds + 32768); LAS float* bl = wl + 1024;
    for (int i = tid; i < 1024; i += 512) wl[i] = sw[((size_t)(i >> 8) * 128 + ((i >> 4) & 15)) * 128 + (i & 15)];
    if (tid < 64) bl[tid] = sb[(tid >> 4) * 128 + (tid & 15)];
    const int cch = tid, g = cch >> 7;
    float uvv[16];
#pragma unroll
    for (int i = 0; i < 16; ++i) uvv[i] = bflo((unsigned)Ub[(r0 + i) * MW + cch]);
    __syncthreads();
    {
        float vv[16];
#pragma unroll
        for (int j = 0; j < 16; ++j) vv[j] = vn[j * 512 + cch];
#pragma unroll
        for (int i = 0; i < 16; ++i) {
            float s = bl[g * 16 + i];
#pragma unroll
            for (int j = 0; j <= i; ++j) s += wl[g * 256 + i * 16 + j] * vv[j];
            const unsigned o = pk2(uvv[i] * s, 0.f);
            CAT[(r0 + i) * D + MW + cch] = (bf16_t)(o & 0xffffu);
        }
    }
}

DI void phase_mix_odd(const Params& p, LAS unsigned char* lds) {
    const int blk = blockIdx.x;
    if (gridDim.x == 256) {
        {
            LAS float* bt = (LAS float*)(lds + AT_B); const float* relb = p.in[18]; const int hp = blk & 3;
            __syncthreads();
            for (int i = threadIdx.x; i < 2 * 513; i += 512) { const int hh = i >= 513 ? 1 : 0, j = i - hh * 513; bt[hh * 516 + j] = relb[(hp * 2 + hh) * 513 + j] * LOG2E; }
        }
        if (blk < 32) attn_unit<true>(p, lds, blk >> 2, 0, blk & 3);
        for (int uid = blk; uid < 1024; uid += 256) attn_unit<false>(p, lds, (uid & 31) >> 2, uid >> 5, uid & 3);
        if (blk >= 32 && blk < 40) sgu_sample_unit(p, lds, blk - 32);
        sgu_all(p, lds, blk, 256);
    } else {
        for (int uid = blk; uid < 1056; uid += gridDim.x) {
            { LAS float* bt = (LAS float*)(lds + AT_B); const float* relb = p.in[18]; const int hp = uid & 3;
              __syncthreads();
              for (int i = threadIdx.x; i < 2 * 513; i += 512) { const int hh = i >= 513 ? 1 : 0, j = i - hh * 513; bt[hh * 516 + j] = relb[(hp * 2 + hh) * 513 + j] * LOG2E; } }
            if (uid < 1024) attn_unit<false>(p, lds, (uid & 31) >> 2, uid >> 5, uid & 3);
            else { const int s_ = uid - 1024; attn_unit<true>(p, lds, s_ >> 2, 0, s_ & 3); }
        }
        sgu_all(p, lds, blk, gridDim.x);
        for (int uid = 1024 + blk; uid < 1032; uid += gridDim.x) sgu_sample_unit(p, lds, uid - 1024);
    }
    __syncthreads();
}

#define XB_TMO      128
#define XB_XCNT(j)  (256  + 64 * (j))
#define XB_XSUB(j)  (1280 + 64 * (j))
#define XB_XGEN(j)  (2304 + 64 * (j))
#define XB_TOP      3328
#define XB_TOPGEN   3392
#define XCD_BAR_WORDS 3456
#define XB_SPIN_CAP (1u << 18)
DI unsigned xb_ld(unsigned* p)              { return __hip_atomic_load(p, __ATOMIC_RELAXED, __HIP_MEMORY_SCOPE_AGENT); }
DI unsigned xb_add(unsigned* p, unsigned v) { return __hip_atomic_fetch_add(p, v, __ATOMIC_RELAXED, __HIP_MEMORY_SCOPE_AGENT); }
DI unsigned xb_xcc_id() { return (unsigned)__builtin_amdgcn_s_getreg((3 << 11) | 20) & 0xFu; }
#define XB_SPIN(cond, bar) do { unsigned _sp = 0; while (cond) { __builtin_amdgcn_s_sleep(1); \
    if ((++_sp & 255u) == 0u) { if (xb_ld(&(bar)[XB_TMO])) break; if (_sp > XB_SPIN_CAP) { atomicAdd(&(bar)[XB_TMO], 1u); break; } } } } while (0)
struct XcdBarrier { unsigned* bar; unsigned x; volatile LAS unsigned* st; };
DI XcdBarrier xcd_barrier_post(unsigned* bar, volatile LAS unsigned* st) {
    XcdBarrier b; b.bar = bar; b.x = xb_xcc_id(); b.st = st;
    if (threadIdx.x == 0) (void)xb_add(&bar[XB_XCNT(b.x)], 1u);
    return b;
}
DI void xcd_barrier_complete(unsigned* bar, unsigned x, unsigned& nloc, unsigned& nx) {
    const unsigned G = gridDim.x * gridDim.y * gridDim.z;
    unsigned sum, cnt, mine, sp = 0u;
    for (;;) {
        sum = 0u; cnt = 0u; mine = 0u;
#pragma unroll
        for (unsigned j = 0; j < 16; ++j) { const unsigned c = xb_ld(&bar[XB_XCNT(j)]); sum += c; cnt += (c > 0u) ? 1u : 0u; mine = (j == x) ? c : mine; }
        if (sum == G) break;
        __builtin_amdgcn_s_sleep(1);
        if ((++sp & 255u) == 0u) { if (xb_ld(&bar[XB_TMO])) break; if (sp > XB_SPIN_CAP) { atomicAdd(&bar[XB_TMO], 1u); break; } }
    }
    nloc = mine > 0u ? mine : 1u; nx = cnt > 0u ? cnt : 1u;
}
DI void xcd_barrier(const XcdBarrier& b) {
    asm volatile("s_waitcnt vmcnt(0)" ::: "memory");
    __syncthreads();
    if (threadIdx.x == 0) {
        unsigned* bar = b.bar;
        __builtin_amdgcn_s_waitcnt(0);
        unsigned nloc = b.st[0], nx = b.st[1];
        if (nloc == 0u) { xcd_barrier_complete(bar, b.x, nloc, nx); b.st[0] = nloc; b.st[1] = nx; }
        const unsigned old = xb_add(&bar[XB_XSUB(b.x)], 1u);
        const unsigned gen = old / nloc;
        if (old + 1u == (gen + 1u) * nloc) {
            __builtin_amdgcn_fence(__ATOMIC_RELEASE, "agent");
            asm volatile("s_waitcnt vmcnt(0)" ::: "memory");
            const unsigned og = xb_add(&bar[XB_TOP], 1u);
            const unsigned tg = og / nx;
            if (og + 1u == (tg + 1u) * nx) xb_add(&bar[XB_TOPGEN], 1u);
            else XB_SPIN(xb_ld(&bar[XB_TOPGEN]) == tg, bar);
            __builtin_amdgcn_fence(__ATOMIC_ACQUIRE, "agent");
            xb_add(&bar[XB_XGEN(b.x)], 1u);
            asm volatile("s_waitcnt vmcnt(0)" ::: "memory");
        } else {
            XB_SPIN(xb_ld(&bar[XB_XGEN(b.x)]) == gen, bar);
            __builtin_amdgcn_fence(__ATOMIC_ACQUIRE, "agent");
            asm volatile("s_waitcnt vmcnt(0)" ::: "memory");
        }
    }
    __syncthreads();
}

__global__ void __launch_bounds__(512, 2) fwd_kernel(Params p) {
    extern __shared__ __attribute__((aligned(16))) unsigned char lds_raw[];
    LAS unsigned char* lds = (LAS unsigned char*)lds_raw;
    const int lo = p.ph_lo, hi = p.ph_hi;
    unsigned char* ws = p.ws;
    bf16_t* XN = (bf16_t*)(ws + WS_XN); bf16_t* CAT = (bf16_t*)(ws + WS_CAT); bf16_t* HID = (bf16_t*)(ws + WS_HID);
    bf16_t* AREG = (bf16_t*)(ws + WS_A);
    float* SS = (float*)(ws + WS_SS); float* SVST = (float*)(ws + WS_SVST);
    float* out = p.out;
    const int G = gridDim.x, cid = blockIdx.x;
    volatile LAS unsigned* bst = (volatile LAS unsigned*)(lds + LDS_BYTES - 64);
    XcdBarrier xbar; xbar.bar = (unsigned*)ws; xbar.x = 0; xbar.st = bst;
    if (hi - lo > 1) {
        if (threadIdx.x < 16) bst[threadIdx.x] = 0u;
        __syncthreads();
        xbar = xcd_barrier_post((unsigned*)ws, bst);
    }
#ifndef PHASE_MASK
#define PHASE_MASK 0x7ff
#endif
#define IN(k) (((PHASE_MASK >> (k)) & 1) && lo <= (k) && (k) < hi)
#ifndef PROBE_DUP
#define PROBE_DUP 0
#endif
#define REPS(k) for (int rep_ = 0; rep_ < ((((PROBE_DUP) >> (k)) & 1) ? 2 : 1); ++rep_)
#define RSYNC() do { if (rep_) cg::this_grid().sync(); } while (0)
#define SEAM(k) do { if (IN(k) && IN((k) + 1)) { xcd_barrier(xbar); } } while (0)
    if (hi > 64) cg::this_grid().sync();
    if (IN(0)) REPS(0) { RSYNC(); phase_prologue(p, lds); __syncthreads(); }
    SEAM(0);
    if (IN(1)) REPS(1) {   RSYNC();
        pg8::Gemm g{XN, (const bf16_t*)(ws + WS_WIN0), MP, PW, D}; pg8::StaticOrder S; S.init(MP, PW, G, cid);
        EpiInEven E{SS + 0 * MT, AREG, (bf16_t*)(ws + WS_A + SUB), (bf16_t*)(ws + WS_A + 2 * SUB)};
        pg8::gemm_phase<EpiInEven, true>(lds, g, S, E);
        SEpiInEven ES{SS + 0 * MT, AREG, (bf16_t*)(ws + WS_A + SUB), (bf16_t*)(ws + WS_A + 2 * SUB)};
        sample_gemm(lds, XN, (const bf16_t*)(ws + WS_WIN0), PW / 256, D, ES);
    }
    SEAM(1);
    if (IN(2)) REPS(2) { RSYNC(); phase_conv(p, lds); }
    SEAM(2);
    if (IN(3)) REPS(3) {   RSYNC();
        pg8::Gemm g{CAT, (const bf16_t*)(ws + WS_WOUT0), MP, D, D}; pg8::StaticOrder S; S.init(MP, D, G, cid);
        EpiResid<0> E{p.in[0], out, XN, SS + 1 * MT};
        pg8::gemm_phase<EpiResid<0>, true>(lds, g, S, E);
        SEpiResid<0> ES{p.in[1] - (size_t)MP * D, out, XN, SS + 1 * MT};
        sample_gemm(lds, CAT, (const bf16_t*)(ws + WS_WOUT0), D / 256, D, ES);
    }
    SEAM(3);
    if (IN(4)) REPS(4) {   RSYNC();
        pg8::Gemm g{XN, (const bf16_t*)(ws + WS_WGU0), MP, 2 * FH, D}; pg8::StaticOrder S; S.init(MP, 2 * FH, G, cid);
        EpiGateUp E{SS + 1 * MT, HID};
        pg8::gemm_phase<EpiGateUp, true>(lds, g, S, E);
        SEpiGateUp ES{SS + 1 * MT, HID};
        sample_gemm(lds, XN, (const bf16_t*)(ws + WS_WGU0), 2 * FH / 256, D, ES);
    }
    SEAM(4);
    if (IN(5)) {
        pg8::Gemm g{HID, (const bf16_t*)(ws + WS_WDN0), MP, D, FH}; pg8::StaticOrder S; S.init(MP, D, G, cid);
        EpiResid<1> E{nullptr, out, XN, SS + 2 * MT};
        pg8::gemm_phase<EpiResid<1>, true>(lds, g, S, E);
        SEpiResid<1> ES{nullptr, out, XN, SS + 2 * MT};
        sample_gemm(lds, HID, (const bf16_t*)(ws + WS_WDN0), D / 256, FH, ES);
    }
    SEAM(5);
    if (IN(6)) REPS(6) {   RSYNC();
        pg8::Gemm g{XN, (const bf16_t*)(ws + WS_WIN1), MP, PW, D}; pg8::StaticOrder S; S.init(MP, PW, G, cid);
        EpiInOdd E{SS + 2 * MT, AREG, p.in[16], p.in[17], SVST, out};
        pg8::gemm_phase<EpiInOdd, true>(lds, g, S, E);
        SEpiInOdd ES{SS + 2 * MT, AREG, p.in[16], p.in[17], SVST, out};
        sample_gemm(lds, XN, (const bf16_t*)(ws + WS_WIN1), PW / 256, D, ES);
    }
    SEAM(6);
    if (IN(7)) REPS(7) { RSYNC(); phase_mix_odd(p, lds); }
    SEAM(7);
    if (IN(8)) {
        pg8::Gemm g{CAT, (const bf16_t*)(ws + WS_WOUT1), MP, D, D}; pg8::StaticOrder S; S.init(MP, D, G, cid);
        EpiResid<1> E{nullptr, out, XN, SS + 3 * MT};
        pg8::gemm_phase<EpiResid<1>, true>(lds, g, S, E);
        SEpiResid<1> ES{nullptr, out, XN, SS + 3 * MT};
        sample_gemm(lds, CAT, (const bf16_t*)(ws + WS_WOUT1), D / 256, D, ES);
    }
    SEAM(8);
    if (IN(9)) REPS(9) {   RSYNC();
        pg8::Gemm g{XN, (const bf16_t*)(ws + WS_WGU1), MP, 2 * FH, D}; pg8::StaticOrder S; S.init(MP, 2 * FH, G, cid);
        EpiGateUp E{SS + 3 * MT, HID};
        pg8::gemm_phase<EpiGateUp, true>(lds, g, S, E);
        SEpiGateUp ES{SS + 3 * MT, HID};
        sample_gemm(lds, XN, (const bf16_t*)(ws + WS_WGU1), 2 * FH / 256, D, ES);
    }
    SEAM(9);
    if (IN(10)) {
        pg8::Gemm g{HID, (const bf16_t*)(ws + WS_WDN1), MP, D, FH}; pg8::StaticOrder S; S.init(MP, D, G, cid);
        EpiResid<2> E{nullptr, out, XN, SS};
        pg8::gemm_phase<EpiResid<2>, true>(lds, g, S, E);
        SEpiResid<2> ES{nullptr, out, XN, SS};
        sample_gemm(lds, HID, (const bf16_t*)(ws + WS_WDN1), D / 256, FH, ES);
    }
#undef IN
#undef SEAM
}

constexpr int N_PHASES = 11;

extern "C" void kernel_launch(void* const* d_in, const int* in_sizes, int n_in, void* d_out, int out_size, void* d_ws, size_t ws_size, hipStream_t stream) {
    static int grid = 0;
    if (grid == 0) {
        if (n_in != 27 || ws_size < WS_END) { fprintf(stderr, "kernel_launch: unexpected n_in %d / ws %zu\n", n_in, ws_size); grid = -1; return; }
        int dev = 0, cus = 0, per_cu = 0;
        hipGetDevice(&dev);
        hipDeviceGetAttribute(&cus, hipDeviceAttributeMultiprocessorCount, dev);
        if (hipFuncSetAttribute((const void*)fwd_kernel, hipFuncAttributeMaxDynamicSharedMemorySize, LDS_BYTES) != hipSuccess) { fprintf(stderr, "kernel_launch: hipFuncSetAttribute failed\n"); grid = -1; return; }
        if (hipOccupancyMaxActiveBlocksPerMultiprocessor(&per_cu, (const void*)fwd_kernel, 512, LDS_BYTES) != hipSuccess || per_cu < 1) { fprintf(stderr, "kernel_launch: occupancy query says %d\n", per_cu); per_cu = 1; }
        (void)hipGetLastError();
        grid = cus;
    }
    if (grid < 0) return;
    Params a{};
    for (int i = 0; i < 27; ++i) a.in[i] = (const float*)d_in[i];
    a.out = (float*)d_out; a.ws = (unsigned char*)d_ws;
#if MK_ONE_LAUNCH
    if (hipMemsetAsync(d_ws, 0, 16384, stream) != hipSuccess) { fprintf(stderr, "kernel_launch: memset failed\n"); return; }
    a.ph_lo = 0; a.ph_hi = N_PHASES;
    void* args[] = {&a};
    hipError_t e = hipLaunchCooperativeKernel((const void*)fwd_kernel, dim3(grid), dim3(512), args, LDS_BYTES, stream);
    if (e != hipSuccess) fprintf(stderr, "cooperative launch failed: %s (grid %d)\n", hipGetErrorString(e), grid);
#else
    for (int ph = 0; ph < N_PHASES; ++ph) {
        a.ph_lo = ph; a.ph_hi = ph + 1;
        hipLaunchKernelGGL(fwd_kernel, dim3(grid), dim3(512), LDS_BYTES, stream, a);
    }
#endif
}
```

```cpp
#include <hip/hip_runtime.h>
#include <hip/hip_cooperative_groups.h>
#include <cstdio>
#include <cstdint>
namespace cg = cooperative_groups;

#ifndef MK_ONE_LAUNCH
#define MK_ONE_LAUNCH 1
#endif

#define LAS __attribute__((address_space(3)))
typedef unsigned short bf16_t;
typedef short bf16x8 __attribute__((ext_vector_type(8)));
typedef short s16x4 __attribute__((ext_vector_type(4)));
typedef float f32x4 __attribute__((ext_vector_type(4)));
typedef float f32x2 __attribute__((ext_vector_type(2)));
typedef float f32x16 __attribute__((ext_vector_type(16)));
typedef unsigned u32x4 __attribute__((ext_vector_type(4)));
typedef unsigned u32x2 __attribute__((ext_vector_type(2)));
typedef __bf16 bf16x2_t __attribute__((ext_vector_type(2)));

#define DI __device__ __forceinline__

constexpr int D = 1024, MP = 32768, MS = 128, MREAL = MP + MS, MT = 33024;
constexpr int SEQ = 4096, NB = 8, DSEQ = 16;
constexpr int MW = 512, PW = 2560, FH = 2816;
constexpr float LOG2E = 1.4426950408889634f;
constexpr float QSCALE = 0.125f * LOG2E;

constexpr size_t O_Y = 0;
constexpr size_t O_CAP = 33685504, O_CBP = 33808384, O_KP = 33816576, O_VP = 35913728;
constexpr size_t O_CAS = 38010880, O_CBS = 38133760, O_KS = 38141952, O_VS = 38207488, O_SVS = 38273024;

constexpr size_t MiB = 1u << 20;
constexpr size_t WS_SS = 1 * MiB;
constexpr size_t WS_SVST = 4 * MiB;
constexpr size_t WS_WIN0 = 8 * MiB, WS_WOUT0 = 13 * MiB, WS_WGU0 = 15 * MiB, WS_WDN0 = 26 * MiB;
constexpr size_t WS_WIN1 = 32 * MiB, WS_WOUT1 = 37 * MiB, WS_WGU1 = 39 * MiB, WS_WDN1 = 50 * MiB;
constexpr size_t WS_XN = 56 * MiB;
constexpr size_t WS_A = 122 * MiB;
constexpr size_t SUB = (size_t)MT * MW * 2;
constexpr size_t WS_CAT = 284 * MiB;
constexpr size_t WS_HID = 122 * MiB;
constexpr size_t WS_END = 349 * MiB;

constexpr int LDS_BYTES = 163840;

DI unsigned pk2(float lo, float hi) { f32x2 v = {lo, hi}; bf16x2_t b = __builtin_convertvector(v, bf16x2_t); return __builtin_bit_cast(unsigned, b); }
DI float bflo(unsigned u) { return __uint_as_float(u << 16); }
DI float bfhi(unsigned u) { return __uint_as_float(u & 0xffff0000u); }
DI u32x4 pk8(f32x4 a, f32x4 b) { u32x4 w; w.x = pk2(a[0], a[1]); w.y = pk2(a[2], a[3]); w.z = pk2(b[0], b[1]); w.w = pk2(b[2], b[3]); return w; }
DI void unpack8(const u32x4 w, float (&f)[8]) { f[0] = bflo(w.x); f[1] = bfhi(w.x); f[2] = bflo(w.y); f[3] = bfhi(w.y); f[4] = bflo(w.z); f[5] = bfhi(w.z); f[6] = bflo(w.w); f[7] = bfhi(w.w); }
DI float sigmoidf_(float x) { return __builtin_amdgcn_rcpf(1.0f + __expf(-x)); }
DI float wave_sum(float v) {
#pragma unroll
    for (int o = 1; o < 64; o <<= 1) v += __shfl_xor(v, o);
    return v;
}

namespace pg8 {
constexpr int BM = 256, BK = 64, HALF = 128, HTB = HALF * BK * 2, STAGE_BYTES = 8 * HTB, NXCD = 8, WGM = 8;
__host__ __device__ __forceinline__ int lds_byte(int r, int c) { const int st = (r >> 4) * 2 + (c >> 5), rr = r & 15, cc = c & 31, ob = rr * 64 + cc * 2; return st * 1024 + (ob ^ (((ob >> 9) & 1) << 5)); }
__host__ __device__ __forceinline__ void stage_rc(int b, int& R, int& C) { const int st = b / 1024, sb = b % 1024, swz = sb ^ (((sb >> 9) & 1) << 5); R = (st >> 1) * 16 + swz / 64; C = (st & 1) * 32 + (swz % 64) / 2; }
__host__ __device__ __forceinline__ int perm32(int rho) { const int n = rho >> 4, i = rho & 15; return 8 * (i >> 2) + 4 * n + (i & 3); }

struct Unit { int pm, pn; };
struct Gemm { const bf16_t* A; const bf16_t* Bt; int M, N, K; };

struct StaticOrder {
    int nM, nN, nwg, G, c;
    __device__ void init(int M, int N, int G_, int c_) { nM = M / BM; nN = N / BM; nwg = nM * nN; G = G_; c = c_; }
    __device__ bool next(int i, Unit& u) const {
        const long L = (long)i * G + c; if (L >= nwg) return false;
        int wgid = (int)L; { const int q = nwg / NXCD, r = nwg % NXCD, xcd = wgid % NXCD, off = wgid / NXCD; wgid = (xcd < r ? xcd * (q + 1) : r * (q + 1) + (xcd - r) * q) + off; }
        const int nig = WGM * nN, gid = wgid / nig, fm = gid * WGM, gsz = (nM - fm) < WGM ? (nM - fm) : WGM;
        u.pm = fm + ((wgid % nig) % gsz); u.pn = (wgid % nig) / gsz; return true;
    }
};

template <class Epi, bool ALIGN_EPI>
__device__ __forceinline__ void gemm_phase(LAS unsigned char* lds, const Gemm g, const StaticOrder& S, const Epi& E) {
    const int tid = threadIdx.x, wid = __builtin_amdgcn_readfirstlane(tid >> 6), lane = tid & 63, wr = wid >> 2, wc = wid & 3, fr = lane & 15, fq = lane >> 4;
    const int K = g.K, nt = K / BK;
    unsigned voffA[2], voffB[2];
#pragma unroll
    for (int i = 0; i < 2; ++i) { int R, C; stage_rc(tid * 16 + i * 8192, R, C); const int Rb = Epi::PERM ? ((R & ~31) + perm32(R & 31)) : R;
        voffA[i] = (unsigned)(R * K + C) * 2u; voffB[i] = (unsigned)(Rb * K + C) * 2u; }
    const size_t kstep = (size_t)(BK * 2);
    const size_t hstep = (size_t)HALF * K * 2;
    const size_t tstep = 2 * hstep;
    const unsigned ldsw = (unsigned)wid * 1024u;
    const int aoff = lds_byte(wr * 64 + fr, fq * 8), boff = lds_byte(wc * 32 + fr, fq * 8);
#define PG8_SA(b, h) (((b) * 2 + (h)) * HTB)
#define PG8_SB(b, h) ((4 + (b) * 2 + (h)) * HTB)
#define PG8_STAGE(bufoff, gbase, voff) do { _Pragma("unroll") for (int _i = 0; _i < 2; ++_i) \
        __builtin_amdgcn_global_load_lds((const unsigned*)((const char*)(gbase) + (voff)[_i]), (LAS unsigned*)(lds + (bufoff) + ldsw + _i * 8192), 16, 0, 0); } while (0)
#define PG8_LDA(dst, b, h) do { _Pragma("unroll") for (int m = 0; m < 4; ++m) _Pragma("unroll") for (int k = 0; k < 2; ++k) dst[m][k] = *(const LAS bf16x8*)(lds + PG8_SA(b, h) + aoff + m * 2048 + k * 1024); } while (0)
#define PG8_LDB(dst, b, h) do { _Pragma("unroll") for (int n = 0; n < 2; ++n) _Pragma("unroll") for (int k = 0; k < 2; ++k) dst[n][k] = *(const LAS bf16x8*)(lds + PG8_SB(b, h) + boff + n * 2048 + k * 1024); } while (0)
#define PG8_MMA(ai, bj, At, Bt) do { __builtin_amdgcn_s_setprio(1); _Pragma("unroll") for (int m = 0; m < 4; ++m) _Pragma("unroll") for (int n = 0; n < 2; ++n) _Pragma("unroll") for (int k = 0; k < 2; ++k) \
        acc[ai][bj][m][n] = __builtin_amdgcn_mfma_f32_16x16x32_bf16(Bt[n][k], At[m][k], acc[ai][bj][m][n], 0, 0, 0); __builtin_amdgcn_s_setprio(0); } while (0)
#define PG8_WAIT_V(n) asm volatile("s_waitcnt vmcnt(" #n ")" ::: "memory")
#define PG8_WAIT_L(n) asm volatile("s_waitcnt lgkmcnt(" #n ")" ::: "memory")
#define PG8_BAR __builtin_amdgcn_s_barrier()
#define PG8_SCHED __builtin_amdgcn_sched_barrier(0)
    Unit cur, nxt; int ui = 0;
    if (!S.next(0, cur)) return;
    f32x4 acc[2][2][4][2];
#pragma unroll
    for (int a = 0; a < 2; ++a)
#pragma unroll
        for (int b = 0; b < 2; ++b)
#pragma unroll
            for (int m = 0; m < 4; ++m)
#pragma unroll
                for (int n = 0; n < 2; ++n) acc[a][b][m][n] = (f32x4){0.f, 0.f, 0.f, 0.f};
    bf16x8 At[4][2], B0[2][2], B1[2][2];
    const char* cA = (const char*)g.A + (size_t)cur.pm * tstep; const char* cB = (const char*)g.Bt + (size_t)cur.pn * tstep;
    PG8_STAGE(PG8_SB(0, 0), cB, voffB); PG8_STAGE(PG8_SB(0, 1), cB + hstep, voffB); PG8_STAGE(PG8_SA(0, 0), cA, voffA); PG8_STAGE(PG8_SA(0, 1), cA + hstep, voffA);
    if (wr == 1) PG8_BAR;
    PG8_WAIT_V(2); PG8_BAR;
    PG8_STAGE(PG8_SB(1, 0), cB + kstep, voffB); PG8_STAGE(PG8_SA(1, 0), cA + kstep, voffA); PG8_STAGE(PG8_SB(1, 1), cB + hstep + kstep, voffB);
    PG8_WAIT_V(6); PG8_BAR;
    for (;;) {
        const bool has_next = S.next(ui + 1, nxt);
        const char* nA = has_next ? (const char*)g.A + (size_t)nxt.pm * tstep : cA; const char* nB = has_next ? (const char*)g.Bt + (size_t)nxt.pn * tstep : cB;
        for (int t = 0; t < nt; t += 2) {
            const bool last = (t == nt - 2);
            const char* a1 = cA + (size_t)(t + 1) * kstep;
            const char* a2 = last ? nA : cA + (size_t)(t + 2) * kstep; const char* b2 = last ? nB : cB + (size_t)(t + 2) * kstep;
            const char* a3 = a2 + kstep; const char* b3 = b2 + kstep;
            PG8_LDB(B0, 0, 0); PG8_LDB(B1, 0, 1); PG8_SCHED; PG8_LDA(At, 0, 0); PG8_STAGE(PG8_SA(1, 1), a1 + hstep, voffA);
            PG8_WAIT_V(8); PG8_WAIT_L(0); PG8_BAR; PG8_MMA(0, 0, At, B0); PG8_MMA(0, 1, At, B1); PG8_BAR; PG8_SCHED;
            PG8_LDA(At, 0, 1); PG8_STAGE(PG8_SB(0, 0), b2, voffB); PG8_STAGE(PG8_SB(0, 1), b2 + hstep, voffB); PG8_STAGE(PG8_SA(0, 0), a2, voffA);
            PG8_WAIT_V(8); PG8_WAIT_L(0); PG8_BAR; PG8_MMA(1, 0, At, B0); PG8_MMA(1, 1, At, B1); PG8_BAR; PG8_SCHED;
            PG8_LDB(B0, 1, 0); PG8_LDB(B1, 1, 1); PG8_SCHED; PG8_LDA(At, 1, 0); PG8_STAGE(PG8_SA(0, 1), a2 + hstep, voffA);
            PG8_WAIT_V(8); PG8_WAIT_L(0); PG8_BAR; PG8_MMA(0, 0, At, B0); PG8_MMA(0, 1, At, B1); PG8_BAR; PG8_SCHED;
            PG8_LDA(At, 1, 1); PG8_STAGE(PG8_SB(1, 0), b3, voffB); PG8_STAGE(PG8_SB(1, 1), b3 + hstep, voffB); PG8_STAGE(PG8_SA(1, 0), a3, voffA);
            PG8_WAIT_V(8); PG8_WAIT_L(0); PG8_BAR; PG8_MMA(1, 0, At, B0); PG8_MMA(1, 1, At, B1); PG8_BAR; PG8_SCHED;
        }
        if constexpr (ALIGN_EPI) { if (wr == 0) PG8_BAR; }
        E(acc, cur, wr, wc, fr, fq);
        if (!has_next) break;
#pragma unroll
        for (int a = 0; a < 2; ++a)
#pragma unroll
            for (int b = 0; b < 2; ++b)
#pragma unroll
                for (int m = 0; m < 4; ++m)
#pragma unroll
                    for (int n = 0; n < 2; ++n) acc[a][b][m][n] = (f32x4){0.f, 0.f, 0.f, 0.f};
        cur = nxt; cA = nA; cB = nB; ++ui;
        if constexpr (ALIGN_EPI) { if (wr == 1) PG8_BAR; }
    }
    PG8_WAIT_V(0);
    if constexpr (!ALIGN_EPI) { if (wr == 0) PG8_BAR; }
    PG8_BAR;
#undef PG8_SA
#undef PG8_SB
#undef PG8_STAGE
#undef PG8_LDA
#undef PG8_LDB
#undef PG8_MMA
#undef PG8_WAIT_V
#undef PG8_WAIT_L
#undef PG8_BAR
#undef PG8_SCHED
}
}

typedef f32x4 Acc[2][2][4][2];

DI float row_rstd(const float* SS, int row) { return rsqrtf(SS[row] * (1.0f / 1024.0f) + 1e-6f); }

struct EpiInEven {
    static constexpr bool PERM = true;
    const float* SS; bf16_t *A0, *Z0, *GB0;
    DI void operator()(const Acc& acc, const pg8::Unit& u, int wr, int wc, int fr, int fq) const {
        const int row0 = u.pm * 256 + wr * 64 + fr, cl = wc * 32 + fq * 8;
        float rsv[2][4];
#pragma unroll
        for (int ai = 0; ai < 2; ++ai)
#pragma unroll
            for (int m = 0; m < 4; ++m) rsv[ai][m] = row_rstd(SS, row0 + ai * 128 + m * 16);
        if (u.pn < 8) {
            bf16_t* O = (u.pn < 4) ? A0 : Z0; const int colb = (u.pn & 3) * 128 + cl; const bool glu = u.pn < 4;
#pragma unroll
            for (int ai = 0; ai < 2; ++ai)
#pragma unroll
                for (int m = 0; m < 4; ++m) {
                    const int row = row0 + ai * 128 + m * 16;
                    const float rs = rsv[ai][m];
                    f32x4 x0 = acc[ai][0][m][0] * rs, x1 = acc[ai][0][m][1] * rs, y0 = acc[ai][1][m][0] * rs, y1 = acc[ai][1][m][1] * rs;
                    if (glu) {
#pragma unroll
                        for (int i = 0; i < 4; ++i) { y0[i] = sigmoidf_(y0[i]); y1[i] = sigmoidf_(y1[i]); }
                    }
                    *(u32x4*)(O + (size_t)row * MW + colb) = pk8(x0 * y0, x1 * y1);
                }
        } else {
            const int colb = (u.pn - 8) * 256 + cl;
#pragma unroll
            for (int ai = 0; ai < 2; ++ai)
#pragma unroll
                for (int m = 0; m < 4; ++m) {
                    const int row = row0 + ai * 128 + m * 16;
                    const float rs = rsv[ai][m];
#pragma unroll
                    for (int bj = 0; bj < 2; ++bj) *(u32x4*)(GB0 + (size_t)row * MW + colb + bj * 128) = pk8(acc[ai][bj][m][0] * rs, acc[ai][bj][m][1] * rs);
                }
        }
    }
};

template <int MODE> struct EpiResid {
    static constexpr bool PERM = true;
    const float* xin; float* out; bf16_t* XN; float* SS;
    DI void operator()(const Acc& acc, const pg8::Unit& u, int wr, int wc, int fr, int fq) const {
        const int colb = u.pn * 256 + wc * 32 + fq * 8;
        const int row0 = u.pm * 256 + wr * 64 + fr;
        if (MODE == 0) {
#pragma unroll
            for (int ai = 0; ai < 2; ++ai) {
                f32x4 rx[4][2][2];
#pragma unroll
                for (int m = 0; m < 4; ++m)
#pragma unroll
                    for (int bj = 0; bj < 2; ++bj) { const float* s = xin + (size_t)(row0 + ai * 128 + m * 16) * D + colb + bj * 128; rx[m][bj][0] = __builtin_nontemporal_load((const f32x4*)s); rx[m][bj][1] = __builtin_nontemporal_load((const f32x4*)(s + 4)); }
#pragma unroll
                for (int m = 0; m < 4; ++m) {
                    const int row = row0 + ai * 128 + m * 16;
                    float ssq = 0.f;
#pragma unroll
                    for (int bj = 0; bj < 2; ++bj) {
                        const f32x4 v0 = rx[m][bj][0] + acc[ai][bj][m][0], v1 = rx[m][bj][1] + acc[ai][bj][m][1];
                        ssq += (v0[0] * v0[0] + v0[1] * v0[1]) + (v0[2] * v0[2] + v0[3] * v0[3]) + (v1[0] * v1[0] + v1[1] * v1[1]) + (v1[2] * v1[2] + v1[3] * v1[3]);
                        *(u32x4*)(XN + (size_t)row * D + colb + bj * 128) = pk8(v0, v1);
                    }
                    ssq += __shfl_xor(ssq, 16); ssq += __shfl_xor(ssq, 32);
                    if (fq == 0) atomicAdd(SS + row, ssq);
                }
            }
        } else {
#pragma unroll
            for (int ai = 0; ai < 2; ++ai) {
                u32x4 rx[4][2];
#pragma unroll
                for (int m = 0; m < 4; ++m)
#pragma unroll
                    for (int bj = 0; bj < 2; ++bj) rx[m][bj] = *(const u32x4*)(XN + (size_t)(row0 + ai * 128 + m * 16) * D + colb + bj * 128);
#pragma unroll
                for (int m = 0; m < 4; ++m) {
                    const int row = row0 + ai * 128 + m * 16;
                    float ssq = 0.f;
#pragma unroll
                    for (int bj = 0; bj < 2; ++bj) {
                        const int col = colb + bj * 128;
                        float f[8]; unpack8(rx[m][bj], f);
                        const f32x4 v0 = (f32x4){f[0], f[1], f[2], f[3]} + acc[ai][bj][m][0], v1 = (f32x4){f[4], f[5], f[6], f[7]} + acc[ai][bj][m][1];
                        if (MODE == 2) { __builtin_nontemporal_store(v0, (f32x4*)(out + (size_t)row * D + col)); __builtin_nontemporal_store(v1, (f32x4*)(out + (size_t)row * D + col + 4)); }
                        else {
                            ssq += (v0[0] * v0[0] + v0[1] * v0[1]) + (v0[2] * v0[2] + v0[3] * v0[3]) + (v1[0] * v1[0] + v1[1] * v1[1]) + (v1[2] * v1[2] + v1[3] * v1[3]);
                            *(u32x4*)(XN + (size_t)row * D + col) = pk8(v0, v1);
                        }
                    }
                    if (MODE != 2) {
                        ssq += __shfl_xor(ssq, 16); ssq += __shfl_xor(ssq, 32);
                        if (fq == 0) atomicAdd(SS + row, ssq);
                    }
                }
            }
        }
    }
};

struct EpiGateUp {
    static constexpr bool PERM = true;
    const float* SS; bf16_t* HID;
    DI void operator()(const Acc& acc, const pg8::Unit& u, int wr, int wc, int fr, int fq) const {
        const int colb = u.pn * 128 + wc * 32 + fq * 8;
        float rsv[2][4];
#pragma unroll
        for (int ai = 0; ai < 2; ++ai)
#pragma unroll
            for (int m = 0; m < 4; ++m) rsv[ai][m] = row_rstd(SS, u.pm * 256 + ai * 128 + wr * 64 + m * 16 + fr);
#pragma unroll
        for (int ai = 0; ai < 2; ++ai)
#pragma unroll
            for (int m = 0; m < 4; ++m) {
                const int row = u.pm * 256 + ai * 128 + wr * 64 + m * 16 + fr;
                const float rs = rsv[ai][m];
                f32x4 h0, h1;
                const float rs2 = rs * rs, nrl = -rs * LOG2E;
#pragma unroll
                for (int i = 0; i < 4; ++i) {
                    const float a0 = acc[ai][0][m][0][i], a1 = acc[ai][0][m][1][i];
                    h0[i] = (a0 * acc[ai][1][m][0][i]) * rs2 * __builtin_amdgcn_rcpf(1.0f + __builtin_amdgcn_exp2f(a0 * nrl));
                    h1[i] = (a1 * acc[ai][1][m][1][i]) * rs2 * __builtin_amdgcn_rcpf(1.0f + __builtin_amdgcn_exp2f(a1 * nrl));
                }
                *(u32x4*)(HID + (size_t)row * FH + colb) = pk8(h0, h1);
            }
    }
};

struct EpiInOdd {
    static constexpr bool PERM = true;
    const float* SS; bf16_t* QKVUS; const float* qg; const float* kg; float* SVST; float* out;
    DI void operator()(const Acc& acc, const pg8::Unit& u, int wr, int wc, int fr, int fq) const {
        const int typ = u.pn >> 1, ph = u.pn & 1;
        bf16_t* O = QKVUS + (size_t)typ * ((size_t)MT * MW);
        const bool samp = (u.pm == 128);
        const bool keep = samp || ((u.pm & 15) >= 14);
        float rsv[2][4];
#pragma unroll
        for (int ai = 0; ai < 2; ++ai)
#pragma unroll
            for (int m = 0; m < 4; ++m) rsv[ai][m] = row_rstd(SS, u.pm * 256 + ai * 128 + wr * 64 + m * 16 + fr);
        if (typ < 2) {
            const float* gsrc = typ == 0 ? qg : kg;
            f32x4 gv[2][2];
#pragma unroll
            for (int bj = 0; bj < 2; ++bj)
#pragma unroll
                for (int n = 0; n < 2; ++n) gv[bj][n] = *(const f32x4*)(gsrc + 32 * bj + 8 * fq + 4 * n);
            const float osc = typ == 0 ? QSCALE : 1.0f;
            const int head = ph * 4 + wc;
#pragma unroll
            for (int ai = 0; ai < 2; ++ai)
#pragma unroll
                for (int m = 0; m < 4; ++m) {
                    const int row = u.pm * 256 + ai * 128 + wr * 64 + m * 16 + fr;
                    const float rs = rsv[ai][m];
                    f32x4 v[2][2]; float ssq = 0.f;
#pragma unroll
                    for (int bj = 0; bj < 2; ++bj)
#pragma unroll
                        for (int n = 0; n < 2; ++n) { v[bj][n] = acc[ai][bj][m][n] * rs; const f32x4 t = v[bj][n]; ssq += (t[0] * t[0] + t[1] * t[1]) + (t[2] * t[2] + t[3] * t[3]); }
                    ssq += __shfl_xor(ssq, 16); ssq += __shfl_xor(ssq, 32);
                    const float r = rsqrtf(ssq * (1.0f / 64.0f) + 1e-6f);
#pragma unroll
                    for (int bj = 0; bj < 2; ++bj) {
                        const f32x4 o0 = v[bj][0] * r * gv[bj][0], o1 = v[bj][1] * r * gv[bj][1];
                        *(u32x4*)(O + (size_t)row * MW + head * 64 + 32 * bj + 8 * fq) = pk8(o0 * osc, o1 * osc);
                        if (typ == 1 && keep && !(samp && ai == 1)) {
                            float* dst;
                            if (samp) dst = out + O_KS + (size_t)(row - MP) * 512;
                            else { const int b = u.pm >> 4, t = (u.pm & 15) * 256 + ai * 128 + wr * 64 + m * 16 + fr - 3584; dst = out + O_KP + ((size_t)b * 512 + t) * 512; }
                            dst += head * 64 + 32 * bj + 8 * fq;
                            *(f32x4*)dst = o0; *(f32x4*)(dst + 4) = o1;
                        }
                    }
                }
        } else {
#pragma unroll
            for (int ai = 0; ai < 2; ++ai)
#pragma unroll
                for (int m = 0; m < 4; ++m) {
                    const int row = u.pm * 256 + ai * 128 + wr * 64 + m * 16 + fr;
                    const float rs = rsv[ai][m];
                    float s1 = 0.f, s2 = 0.f;
#pragma unroll
                    for (int bj = 0; bj < 2; ++bj) {
                        const f32x4 o0 = acc[ai][bj][m][0] * rs, o1 = acc[ai][bj][m][1] * rs;
                        const int col = ph * 256 + bj * 128 + wc * 32 + fq * 8;
                        *(u32x4*)(O + (size_t)row * MW + col) = pk8(o0, o1);
                        if (typ == 4) {
                            s1 += (o0[0] + o0[1]) + (o0[2] + o0[3]) + (o1[0] + o1[1]) + (o1[2] + o1[3]);
                            s2 += (o0[0] * o0[0] + o0[1] * o0[1]) + (o0[2] * o0[2] + o0[3] * o0[3]) + (o1[0] * o1[0] + o1[1] * o1[1]) + (o1[2] * o1[2] + o1[3] * o1[3]);
                        }
                        if (typ == 2 && keep && !(samp && ai == 1)) {
                            float* dst;
                            if (samp) dst = out + O_VS + (size_t)(row - MP) * 512;
                            else { const int b = u.pm >> 4, t = (u.pm & 15) * 256 + ai * 128 + wr * 64 + m * 16 + fr - 3584; dst = out + O_VP + ((size_t)b * 512 + t) * 512; }
                            dst += col;
                            *(f32x4*)dst = o0; *(f32x4*)(dst + 4) = o1;
                        }
                    }
                    if (typ == 4) {
                        s1 += __shfl_xor(s1, 16); s1 += __shfl_xor(s1, 32); s2 += __shfl_xor(s2, 16); s2 += __shfl_xor(s2, 32);
                        if (fq == 0) *(f32x2*)(SVST + ((size_t)row * 8 + ph * 4 + wc) * 2) = (f32x2){s1, s2};
                    }
                }
        }
    }
};


DI float red16(float v) { v += __shfl_xor(v, 1); v += __shfl_xor(v, 2); v += __shfl_xor(v, 4); v += __shfl_xor(v, 8); return v; }
DI f32x4 shx8(const f32x4 v) { f32x4 o; o[0] = __shfl_xor(v[0], 8); o[1] = __shfl_xor(v[1], 8); o[2] = __shfl_xor(v[2], 8); o[3] = __shfl_xor(v[3], 8); return o; }
DI u32x2 pk4(const f32x4 a) { return (u32x2){pk2(a[0], a[1]), pk2(a[2], a[3])}; }

struct SEpiInEven {
    const float* SS; bf16_t *A0, *Z0, *GB0;
    DI void operator()(const f32x4 vraw, int row, int pn, int wc, int bj, int cl) const {
        const f32x4 v = vraw * row_rstd(SS, row);
        const f32x4 o = shx8(v);
        if (pn < 8) {
            if (bj == 0) {
                f32x4 y = o;
                if (pn < 4) {
#pragma unroll
                    for (int i = 0; i < 4; ++i) y[i] = sigmoidf_(y[i]);
                }
                bf16_t* O = (pn < 4) ? A0 : Z0;
                *(u32x2*)(O + (size_t)row * MW + (pn & 3) * 128 + wc * 32 + cl) = pk4(v * y);
            }
        } else *(u32x2*)(GB0 + (size_t)row * MW + (pn - 8) * 256 + bj * 128 + wc * 32 + cl) = pk4(v);
    }
};
template <int MODE> struct SEpiResid {
    const float* xin; float* out; bf16_t* XN; float* SS;
    DI void operator()(const f32x4 v, int row, int pn, int wc, int bj, int cl) const {
        const int col = pn * 256 + bj * 128 + wc * 32 + cl;
        f32x4 x;
        if (MODE == 0) x = *(const f32x4*)(xin + (size_t)row * D + col);
        else { const u32x2 w = *(const u32x2*)(XN + (size_t)row * D + col); x = (f32x4){bflo(w.x), bfhi(w.x), bflo(w.y), bfhi(w.y)}; }
        x += v;
        if (MODE == 2) *(f32x4*)(out + (size_t)row * D + col) = x;
        else {
            *(u32x2*)(XN + (size_t)row * D + col) = pk4(x);
            const float ssq = red16((x[0] * x[0] + x[1] * x[1]) + (x[2] * x[2] + x[3] * x[3]));
            if ((threadIdx.x & 15) == 0) atomicAdd(SS + row, ssq);
        }
    }
};
struct SEpiGateUp {
    const float* SS; bf16_t* HID;
    DI void operator()(const f32x4 v, int row, int pn, int wc, int bj, int cl) const {
        const float rs = row_rstd(SS, row);
        const f32x4 o = shx8(v);
        if (bj == 0) {
            f32x4 hv;
#pragma unroll
            for (int i = 0; i < 4; ++i) { const float g0 = v[i] * rs; hv[i] = g0 * sigmoidf_(g0) * (o[i] * rs); }
            *(u32x2*)(HID + (size_t)row * FH + pn * 128 + wc * 32 + cl) = pk4(hv);
        }
    }
};
struct SEpiInOdd {
    const float* SS; bf16_t* QKVUS; const float* qg; const float* kg; float* SVST; float* out;
    DI void operator()(const f32x4 v, int row, int pn, int wc, int bj, int cl) const {
        const int typ = pn >> 1, ph = pn & 1;
        bf16_t* O = QKVUS + (size_t)typ * ((size_t)MT * MW);
        const float rs = row_rstd(SS, row);
        const f32x4 x = v * rs;
        if (typ < 2) {
            const int head = ph * 4 + wc, dd = 32 * bj + cl;
            const float ssq = red16((x[0] * x[0] + x[1] * x[1]) + (x[2] * x[2] + x[3] * x[3]));
            const float r = rsqrtf(ssq * (1.0f / 64.0f) + 1e-6f);
            const f32x4 gv = *(const f32x4*)((typ == 0 ? qg : kg) + dd);
            const f32x4 o = x * r * gv;
            *(u32x2*)(O + (size_t)row * MW + head * 64 + dd) = pk4(o * (typ == 0 ? QSCALE : 1.0f));
            if (typ == 1) *(f32x4*)(out + O_KS + (size_t)(row - MP) * 512 + head * 64 + dd) = o;
        } else {
            const int col = ph * 256 + bj * 128 + wc * 32 + cl;
            *(u32x2*)(O + (size_t)row * MW + col) = pk4(x);
            if (typ == 2) *(f32x4*)(out + O_VS + (size_t)(row - MP) * 512 + col) = x;
            if (typ == 4) {
                const float s1 = red16((x[0] + x[1]) + (x[2] + x[3])), s2 = red16((x[0] * x[0] + x[1] * x[1]) + (x[2] * x[2] + x[3] * x[3]));
                if ((threadIdx.x & 15) == 0) *(f32x2*)(SVST + ((size_t)row * 8 + ph * 4 + wc) * 2) = (f32x2){s1, s2};
            }
        }
    }
};

template <class EpiS>
DI void sample_gemm(LAS unsigned char* lds, const bf16_t* A, const bf16_t* Bt, int nN, int K, const EpiS& E) {
    const int tid = threadIdx.x, lane = tid & 63, w = __builtin_amdgcn_readfirstlane(tid >> 6), r32 = lane & 31, h = lane >> 5;
    const int nunits = 16 * nN, kw = K >> 3, nk = kw >> 4;
    for (int un = (int)blockIdx.x; un < nunits; un += (int)gridDim.x) {
        const int rb = un & 3, wc = (un >> 2) & 3, pn = un >> 4;
        const bf16_t* ap = A + (size_t)(MP + rb * 32 + r32) * K + w * kw + h * 8;
        const bf16_t* b0p = Bt + (size_t)(pn * 256 + wc * 32 + r32) * K + w * kw + h * 8;
        const bf16_t* b1p = b0p + (size_t)128 * K;
        f32x16 c0, c1;
#pragma unroll
        for (int r = 0; r < 16; ++r) { c0[r] = 0.f; c1[r] = 0.f; }
#pragma unroll 8
        for (int ks = 0; ks < nk; ++ks) {
            const bf16x8 a = *(const bf16x8*)(ap + ks * 16), b0 = *(const bf16x8*)(b0p + ks * 16), b1 = *(const bf16x8*)(b1p + ks * 16);
            c0 = __builtin_amdgcn_mfma_f32_32x32x16_bf16(a, b0, c0, 0, 0, 0);
            c1 = __builtin_amdgcn_mfma_f32_32x32x16_bf16(a, b1, c1, 0, 0, 0);
        }
        __syncthreads();
        LAS float* part = (LAS float*)(lds + w * 8192);
#pragma unroll
        for (int r = 0; r < 16; ++r) { const int row = (r & 3) + 8 * (r >> 2) + 4 * h; part[row * 64 + r32] = c0[r]; part[row * 64 + 32 + r32] = c1[r]; }
        __syncthreads();
        f32x4 v = (f32x4){0.f, 0.f, 0.f, 0.f};
#pragma unroll
        for (int ww = 0; ww < 8; ++ww) v += *(const LAS f32x4*)(lds + ww * 8192 + (tid >> 4) * 256 + (tid & 15) * 16);
        E(v, MP + rb * 32 + (tid >> 4), pn, wc, (tid >> 3) & 1, 4 * (tid & 7));
    }
    __syncthreads();
}

struct Params {
    const float* in[27];
    float* out;
    unsigned char* ws;
    int ph_lo, ph_hi;
};

DI int map_col(int kind, int n) {
    if (kind == 1) { const int seg = n >> 9, o = n & 511, t = o >> 7, r = o & 127;
        if (seg == 0) return t * 256 + r; if (seg == 1) return t * 256 + 128 + r; if (seg == 2) return 2048 + o;
        if (seg == 3) return 1024 + t * 256 + r; return 1024 + t * 256 + 128 + r; }
    if (kind == 2) { const int up = n >= FH ? 1 : 0, o = up ? n - FH : n; return (o >> 7) * 256 + up * 128 + (o & 127); }
    if (kind == 3) { if (n >= 1024) return n; const int t = n >> 8, hl = (n >> 6) & 3, dd = n & 63; return t * 256 + (dd >> 5) * 128 + hl * 32 + (dd & 31); }
    return n;
}
DI void transpose_item(const float* W, int K, int N, bf16_t* WT, int kind, const float* gain, LAS float* scr, int item, int lane) {
    const int nblk = N / 64, kb = item / nblk, nb = item % nblk, k0 = 64 * kb, n0 = 64 * nb;
    const int lr = lane >> 4, lc = (lane & 15) * 4;
    f32x4 v[16];
#pragma unroll
    for (int i = 0; i < 16; ++i) v[i] = __builtin_nontemporal_load((const f32x4*)(W + (size_t)(k0 + 4 * i + lr) * N + n0 + lc));
    if (gain) {
        float gk[16];
#pragma unroll
        for (int i = 0; i < 16; ++i) gk[i] = gain[k0 + 4 * i + lr];
#pragma unroll
        for (int i = 0; i < 16; ++i) v[i] *= gk[i];
    }
#pragma unroll
    for (int i = 0; i < 16; ++i) { LAS float* d = scr + (4 * i + lr) * 65 + lc; d[0] = v[i][0]; d[1] = v[i][1]; d[2] = v[i][2]; d[3] = v[i][3]; }
    asm volatile("s_waitcnt lgkmcnt(0)" ::: "memory");
    const int c = lane & 7;
#pragma unroll
    for (int j = 0; j < 8; ++j) { const int n = (lane >> 3) + 8 * j; const LAS float* s = scr + (8 * c) * 65 + n;
        u32x4 o; o.x = pk2(s[0 * 65], s[1 * 65]); o.y = pk2(s[2 * 65], s[3 * 65]); o.z = pk2(s[4 * 65], s[5 * 65]); o.w = pk2(s[6 * 65], s[7 * 65]);
        *(u32x4*)(WT + (size_t)map_col(kind, n0 + n) * K + k0 + 8 * c) = o; }
    asm volatile("s_waitcnt lgkmcnt(0)" ::: "memory");
}

DI void phase_prologue(const Params& p, LAS unsigned char* lds) {
    const int tid = threadIdx.x, lane = tid & 63, wave = tid >> 6;
    LAS float* scr = (LAS float*)(lds + wave * 16896);
    const int gw = blockIdx.x * 8 + wave, NGW = gridDim.x * 8;
    unsigned char* ws = p.ws;
    bf16_t* XN = (bf16_t*)(ws + WS_XN);
    float* SS = (float*)(ws + WS_SS);
    for (int q = gw; q < MT / 4; q += NGW) {
        const int row0 = q * 4;
        if (row0 < MREAL) {
            f32x4 v[4][4];
#pragma unroll
            for (int r = 0; r < 4; ++r) {
                const int row = row0 + r;
                const float* src = row < MP ? p.in[0] + (size_t)row * D : p.in[1] + (size_t)(row - MP) * D;
                const f32x4* xr = (const f32x4*)src + lane;
#pragma unroll
                for (int j = 0; j < 4; ++j) v[r][j] = __builtin_nontemporal_load(xr + 64 * j);
            }
#pragma unroll
            for (int r = 0; r < 4; ++r) {
                const int row = row0 + r;
                float s = 0.f;
#pragma unroll
                for (int j = 0; j < 4; ++j) s += (v[r][j][0] * v[r][j][0] + v[r][j][1] * v[r][j][1]) + (v[r][j][2] * v[r][j][2] + v[r][j][3] * v[r][j][3]);
                s = wave_sum(s);
                u32x2* o8 = (u32x2*)(XN + (size_t)row * D) + lane;
#pragma unroll
                for (int j = 0; j < 4; ++j) o8[64 * j] = (u32x2){pk2(v[r][j][0], v[r][j][1]), pk2(v[r][j][2], v[r][j][3])};
                if (lane < 4) SS[(size_t)lane * MT + row] = lane == 0 ? s : 0.f;
            }
        } else {
#pragma unroll
            for (int r = 0; r < 4; ++r) { u32x2* o8 = (u32x2*)(XN + (size_t)(row0 + r) * D) + lane;
#pragma unroll
                for (int j = 0; j < 4; ++j) o8[64 * j] = (u32x2){0u, 0u}; }
        }
    }
    constexpr int I_IN = 16 * 40, I_OUT = 16 * 16, I_GU = 16 * 88, I_DN = 44 * 16, I_L = I_IN + I_OUT + I_GU + I_DN;
    for (int it = gw; it < 2 * I_L; it += NGW) {
        const int L = it >= I_L ? 1 : 0; int r = it - L * I_L;
        if (r < I_IN) { transpose_item(L ? p.in[15] : p.in[7], D, PW, (bf16_t*)(ws + (L ? WS_WIN1 : WS_WIN0)), L ? 3 : 1, L ? p.in[14] : p.in[6], scr, r, lane); continue; } r -= I_IN;
        if (r < I_OUT) { transpose_item(L ? p.in[23] : p.in[13], D, D, (bf16_t*)(ws + (L ? WS_WOUT1 : WS_WOUT0)), 0, nullptr, scr, r, lane); continue; } r -= I_OUT;
        if (r < I_GU) { transpose_item(p.in[25] + (size_t)L * D * 2 * FH, D, 2 * FH, (bf16_t*)(ws + (L ? WS_WGU1 : WS_WGU0)), 2, p.in[24] + L * D, scr, r, lane); continue; } r -= I_GU;
        transpose_item(p.in[26] + (size_t)L * FH * D, FH, D, (bf16_t*)(ws + (L ? WS_WDN1 : WS_WDN0)), 0, nullptr, scr, r, lane);
    }
}


DI float dot2bf(unsigned a, unsigned b, float c) { return __builtin_amdgcn_fdot2_f32_bf16(__builtin_bit_cast(bf16x2_t, a), __builtin_bit_cast(bf16x2_t, b), c, false); }
DI void st8f(float* dst, const u32x4 w) { float f[8]; unpack8(w, f); *(f32x4*)dst = (f32x4){f[0], f[1], f[2], f[3]}; *(f32x4*)(dst + 4) = (f32x4){f[4], f[5], f[6], f[7]}; }

constexpr int CV_PAR = 98304;
DI void phase_conv(const Params& p, LAS unsigned char* lds) {
    const int tid = threadIdx.x, lane = tid & 63, wid = __builtin_amdgcn_readfirstlane(tid >> 6);
    unsigned char* ws = p.ws;
    const bf16_t* A0 = (const bf16_t*)(ws + WS_A); const bf16_t* Z0 = (const bf16_t*)(ws + WS_A + SUB); const bf16_t* GB0 = (const bf16_t*)(ws + WS_A + 2 * SUB);
    bf16_t* CAT = (bf16_t*)(ws + WS_CAT);
    const float* cache_a = p.in[2]; const float* cache_b = p.in[3];
    const float* caw = p.in[8];
    float* out = p.out;
    const int c0 = lane * 8, par = wid >> 2;
    __syncthreads();
    {
        LAS float* pr = (LAS float*)(lds + CV_PAR);
        for (int i = tid; i < 512; i += 512) { pr[i] = p.in[9][i]; pr[512 + i] = p.in[10][i]; pr[1024 + i] = p.in[11][i]; pr[1536 + i] = p.in[12][i]; pr[2048 + i] = p.in[12][512 + i]; pr[2560 + i] = p.in[12][1024 + i]; }
    }
    unsigned wp[16][8];
#pragma unroll
    for (int i = 0; i < 16; ++i) {
        const int ja = par ? 2 * i - 1 : 2 * i, jb = ja + 1;
        f32x4 a0 = (f32x4){0.f, 0.f, 0.f, 0.f}, a1 = a0, b0 = a0, b1 = a0;
        if (ja >= 0) { a0 = *(const f32x4*)(caw + ja * MW + c0); a1 = *(const f32x4*)(caw + ja * MW + c0 + 4); }
        if (jb <= 30) { b0 = *(const f32x4*)(caw + jb * MW + c0); b1 = *(const f32x4*)(caw + jb * MW + c0 + 4); }
#pragma unroll
        for (int k = 0; k < 4; ++k) { asm volatile("v_cvt_pk_bf16_f32 %0, %1, %2" : "=v"(wp[i][k]) : "v"(a0[k]), "v"(b0[k])); asm volatile("v_cvt_pk_bf16_f32 %0, %1, %2" : "=v"(wp[i][4 + k]) : "v"(a1[k]), "v"(b1[k])); }
    }
    for (int un = blockIdx.x; un < 520; un += gridDim.x) {
        const bool samp = un >= 512;
        const int b = samp ? un - 512 : un >> 6, t0 = samp ? 0 : (un & 63) * 64, R = samp ? 16 : 64;
        const size_t rowbase = samp ? (size_t)MP + b * 16 : (size_t)b * SEQ;
        __syncthreads();
        for (int pr_ = wid; pr_ < (R + 30) / 2; pr_ += 8) {
            u32x4 v0 = (u32x4){0u, 0u, 0u, 0u}, v1 = v0;
            const int ta = t0 - 30 + 2 * pr_;
            if (ta >= 0) { v0 = *(const u32x4*)(A0 + (rowbase + ta) * MW + c0); v1 = *(const u32x4*)(A0 + (rowbase + ta + 1) * MW + c0); }
            else if (samp) { const f32x4* s0 = (const f32x4*)(cache_a + ((size_t)b * 30 + (30 + ta)) * MW + c0); const f32x4* s1 = s0 + MW / 4; v0 = pk8(s0[0], s0[1]); v1 = pk8(s1[0], s1[1]); }
            u32x4 e0, e1;
            e0.x = (v0.x & 0xffffu) | (v1.x << 16); e0.y = (v0.x >> 16) | (v1.x & 0xffff0000u); e0.z = (v0.y & 0xffffu) | (v1.y << 16); e0.w = (v0.y >> 16) | (v1.y & 0xffff0000u);
            e1.x = (v0.z & 0xffffu) | (v1.z << 16); e1.y = (v0.z >> 16) | (v1.z & 0xffff0000u); e1.z = (v0.w & 0xffffu) | (v1.w << 16); e1.w = (v0.w >> 16) | (v1.w & 0xffff0000u);
            *(LAS u32x4*)(lds + pr_ * 2048 + lane * 16) = e0; *(LAS u32x4*)(lds + pr_ * 2048 + 1024 + lane * 16) = e1;
        }
        __syncthreads();
        const int nrow = R >> 3;
        for (int i = 0; i < nrow; ++i) {
            const int r = par + 2 * ((wid & 3) + 4 * i);
            const int t = t0 + r; const size_t row = rowbase + t;
            const u32x4 zz = *(const u32x4*)(Z0 + row * MW + c0), gbv = *(const u32x4*)(GB0 + row * MW + c0);
            u32x4 z1 = (u32x4){0u, 0u, 0u, 0u}, z2 = z1;
            if (t >= 1) z1 = *(const u32x4*)(Z0 + (row - 1) * MW + c0);
            else if (samp) { const f32x4* s = (const f32x4*)(cache_b + ((size_t)b * 2 + 1) * MW + c0); z1 = pk8(s[0], s[1]); }
            if (t >= 2) z2 = *(const u32x4*)(Z0 + (row - 2) * MW + c0);
            else if (samp) { const f32x4* s = (const f32x4*)(cache_b + ((size_t)b * 2 + t) * MW + c0); z2 = pk8(s[0], s[1]); }
            const LAS float* pr = (const LAS float*)(lds + CV_PAR) + c0;
            f32x4 ac0 = *(const LAS f32x4*)pr, ac1 = *(const LAS f32x4*)(pr + 4);
            const LAS unsigned char* eb = lds + (r >> 1) * 2048 + lane * 16;
#pragma unroll
            for (int q = 0; q < 16; ++q) {
                const u32x4 e0 = *(const LAS u32x4*)(eb + q * 2048), e1 = *(const LAS u32x4*)(eb + q * 2048 + 1024);
                ac0[0] = dot2bf(e0.x, wp[q][0], ac0[0]); ac0[1] = dot2bf(e0.y, wp[q][1], ac0[1]); ac0[2] = dot2bf(e0.z, wp[q][2], ac0[2]); ac0[3] = dot2bf(e0.w, wp[q][3], ac0[3]);
                ac1[0] = dot2bf(e1.x, wp[q][4], ac1[0]); ac1[1] = dot2bf(e1.y, wp[q][5], ac1[1]); ac1[2] = dot2bf(e1.z, wp[q][6], ac1[2]); ac1[3] = dot2bf(e1.w, wp[q][7], ac1[3]);
                if ((q & 1) == 1) __builtin_amdgcn_sched_barrier(0);
            }
            const float mean = wave_sum((ac0[0] + ac0[1]) + (ac0[2] + ac0[3]) + (ac1[0] + ac1[1]) + (ac1[2] + ac1[3])) * (1.0f / 512.0f);
            ac0 -= mean; ac1 -= mean;
            const float rstd = rsqrtf(wave_sum((ac0[0] * ac0[0] + ac0[1] * ac0[1]) + (ac0[2] * ac0[2] + ac0[3] * ac0[3]) + (ac1[0] * ac1[0] + ac1[1] * ac1[1]) + (ac1[2] * ac1[2] + ac1[3] * ac1[3])) * (1.0f / 512.0f) + 1e-5f);
            const f32x4 g0 = *(const LAS f32x4*)(pr + 512), g1 = *(const LAS f32x4*)(pr + 516), b0 = *(const LAS f32x4*)(pr + 1024), b1 = *(const LAS f32x4*)(pr + 1028);
            f32x4 y0 = ac0 * rstd * g0 + b0, y1 = ac1 * rstd * g1 + b1;
#pragma unroll
            for (int k = 0; k < 4; ++k) { y0[k] *= sigmoidf_(y0[k]); y1[k] *= sigmoidf_(y1[k]); }
            *(u32x4*)(CAT + row * D + c0) = pk8(y0, y1);
            float fz[8], f1[8], f2[8], fg[8];
            unpack8(zz, fz); unpack8(z1, f1); unpack8(z2, f2); unpack8(gbv, fg);
            const f32x4 w00 = *(const LAS f32x4*)(pr + 1536), w01 = *(const LAS f32x4*)(pr + 1540), w10 = *(const LAS f32x4*)(pr + 2048), w11 = *(const LAS f32x4*)(pr + 2052), w20 = *(const LAS f32x4*)(pr + 2560), w21 = *(const LAS f32x4*)(pr + 2564);
            f32x4 o0, o1;
#pragma unroll
            for (int k = 0; k < 4; ++k) { o0[k] = fg[k] * (w00[k] * f2[k] + w10[k] * f1[k] + w20[k] * fz[k]); o1[k] = fg[4 + k] * (w01[k] * f2[4 + k] + w11[k] * f1[4 + k] + w21[k] * fz[4 + k]); }
            *(u32x4*)(CAT + row * D + MW + c0) = pk8(o0, o1);
        }
        if (!samp && (un & 63) == 63) {
            for (int i = wid; i < 30; i += 8) st8f(out + O_CAP + ((size_t)b * 30 + i) * MW + c0, *(const u32x4*)(A0 + (rowbase + 4066 + i) * MW + c0));
            if (wid < 2) st8f(out + O_CBP + ((size_t)b * 2 + wid) * MW + c0, *(const u32x4*)(Z0 + (rowbase + 4094 + wid) * MW + c0));
        }
        if (samp) {
            for (int i = wid; i < 30; i += 8) {
                float* dst = out + O_CAS + ((size_t)b * 30 + i) * MW + c0;
                if (i < 14) { const f32x4* s = (const f32x4*)(cache_a + ((size_t)b * 30 + 16 + i) * MW + c0); *(f32x4*)dst = s[0]; *(f32x4*)(dst + 4) = s[1]; }
                else st8f(dst, *(const u32x4*)(A0 + (rowbase + i - 14) * MW + c0));
            }
            if (wid < 2) st8f(out + O_CBS + ((size_t)b * 2 + wid) * MW + c0, *(const u32x4*)(Z0 + (rowbase + 14 + wid) * MW + c0));
        }
    }
    __syncthreads();
}

typedef short v4i16_t __attribute__((ext_vector_type(4)));
DI s16x4 tr_read(const LAS unsigned char* p) { return __builtin_bit_cast(s16x4, __builtin_amdgcn_ds_read_tr16_b64_v4i16((LAS v4i16_t*)p)); }
#define VFR(lo, hi) ((bf16x8){lo[0], lo[1], lo[2], lo[3], hi[0], hi[1], hi[2], hi[3]})
constexpr int KSTR = 272, VSTR = 320, AT_V = 64 * KSTR, AT_BUF = AT_V + 64 * VSTR, AT_B = 2 * AT_BUF;

template <bool SAMPLE>
DI void attn_load_tile(const Params& p, int b, int cp, int hp, int j, u32x4 (&kr)[2], u32x4 (&vr)[2]) {
    const int tid = threadIdx.x, chunk = tid & 15, k0 = tid >> 4;
    const bf16_t* Kb = (const bf16_t*)(p.ws + WS_A + SUB); const bf16_t* Vb = (const bf16_t*)(p.ws + WS_A + 2 * SUB);
#pragma unroll
    for (int i = 0; i < 2; ++i) {
        const int key = i * 32 + k0;
        if (!SAMPLE) {
            const size_t row = (size_t)b * SEQ + (size_t)(2 * cp - 8 + j) * 64 + key;
            kr[i] = *(const u32x4*)(Kb + row * MW + hp * 128 + chunk * 8);
            vr[i] = *(const u32x4*)(Vb + row * MW + hp * 128 + chunk * 8);
        } else {
            if (j < 8) {
                const size_t off = ((size_t)b * 512 + 64 * j + key) * 512 + hp * 128 + chunk * 8;
                const f32x4* ks = (const f32x4*)(p.in[4] + off); const f32x4* vs = (const f32x4*)(p.in[5] + off);
                kr[i] = pk8(ks[0], ks[1]); vr[i] = pk8(vs[0], vs[1]);
            } else if (key < 16) {
                const size_t row = (size_t)MP + b * 16 + key;
                kr[i] = *(const u32x4*)(Kb + row * MW + hp * 128 + chunk * 8);
                vr[i] = *(const u32x4*)(Vb + row * MW + hp * 128 + chunk * 8);
            } else { kr[i] = (u32x4){0u, 0u, 0u, 0u}; vr[i] = (u32x4){0u, 0u, 0u, 0u}; }
        }
    }
}
DI void attn_store_tile(LAS unsigned char* buf, const u32x4 (&kr)[2], const u32x4 (&vr)[2]) {
    const int tid = threadIdx.x, chunk = tid & 15, k0 = tid >> 4;
#pragma unroll
    for (int i = 0; i < 2; ++i) { const int key = i * 32 + k0;
        *(LAS u32x4*)(buf + key * KSTR + chunk * 16) = kr[i];
        *(LAS u32x4*)(buf + AT_V + key * VSTR + chunk * 16) = vr[i]; }
}

template <int BM, bool SMASK>
DI void attn_tile(const LAS unsigned char* kbase, const LAS unsigned char* vbase, const LAS float* bth, int ibase, int h, const bf16x8 (&qf)[4], f32x16& o0, f32x16& o1, float& lsum) {
#pragma unroll
    for (int kb = 0; kb < 2; ++kb) {
        f32x16 pa;
#pragma unroll
        for (int r = 0; r < 16; ++r) pa[r] = 0.f;
#pragma unroll
        for (int d0 = 0; d0 < 4; ++d0) { const bf16x8 a = *(const LAS bf16x8*)(kbase + kb * 32 * KSTR + d0 * 32); pa = __builtin_amdgcn_mfma_f32_32x32x16_bf16(a, qf[d0], pa, 0, 0, 0); }
        if (BM == 0) {
            const float cb = bth[512];
#pragma unroll
            for (int r = 0; r < 16; ++r) pa[r] += cb;
        } else if (BM == 1) {
#pragma unroll
            for (int r = 0; r < 16; ++r) { int idx = ibase - 32 * kb - ((r & 3) + 8 * (r >> 2)); idx = idx > 512 ? 512 : idx; pa[r] += bth[idx]; }
        } else {
            const LAS float* bp = bth + (ibase - 32 * kb - 27);
#pragma unroll
            for (int r = 0; r < 16; ++r) pa[r] += bp[27 - ((r & 3) + 8 * (r >> 2))];
        }
#pragma unroll
        for (int r = 0; r < 16; ++r) pa[r] = __builtin_amdgcn_exp2f(pa[r]);
        if (SMASK) {
#pragma unroll
            for (int r = 0; r < 16; ++r) { const int key = 32 * kb + (r & 3) + 8 * (r >> 2) + 4 * h; if (key >= 16) pa[r] = 0.f; }
        }
#pragma unroll
        for (int r = 0; r < 16; ++r) lsum += pa[r];
#pragma unroll
        for (int s = 0; s < 2; ++s) {
            u32x4 pw; pw.x = pk2(pa[8 * s], pa[8 * s + 1]); pw.y = pk2(pa[8 * s + 2], pa[8 * s + 3]); pw.z = pk2(pa[8 * s + 4], pa[8 * s + 5]); pw.w = pk2(pa[8 * s + 6], pa[8 * s + 7]);
            const bf16x8 pb = __builtin_bit_cast(bf16x8, pw);
            const LAS unsigned char* va = vbase + (kb * 32 + 16 * s) * VSTR;
            { const s16x4 lo = tr_read(va), hi = tr_read(va + 8 * VSTR); o0 = __builtin_amdgcn_mfma_f32_32x32x16_bf16(VFR(lo, hi), pb, o0, 0, 0, 0); }
            { const s16x4 lo = tr_read(va + 64), hi = tr_read(va + 64 + 8 * VSTR); o1 = __builtin_amdgcn_mfma_f32_32x32x16_bf16(VFR(lo, hi), pb, o1, 0, 0, 0); }
        }
    }
}

template <bool SAMPLE>
DI void attn_unit(const Params& p, LAS unsigned char* lds, int b, int cp, int hp) {
    int tid_ = threadIdx.x; asm volatile("" : "+v"(tid_));
    const int tid = tid_, lane = tid & 63, w = __builtin_amdgcn_readfirstlane(tid >> 6), r32 = lane & 31, h = lane >> 5;
    const int cl = SAMPLE ? 0 : (w >> 2), hl = (w >> 1) & 1, head = hp * 2 + hl, qoff = SAMPLE ? 0 : 32 * (w & 1);
    const bf16_t* Qb = (const bf16_t*)(p.ws + WS_A);
    bf16_t* CAT = (bf16_t*)(p.ws + WS_CAT);
    const size_t qrow = SAMPLE ? (size_t)MP + b * 16 + (r32 & 15) : (size_t)b * SEQ + (2 * cp + cl) * 64 + qoff + r32;
    bf16x8 qf[4];
#pragma unroll
    for (int d0 = 0; d0 < 4; ++d0) qf[d0] = *(const bf16x8*)(Qb + qrow * MW + head * 64 + d0 * 16 + h * 8);
    LAS float* bt = (LAS float*)(lds + AT_B);
    const int j_first = SAMPLE ? 0 : (cp >= 4 ? 0 : 8 - 2 * cp), j_last = SAMPLE ? 8 : 9;
    u32x4 ka[2], va_[2], kb_[2], vb_[2];
    attn_load_tile<SAMPLE>(p, b, cp, hp, j_first, ka, va_);
    __syncthreads();
    attn_store_tile(lds + (j_first & 1) * AT_BUF, ka, va_);
    attn_load_tile<SAMPLE>(p, b, cp, hp, j_first + 1, ka, va_);
    if (j_first + 2 <= j_last) attn_load_tile<SAMPLE>(p, b, cp, hp, j_first + 2, kb_, vb_);
    f32x16 o0, o1;
#pragma unroll
    for (int r = 0; r < 16; ++r) { o0[r] = 0.f; o1[r] = 0.f; }
    float lsum = 0.f;
    const int i16 = lane & 15, qd = i16 >> 2, pp = i16 & 3, g16 = (lane >> 4) & 1;
    const int koff = r32 * KSTR + hl * 128 + h * 16;
    const int voff = AT_V + (4 * h + qd) * VSTR + hl * 128 + (16 * g16 + 4 * pp) * 2;
    const LAS float* bth = bt + hl * 516;
#define ATT_STEP(j, KR, VR) do { \
        __syncthreads();                                        \
        if ((j) < j_last) { attn_store_tile(lds + (((j) + 1) & 1) * AT_BUF, KR, VR); if ((j) + 3 <= j_last) attn_load_tile<SAMPLE>(p, b, cp, hp, (j) + 3, KR, VR); } \
        const int t = (j) - cl; \
        if (t >= 0 && t <= 8) { \
            const LAS unsigned char* bufp = lds + ((j) & 1) * AT_BUF; \
            const int ibase = 768 - 64 * t + qoff + r32 - 4 * h; \
            if (t <= 3) attn_tile<0, false>(bufp + koff, bufp + voff, bth, ibase, h, qf, o0, o1, lsum); \
            else if (t == 4) attn_tile<1, false>(bufp + koff, bufp + voff, bth, ibase, h, qf, o0, o1, lsum); \
            else if (SAMPLE && t == 8) attn_tile<2, true>(bufp + koff, bufp + voff, bth, ibase, h, qf, o0, o1, lsum); \
            else attn_tile<2, false>(bufp + koff, bufp + voff, bth, ibase, h, qf, o0, o1, lsum); \
        } } while (0)
    for (int j = j_first; j <= j_last; j += 2) {
        ATT_STEP(j, ka, va_);
        if (j + 1 <= j_last) ATT_STEP(j + 1, kb_, vb_);
    }
#undef ATT_STEP
    lsum += __shfl_xor(lsum, 32);
    const float inv = 1.0f / lsum;
    const bool do_store = SAMPLE ? (w < 4 && (w & 1) == 0 && r32 < 16) : true;
    if (do_store) {
        bf16_t* dst = CAT + qrow * D + head * 64 + 4 * h;
#pragma unroll
        for (int gq = 0; gq < 4; ++gq) {
            *(u32x2*)(dst + 8 * gq) = (u32x2){pk2(o0[4 * gq] * inv, o0[4 * gq + 1] * inv), pk2(o0[4 * gq + 2] * inv, o0[4 * gq + 3] * inv)};
            *(u32x2*)(dst + 32 + 8 * gq) = (u32x2){pk2(o1[4 * gq] * inv, o1[4 * gq + 1] * inv), pk2(o1[4 * gq + 2] * inv, o1[4 * gq + 3] * inv)};
        }
    }
}

constexpr int SG_STR = 320, SG_LN = 49152;
struct SguRegs { f32x4 st[4]; u32x4 sv[4]; float bsv; };
DI void sgu_load(const Params& p, int uid, int tid, SguRegs& R) {
    const int b = uid >> 7, ch = (uid >> 2) & 31, g = uid & 3;
    const int lane = tid & 63, w = tid >> 6, r32 = lane & 31;
    const bf16_t* SVb = (const bf16_t*)(p.ws + WS_A + 4 * SUB);
    const float* SVST = (const float*)(p.ws + WS_SVST);
    const size_t r0 = (size_t)b * SEQ + ch * 128;
    const int srow = tid >> 2, qt = tid & 3;
    const f32x4* st = (const f32x4*)(SVST + (r0 + srow) * 16);
#pragma unroll
    for (int i = 0; i < 4; ++i) { R.st[i] = st[i]; R.sv[i] = *(const u32x4*)(SVb + (r0 + srow) * MW + g * 128 + qt * 32 + i * 8); }
    const int ib = w & 3, iloc = 32 * ib + r32;
    R.bsv = p.in[22][g * 128 + iloc];
}
DI void sgu_unit(const Params& p, LAS unsigned char* lds, int uid, int tid, const SguRegs& C, bool has_next, int uid_next, SguRegs& R) {
    const int b = uid >> 7, ch = (uid >> 2) & 31, g = uid & 3;
    const int lane = tid & 63, w = __builtin_amdgcn_readfirstlane(tid >> 6), r32 = lane & 31, h = lane >> 5;
    bf16_t* CAT = (bf16_t*)(p.ws + WS_CAT);
    const float* sw = p.in[21];
    const size_t r0 = (size_t)b * SEQ + ch * 128;
    const int ib = w & 3, dh = w >> 2, iloc = 32 * ib + r32;
    const size_t row = r0 + iloc;
    const float* Wrow = sw + ((size_t)g * 128 + iloc) * 128 + 8 * h;
    f32x4 wv[8][2];
#pragma unroll
    for (int js = 0; js < 8; ++js) { if (js <= 2 * ib + 1) { wv[js][0] = *(const f32x4*)(Wrow + 16 * js); wv[js][1] = *(const f32x4*)(Wrow + 16 * js + 4); } else { wv[js][0] = (f32x4){0.f, 0.f, 0.f, 0.f}; wv[js][1] = wv[js][0]; } }
    const bf16_t* Ub = (const bf16_t*)(p.ws + WS_A + 3 * SUB);
    u32x2 uu[2][4];
#pragma unroll
    for (int db = 0; db < 2; ++db)
#pragma unroll
        for (int gq = 0; gq < 4; ++gq) uu[db][gq] = *(const u32x2*)(Ub + row * MW + g * 128 + 64 * dh + 32 * db + 8 * gq + 4 * h);
    if (has_next) sgu_load(p, uid_next, tid, R);
    __syncthreads();
    {
        const int srow = tid >> 2, qt = tid & 3;
        const f32x4 a0 = C.st[0], a1 = C.st[1], a2 = C.st[2], a3 = C.st[3];
        const float s1 = (a0[0] + a0[2]) + (a1[0] + a1[2]) + (a2[0] + a2[2]) + (a3[0] + a3[2]);
        const float s2 = (a0[1] + a0[3]) + (a1[1] + a1[3]) + (a2[1] + a2[3]) + (a3[1] + a3[3]);
        const float mean = s1 * (1.0f / 512.0f), var = s2 * (1.0f / 512.0f) - mean * mean, rstd = rsqrtf(fmaxf(var, 0.f) + 1e-5f);
        const LAS float* lnp = (const LAS float*)(lds + SG_LN);
#pragma unroll
        for (int i = 0; i < 4; ++i) {
            const int c8 = qt * 32 + i * 8, ca = g * 128 + c8;
            float f[8]; unpack8(C.sv[i], f);
            const f32x4 g0 = *(const LAS f32x4*)(lnp + ca), g1 = *(const LAS f32x4*)(lnp + ca + 4), b0 = *(const LAS f32x4*)(lnp + 512 + ca), b1 = *(const LAS f32x4*)(lnp + 512 + ca + 4);
            f32x4 x0, x1;
#pragma unroll
            for (int k = 0; k < 4; ++k) { x0[k] = (f[k] - mean) * rstd * g0[k] + b0[k]; x1[k] = (f[4 + k] - mean) * rstd * g1[k] + b1[k]; }
            *(LAS u32x4*)(lds + srow * SG_STR + c8 * 2) = pk8(x0, x1);
        }
    }
    __syncthreads();
    const int i16 = lane & 15, qd = i16 >> 2, pp = i16 & 3, g16 = (lane >> 4) & 1;
    f32x16 acc0, acc1;
#pragma unroll
    for (int r = 0; r < 16; ++r) { acc0[r] = 0.f; acc1[r] = 0.f; }
    const LAS unsigned char* vb = lds + (8 * h + qd) * SG_STR + (64 * dh + 16 * g16 + 4 * pp) * 2;
#pragma unroll
    for (int js = 0; js < 8; ++js) {
        if (js <= 2 * ib + 1) {
            const int jb = 16 * js + 8 * h;
            f32x4 w0 = wv[js][0], w1 = wv[js][1];
#pragma unroll
            for (int k = 0; k < 4; ++k) { w0[k] = (jb + k <= iloc) ? w0[k] : 0.f; w1[k] = (jb + 4 + k <= iloc) ? w1[k] : 0.f; }
            const bf16x8 bw = __builtin_bit_cast(bf16x8, pk8(w0, w1));
            const LAS unsigned char* va = vb + js * 16 * SG_STR;
            { const s16x4 lo = tr_read(va), hi = tr_read(va + 4 * SG_STR); acc0 = __builtin_amdgcn_mfma_f32_32x32x16_bf16(VFR(lo, hi), bw, acc0, 0, 0, 0); }
            { const s16x4 lo = tr_read(va + 64), hi = tr_read(va + 64 + 4 * SG_STR); acc1 = __builtin_amdgcn_mfma_f32_32x32x16_bf16(VFR(lo, hi), bw, acc1, 0, 0, 0); }
        }
    }
    const float bsv = C.bsv;
#pragma unroll
    for (int gq = 0; gq < 4; ++gq) {
        const int d4 = 64 * dh + 8 * gq + 4 * h;
        { const u32x2 u2 = uu[0][gq];
          *(u32x2*)(CAT + row * D + MW + g * 128 + d4) = (u32x2){pk2(bflo(u2.x) * (acc0[4 * gq] + bsv), bfhi(u2.x) * (acc0[4 * gq + 1] + bsv)), pk2(bflo(u2.y) * (acc0[4 * gq + 2] + bsv), bfhi(u2.y) * (acc0[4 * gq + 3] + bsv))}; }
        { const u32x2 u2 = uu[1][gq];
          *(u32x2*)(CAT + row * D + MW + g * 128 + d4 + 32) = (u32x2){pk2(bflo(u2.x) * (acc1[4 * gq] + bsv), bfhi(u2.x) * (acc1[4 * gq + 1] + bsv)), pk2(bflo(u2.y) * (acc1[4 * gq + 2] + bsv), bfhi(u2.y) * (acc1[4 * gq + 3] + bsv))}; }
    }
}
DI void sgu_all(const Params& p, LAS unsigned char* lds, int first, int stride) {
    int tid_ = threadIdx.x; asm volatile("" : "+v"(tid_));
    const int tid = tid_;
    __syncthreads();
    { LAS float* lnp = (LAS float*)(lds + SG_LN); lnp[tid] = p.in[19][tid]; lnp[512 + tid] = p.in[20][tid]; }
    if (first >= 1024) { __syncthreads(); return; }
    SguRegs R; sgu_load(p, first, tid, R);
    for (int uid = first; uid < 1024; uid += stride) {
        const SguRegs C = R;
        sgu_unit(p, lds, uid, tid, C, uid + stride < 1024, uid + stride, R);
    }
    __syncthreads();
}

DI void sgu_sample_unit(const Params& p, LAS unsigned char* lds, int b) {
    int tid_ = threadIdx.x; asm volatile("" : "+v"(tid_));
    const int tid = tid_, lane = tid & 63, wid = tid >> 6;
    const bf16_t* Ub = (const bf16_t*)(p.ws + WS_A + 3 * SUB); const bf16_t* SVb = (const bf16_t*)(p.ws + WS_A + 4 * SUB);
    bf16_t* CAT = (bf16_t*)(p.ws + WS_CAT);
    const float* lng = p.in[19]; const float* lnb = p.in[20]; const float* sw = p.in[21]; const float* sb = p.in[22];
    LAS float* vn = (LAS float*)lds;
    const size_t r0 = (size_t)MP + b * 16;
    __syncthreads();
    for (int i = wid; i < 16; i += 8) {
        const int c0 = lane * 8;
        float f[8]; unpack8(*(const u32x4*)(SVb + (r0 + i) * MW + c0), f);
        float s = 0.f;
#pragma unroll
        for (int k = 0; k < 8; ++k) s += f[k];
        const float mean = wave_sum(s) * (1.0f / 512.0f);
        float q = 0.f;
#pragma unroll
        for (int k = 0; k < 8; ++k) { f[k] -= mean; q += f[k] * f[k]; }
        const float rstd = rsqrtf(wave_sum(q) * (1.0f / 512.0f) + 1e-5f);
        float* dst = p.out + O_SVS + ((size_t)b * 16 + i) * MW + c0;
#pragma unroll
        for (int k = 0; k < 8; ++k) { const float y = f[k] * rstd * lng[c0 + k] + lnb[c0 + k]; vn[i * 512 + c0 + k] = y; dst[k] = y; }
    }
    LAS float* wl = (LAS float*)(lds + 32768); LAS float* bl = wl + 1024;
    for (int i = tid; i < 1024; i += 512) wl[i] = sw[((size_t)(i >> 8) * 128 + ((i >> 4) & 15)) * 128 + (i & 15)];
    if (tid < 64) bl[tid] = sb[(tid >> 4) * 128 + (tid & 15)];
    const int cch = tid, g = cch >> 7;
    float uvv[16];
#pragma unroll
    for (int i = 0; i < 16; ++i) uvv[i] = bflo((unsigned)Ub[(r0 + i) * MW + cch]);
    __syncthreads();
    {
        float vv[16];
#pragma unroll
        for (int j = 0; j < 16; ++j) vv[j] = vn[j * 512 + cch];
#pragma unroll
        for (int i = 0; i < 16; ++i) {
            float s = bl[g * 16 + i];
#pragma unroll
            for (int j = 0; j <= i; ++j) s += wl[g * 256 + i * 16 + j] * vv[j];
            const unsigned o = pk2(uvv[i] * s, 0.f);
            CAT[(r0 + i) * D + MW + cch] = (bf16_t)(o & 0xffffu);
        }
    }
}

DI void phase_mix_odd(const Params& p, LAS unsigned char* lds) {
    const int blk = blockIdx.x;
    if (gridDim.x == 256) {
        {
            LAS float* bt = (LAS float*)(lds + AT_B); const float* relb = p.in[18]; const int hp = blk & 3;
            __syncthreads();
            for (int i = threadIdx.x; i < 2 * 513; i += 512) { const int hh = i >= 513 ? 1 : 0, j = i - hh * 513; bt[hh * 516 + j] = relb[(hp * 2 + hh) * 513 + j] * LOG2E; }
        }
        if (blk < 32) attn_unit<true>(p, lds, blk >> 2, 0, blk & 3);
        for (int uid = blk; uid < 1024; uid += 256) attn_unit<false>(p, lds, (uid & 31) >> 2, uid >> 5, uid & 3);
        if (blk >= 32 && blk < 40) sgu_sample_unit(p, lds, blk - 32);
        sgu_all(p, lds, blk, 256);
    } else {
        for (int uid = blk; uid < 1056; uid += gridDim.x) {
            { LAS float* bt = (LAS float*)(lds + AT_B); const float* relb = p.in[18]; const int hp = uid & 3;
              __syncthreads();
              for (int i = threadIdx.x; i < 2 * 513; i += 512) { const int hh = i >= 513 ? 1 : 0, j = i - hh * 513; bt[hh * 516 + j] = relb[(hp * 2 + hh) * 513 + j] * LOG2E; } }
            if (uid < 1024) attn_unit<false>(p, lds, (uid & 31) >> 2, uid >> 5, uid & 3);
            else { const int s_ = uid - 1024; attn_unit<true>(p, lds, s_ >> 2, 0, s_ & 3); }
        }
        sgu_all(p, lds, blk, gridDim.x);
        for (int uid = 1024 + blk; uid < 1032; uid += gridDim.x) sgu_sample_unit(p, lds, uid - 1024);
    }
    __syncthreads();
}

#define XB_TMO      128
#define XB_XCNT(j)  (256  + 64 * (j))
#define XB_XSUB(j)  (1280 + 64 * (j))
#define XB_XGEN(j)  (2304 + 64 * (j))
#define XB_TOP      3328
#define XB_TOPGEN   3392
#define XCD_BAR_WORDS 3456
#define XB_SPIN_CAP (1u << 18)
DI unsigned xb_ld(unsigned* p)              { return __hip_atomic_load(p, __ATOMIC_RELAXED, __HIP_MEMORY_SCOPE_AGENT); }
DI unsigned xb_add(unsigned* p, unsigned v) { return __hip_atomic_fetch_add(p, v, __ATOMIC_RELAXED, __HIP_MEMORY_SCOPE_AGENT); }
DI unsigned xb_xcc_id() { return (unsigned)__builtin_amdgcn_s_getreg((3 << 11) | 20) & 0xFu; }
#define XB_SPIN(cond, bar) do { unsigned _sp = 0; while (cond) { __builtin_amdgcn_s_sleep(1); \
    if ((++_sp & 255u) == 0u) { if (xb_ld(&(bar)[XB_TMO])) break; if (_sp > XB_SPIN_CAP) { atomicAdd(&(bar)[XB_TMO], 1u); break; } } } } while (0)
struct XcdBarrier { unsigned* bar; unsigned x; volatile LAS unsigned* st; };
DI XcdBarrier xcd_barrier_post(unsigned* bar, volatile LAS unsigned* st) {
    XcdBarrier b; b.bar = bar; b.x = xb_xcc_id(); b.st = st;
    if (threadIdx.x == 0) (void)xb_add(&bar[XB_XCNT(b.x)], 1u);
    return b;
}
DI void xcd_barrier_complete(unsigned* bar, unsigned x, unsigned& nloc, unsigned& nx) {
    const unsigned G = gridDim.x * gridDim.y * gridDim.z;
    unsigned sum, cnt, mine, sp = 0u;
    for (;;) {
        sum = 0u; cnt = 0u; mine = 0u;
#pragma unroll
        for (unsigned j = 0; j < 16; ++j) { const unsigned c = xb_ld(&bar[XB_XCNT(j)]); sum += c; cnt += (c > 0u) ? 1u : 0u; mine = (j == x) ? c : mine; }
        if (sum == G) break;
        __builtin_amdgcn_s_sleep(1);
        if ((++sp & 255u) == 0u) { if (xb_ld(&bar[XB_TMO])) break; if (sp > XB_SPIN_CAP) { atomicAdd(&bar[XB_TMO], 1u); break; } }
    }
    nloc = mine > 0u ? mine : 1u; nx = cnt > 0u ? cnt : 1u;
}
DI void xcd_barrier(const XcdBarrier& b) {
    asm volatile("s_waitcnt vmcnt(0)" ::: "memory");
    __syncthreads();
    if (threadIdx.x == 0) {
        unsigned* bar = b.bar;
        __builtin_amdgcn_s_waitcnt(0);
        unsigned nloc = b.st[0], nx = b.st[1];
        if (nloc == 0u) { xcd_barrier_complete(bar, b.x, nloc, nx); b.st[0] = nloc; b.st[1] = nx; }
        const unsigned old = xb_add(&bar[XB_XSUB(b.x)], 1u);
        const unsigned gen = old / nloc;
        if (old + 1u == (gen + 1u) * nloc) {
            __builtin_amdgcn_fence(__ATOMIC_RELEASE, "agent");
            asm volatile("s_waitcnt vmcnt(0)" ::: "memory");
            const unsigned og = xb_add(&bar[XB_TOP], 1u);
            const unsigned tg = og / nx;
            if (og + 1u == (tg + 1u) * nx) xb_add(&bar[XB_TOPGEN], 1u);
            else XB_SPIN(xb_ld(&bar[XB_TOPGEN]) == tg, bar);
            __builtin_amdgcn_fence(__ATOMIC_ACQUIRE, "agent");
            xb_add(&bar[XB_XGEN(b.x)], 1u);
            asm volatile("s_waitcnt vmcnt(0)" ::: "memory");
        } else {
            XB_SPIN(xb_ld(&bar[XB_XGEN(b.x)]) == gen, bar);
            __builtin_amdgcn_fence(__ATOMIC_ACQUIRE, "agent");
            asm volatile("s_waitcnt vmcnt(0)" ::: "memory");
        }
    }
    __syncthreads();
}

__global__ void __launch_bounds__(512, 2) fwd_kernel(Params p) {
    extern __shared__ __attribute__((aligned(16))) unsigned char lds_raw[];
    LAS unsigned char* lds = (LAS unsigned char*)lds_raw;
    const int lo = p.ph_lo, hi = p.ph_hi;
    unsigned char* ws = p.ws;
    bf16_t* XN = (bf16_t*)(ws + WS_XN); bf16_t* CAT = (bf16_t*)(ws + WS_CAT); bf16_t* HID = (bf16_t*)(ws + WS_HID);
    bf16_t* AREG = (bf16_t*)(ws + WS_A);
    float* SS = (float*)(ws + WS_SS); float* SVST = (float*)(ws + WS_SVST);
    float* out = p.out;
    const int G = gridDim.x, cid = blockIdx.x;
    volatile LAS unsigned* bst = (volatile LAS unsigned*)(lds + LDS_BYTES - 64);
    XcdBarrier xbar; xbar.bar = (unsigned*)ws; xbar.x = 0; xbar.st = bst;
    if (hi - lo > 1) {
        if (threadIdx.x < 16) bst[threadIdx.x] = 0u;
        __syncthreads();
        xbar = xcd_barrier_post((unsigned*)ws, bst);
    }
#ifndef PHASE_MASK
#define PHASE_MASK 0x7ff
#endif
#define IN(k) (((PHASE_MASK >> (k)) & 1) && lo <= (k) && (k) < hi)
#ifndef PROBE_DUP
#define PROBE_DUP 0
#endif
#define REPS(k) for (int rep_ = 0; rep_ < ((((PROBE_DUP) >> (k)) & 1) ? 2 : 1); ++rep_)
#define RSYNC() do { if (rep_) cg::this_grid().sync(); } while (0)
#define SEAM(k) do { if (IN(k) && IN((k) + 1)) { xcd_barrier(xbar); } } while (0)
    if (hi > 64) cg::this_grid().sync();
    if (IN(0)) REPS(0) { RSYNC(); phase_prologue(p, lds); __syncthreads(); }
    SEAM(0);
    if (IN(1)) REPS(1) {   RSYNC();
        pg8::Gemm g{XN, (const bf16_t*)(ws + WS_WIN0), MP, PW, D}; pg8::StaticOrder S; S.init(MP, PW, G, cid);
        EpiInEven E{SS + 0 * MT, AREG, (bf16_t*)(ws + WS_A + SUB), (bf16_t*)(ws + WS_A + 2 * SUB)};
        pg8::gemm_phase<EpiInEven, true>(lds, g, S, E);
        SEpiInEven ES{SS + 0 * MT, AREG, (bf16_t*)(ws + WS_A + SUB), (bf16_t*)(ws + WS_A + 2 * SUB)};
        sample_gemm(lds, XN, (const bf16_t*)(ws + WS_WIN0), PW / 256, D, ES);
    }
    SEAM(1);
    if (IN(2)) REPS(2) { RSYNC(); phase_conv(p, lds); }
    SEAM(2);
    if (IN(3)) REPS(3) {   RSYNC();
        pg8::Gemm g{CAT, (const bf16_t*)(ws + WS_WOUT0), MP, D, D}; pg8::StaticOrder S; S.init(MP, D, G, cid);
        EpiResid<0> E{p.in[0], out, XN, SS + 1 * MT};
        pg8::gemm_phase<EpiResid<0>, true>(lds, g, S, E);
        SEpiResid<0> ES{p.in[1] - (size_t)MP * D, out, XN, SS + 1 * MT};
        sample_gemm(lds, CAT, (const bf16_t*)(ws + WS_WOUT0), D / 256, D, ES);
    }
    SEAM(3);
    if (IN(4)) REPS(4) {   RSYNC();
        pg8::Gemm g{XN, (const bf16_t*)(ws + WS_WGU0), MP, 2 * FH, D}; pg8::StaticOrder S; S.init(MP, 2 * FH, G, cid);
        EpiGateUp E{SS + 1 * MT, HID};
        pg8::gemm_phase<EpiGateUp, true>(lds, g, S, E);
        SEpiGateUp ES{SS + 1 * MT, HID};
        sample_gemm(lds, XN, (const bf16_t*)(ws + WS_WGU0), 2 * FH / 256, D, ES);
    }
    SEAM(4);
    if (IN(5)) {
        pg8::Gemm g{HID, (const bf16_t*)(ws + WS_WDN0), MP, D, FH}; pg8::StaticOrder S; S.init(MP, D, G, cid);
        EpiResid<1> E{nullptr, out, XN, SS + 2 * MT};
        pg8::gemm_phase<EpiResid<1>, true>(lds, g, S, E);
        SEpiResid<1> ES{nullptr, out, XN, SS + 2 * MT};
        sample_gemm(lds, HID, (const bf16_t*)(ws + WS_WDN0), D / 256, FH, ES);
    }
    SEAM(5);
    if (IN(6)) REPS(6) {   RSYNC();
        pg8::Gemm g{XN, (const bf16_t*)(ws + WS_WIN1), MP, PW, D}; pg8::StaticOrder S; S.init(MP, PW, G, cid);
        EpiInOdd E{SS + 2 * MT, AREG, p.in[16], p.in[17], SVST, out};
        pg8::gemm_phase<EpiInOdd, true>(lds, g, S, E);
        SEpiInOdd ES{SS + 2 * MT, AREG, p.in[16], p.in[17], SVST, out};
        sample_gemm(lds, XN, (const bf16_t*)(ws + WS_WIN1), PW / 256, D, ES);
    }
    SEAM(6);
    if (IN(7)) REPS(7) { RSYNC(); phase_mix_odd(p, lds); }
    SEAM(7);
    if (IN(8)) {
        pg8::Gemm g{CAT, (const bf16_t*)(ws + WS_WOUT1), MP, D, D}; pg8::StaticOrder S; S.init(MP, D, G, cid);
        EpiResid<1> E{nullptr, out, XN, SS + 3 * MT};
        pg8::gemm_phase<EpiResid<1>, true>(lds, g, S, E);
        SEpiResid<1> ES{nullptr, out, XN, SS + 3 * MT};
        sample_gemm(lds, CAT, (const bf16_t*)(ws + WS_WOUT1), D / 256, D, ES);
    }
    SEAM(8);
    if (IN(9)) REPS(9) {   RSYNC();
        pg8::Gemm g{XN, (const bf16_t*)(ws + WS_WGU1), MP, 2 * FH, D}; pg8::StaticOrder S; S.init(MP, 2 * FH, G, cid);
        EpiGateUp E{SS + 3 * MT, HID};
        pg8::gemm_phase<EpiGateUp, true>(lds, g, S, E);
        SEpiGateUp ES{SS + 3 * MT, HID};
        sample_gemm(lds, XN, (const bf16_t*)(ws + WS_WGU1), 2 * FH / 256, D, ES);
    }
    SEAM(9);
    if (IN(10)) {
        pg8::Gemm g{HID, (const bf16_t*)(ws + WS_WDN1), MP, D, FH}; pg8::StaticOrder S; S.init(MP, D, G, cid);
        EpiResid<2> E{nullptr, out, XN, SS};
        pg8::gemm_phase<EpiResid<2>, true>(lds, g, S, E);
        SEpiResid<2> ES{nullptr, out, XN, SS};
        sample_gemm(lds, HID, (const bf16_t*)(ws + WS_WDN1), D / 256, FH, ES);
    }
#undef IN
#undef SEAM
}

constexpr int N_PHASES = 11;

extern "C" void kernel_launch(void* const* d_in, const int* in_sizes, int n_in, void* d_out, int out_size, void* d_ws, size_t ws_size, hipStream_t stream) {
    static int grid = 0;
    if (grid == 0) {
        if (n_in != 27 || ws_size < WS_END) { fprintf(stderr, "kernel_launch: unexpected n_in %d / ws %zu\n", n_in, ws_size); grid = -1; return; }
        int dev = 0, cus = 0, per_cu = 0;
        hipGetDevice(&dev);
        hipDeviceGetAttribute(&cus, hipDeviceAttributeMultiprocessorCount, dev);
        if (hipFuncSetAttribute((const void*)fwd_kernel, hipFuncAttributeMaxDynamicSharedMemorySize, LDS_BYTES) != hipSuccess) { fprintf(stderr, "kernel_launch: hipFuncSetAttribute failed\n"); grid = -1; return; }
        if (hipOccupancyMaxActiveBlocksPerMultiprocessor(&per_cu, (const void*)fwd_kernel, 512, LDS_BYTES) != hipSuccess || per_cu < 1) { fprintf(stderr, "kernel_launch: occupancy query says %d\n", per_cu); per_cu = 1; }
        (void)hipGetLastError();
        grid = cus;
    }
    if (grid < 0) return;
    Params a{};
    for (int i = 0; i < 27; ++i) a.in[i] = (const float*)d_in[i];
    a.out = (float*)d_out; a.ws = (unsigned char*)d_ws;
#if MK_ONE_LAUNCH
    if (hipMemsetAsync(d_ws, 0, 16384, stream) != hipSuccess) { fprintf(stderr, "kernel_launch: memset failed\n"); return; }
    a.ph_lo = 0; a.ph_hi = N_PHASES;
    void* args[] = {&a};
    hipError_t e = hipLaunchCooperativeKernel((const void*)fwd_kernel, dim3(grid), dim3(512), args, LDS_BYTES, stream);
    if (e != hipSuccess) fprintf(stderr, "cooperative launch failed: %s (grid %d)\n", hipGetErrorString(e), grid);
#else
    for (int ph = 0; ph < N_PHASES; ++ph) {
        a.ph_lo = ph; a.ph_hi = ph + 1;
        hipLaunchKernelGGL(fwd_kernel, dim3(grid), dim3(512), LDS_BYTES, stream, a);
    }
#endif
}
```

```cpp
#include <hip/hip_runtime.h>
#include <hip/hip_cooperative_groups.h>
#include <cstdio>
#include <cstdint>
namespace cg = cooperative_groups;

#ifndef MK_ONE_LAUNCH
#define MK_ONE_LAUNCH 1
#endif

#define LAS __attribute__((address_space(3)))
typedef unsigned short bf16_t;
typedef short bf16x8 __attribute__((ext_vector_type(8)));
typedef short s16x4 __attribute__((ext_vector_type(4)));
typedef float f32x4 __attribute__((ext_vector_type(4)));
typedef float f32x2 __attribute__((ext_vector_type(2)));
typedef float f32x16 __attribute__((ext_vector_type(16)));
typedef unsigned u32x4 __attribute__((ext_vector_type(4)));
typedef unsigned u32x2 __attribute__((ext_vector_type(2)));
typedef __bf16 bf16x2_t __attribute__((ext_vector_type(2)));

#define DI __device__ __forceinline__

constexpr int D = 1024, MP = 32768, MS = 128, MREAL = MP + MS, MT = 33024;
constexpr int SEQ = 4096, NB = 8, DSEQ = 16;
constexpr int MW = 512, PW = 2560, FH = 2816;
constexpr float LOG2E = 1.4426950408889634f;
constexpr float QSCALE = 0.125f * LOG2E;

constexpr size_t O_Y = 0;
constexpr size_t O_CAP = 33685504, O_CBP = 33808384, O_KP = 33816576, O_VP = 35913728;
constexpr size_t O_CAS = 38010880, O_CBS = 38133760, O_KS = 38141952, O_VS = 38207488, O_SVS = 38273024;

constexpr size_t MiB = 1u << 20;
constexpr size_t WS_SS = 1 * MiB;
constexpr size_t WS_SVST = 4 * MiB;
constexpr size_t WS_WIN0 = 8 * MiB, WS_WOUT0 = 13 * MiB, WS_WGU0 = 15 * MiB, WS_WDN0 = 26 * MiB;
constexpr size_t WS_WIN1 = 32 * MiB, WS_WOUT1 = 37 * MiB, WS_WGU1 = 39 * MiB, WS_WDN1 = 50 * MiB;
constexpr size_t WS_XN = 56 * MiB;
constexpr size_t WS_A = 122 * MiB;
constexpr size_t SUB = (size_t)MT * MW * 2;
constexpr size_t WS_CAT = 284 * MiB;
constexpr size_t WS_HID = 122 * MiB;
constexpr size_t WS_END = 349 * MiB;

constexpr int LDS_BYTES = 163840;

DI unsigned pk2(float lo, float hi) { f32x2 v = {lo, hi}; bf16x2_t b = __builtin_convertvector(v, bf16x2_t); return __builtin_bit_cast(unsigned, b); }
DI float bflo(unsigned u) { return __uint_as_float(u << 16); }
DI float bfhi(unsigned u) { return __uint_as_float(u & 0xffff0000u); }
DI u32x4 pk8(f32x4 a, f32x4 b) { u32x4 w; w.x = pk2(a[0], a[1]); w.y = pk2(a[2], a[3]); w.z = pk2(b[0], b[1]); w.w = pk2(b[2], b[3]); return w; }
DI void unpack8(const u32x4 w, float (&f)[8]) { f[0] = bflo(w.x); f[1] = bfhi(w.x); f[2] = bflo(w.y); f[3] = bfhi(w.y); f[4] = bflo(w.z); f[5] = bfhi(w.z); f[6] = bflo(w.w); f[7] = bfhi(w.w); }
DI float sigmoidf_(float x) { return __builtin_amdgcn_rcpf(1.0f + __expf(-x)); }
DI float wave_sum(float v) {
#pragma unroll
    for (int o = 1; o < 64; o <<= 1) v += __shfl_xor(v, o);
    return v;
}

namespace pg8 {
constexpr int BM = 256, BK = 64, HALF = 128, HTB = HALF * BK * 2, STAGE_BYTES = 8 * HTB, NXCD = 8, WGM = 8;
__host__ __device__ __forceinline__ int lds_byte(int r, int c) { const int st = (r >> 4) * 2 + (c >> 5), rr = r & 15, cc = c & 31, ob = rr * 64 + cc * 2; return st * 1024 + (ob ^ (((ob >> 9) & 1) << 5)); }
__host__ __device__ __forceinline__ void stage_rc(int b, int& R, int& C) { const int st = b / 1024, sb = b % 1024, swz = sb ^ (((sb >> 9) & 1) << 5); R = (st >> 1) * 16 + swz / 64; C = (st & 1) * 32 + (swz % 64) / 2; }
__host__ __device__ __forceinline__ int perm32(int rho) { const int n = rho >> 4, i = rho & 15; return 8 * (i >> 2) + 4 * n + (i & 3); }

struct Unit { int pm, pn; };
struct Gemm { const bf16_t* A; const bf16_t* Bt; int M, N, K; };

struct StaticOrder {
    int nM, nN, nwg, G, c;
    __device__ void init(int M, int N, int G_, int c_) { nM = M / BM; nN = N / BM; nwg = nM * nN; G = G_; c = c_; }
    __device__ bool next(int i, Unit& u) const {
        const long L = (long)i * G + c; if (L >= nwg) return false;
        int wgid = (int)L; { const int q = nwg / NXCD, r = nwg % NXCD, xcd = wgid % NXCD, off = wgid / NXCD; wgid = (xcd < r ? xcd * (q + 1) : r * (q + 1) + (xcd - r) * q) + off; }
        const int nig = WGM * nN, gid = wgid / nig, fm = gid * WGM, gsz = (nM - fm) < WGM ? (nM - fm) : WGM;
        u.pm = fm + ((wgid % nig) % gsz); u.pn = (wgid % nig) / gsz; return true;
    }
};

template <class Epi, bool ALIGN_EPI>
__device__ __forceinline__ void gemm_phase(LAS unsigned char* lds, const Gemm g, const StaticOrder& S, const Epi& E) {
    const int tid = threadIdx.x, wid = __builtin_amdgcn_readfirstlane(tid >> 6), lane = tid & 63, wr = wid >> 2, wc = wid & 3, fr = lane & 15, fq = lane >> 4;
    const int K = g.K, nt = K / BK;
    unsigned voffA[2], voffB[2];
#pragma unroll
    for (int i = 0; i < 2; ++i) { int R, C; stage_rc(tid * 16 + i * 8192, R, C); const int Rb = Epi::PERM ? ((R & ~31) + perm32(R & 31)) : R;
        voffA[i] = (unsigned)(R * K + C) * 2u; voffB[i] = (unsigned)(Rb * K + C) * 2u; }
    const size_t kstep = (size_t)(BK * 2);
    const size_t hstep = (size_t)HALF * K * 2;
    const size_t tstep = 2 * hstep;
    const unsigned ldsw = (unsigned)wid * 1024u;
    const int aoff = lds_byte(wr * 64 + fr, fq * 8), boff = lds_byte(wc * 32 + fr, fq * 8);
#define PG8_SA(b, h) (((b) * 2 + (h)) * HTB)
#define PG8_SB(b, h) ((4 + (b) * 2 + (h)) * HTB)
#define PG8_STAGE(bufoff, gbase, voff) do { _Pragma("unroll") for (int _i = 0; _i < 2; ++_i) \
        __builtin_amdgcn_global_load_lds((const unsigned*)((const char*)(gbase) + (voff)[_i]), (LAS unsigned*)(lds + (bufoff) + ldsw + _i * 8192), 16, 0, 0); } while (0)
#define PG8_LDA(dst, b, h) do { _Pragma("unroll") for (int m = 0; m < 4; ++m) _Pragma("unroll") for (int k = 0; k < 2; ++k) dst[m][k] = *(const LAS bf16x8*)(lds + PG8_SA(b, h) + aoff + m * 2048 + k * 1024); } while (0)
#define PG8_LDB(dst, b, h) do { _Pragma("unroll") for (int n = 0; n < 2; ++n) _Pragma("unroll") for (int k = 0; k < 2; ++k) dst[n][k] = *(const LAS bf16x8*)(lds + PG8_SB(b, h) + boff + n * 2048 + k * 1024); } while (0)
#define PG8_MMA(ai, bj, At, Bt) do { __builtin_amdgcn_s_setprio(3); _Pragma("unroll") for (int m = 0; m < 4; ++m) _Pragma("unroll") for (int n = 0; n < 2; ++n) _Pragma("unroll") for (int k = 0; k < 2; ++k) \
        acc[ai][bj][m][n] = __builtin_amdgcn_mfma_f32_16x16x32_bf16(Bt[n][k], At[m][k], acc[ai][bj][m][n], 0, 0, 0); __builtin_amdgcn_s_setprio(0); } while (0)
#define PG8_WAIT_V(n) asm volatile("s_waitcnt vmcnt(" #n ")" ::: "memory")
#define PG8_WAIT_L(n) asm volatile("s_waitcnt lgkmcnt(" #n ")" ::: "memory")
#define PG8_BAR __builtin_amdgcn_s_barrier()
#define PG8_SCHED __builtin_amdgcn_sched_barrier(0)
    Unit cur, nxt; int ui = 0;
    if (!S.next(0, cur)) return;
    f32x4 acc[2][2][4][2];
#pragma unroll
    for (int a = 0; a < 2; ++a)
#pragma unroll
        for (int b = 0; b < 2; ++b)
#pragma unroll
            for (int m = 0; m < 4; ++m)
#pragma unroll
                for (int n = 0; n < 2; ++n) acc[a][b][m][n] = (f32x4){0.f, 0.f, 0.f, 0.f};
    bf16x8 At[4][2], B0[2][2], B1[2][2];
    const char* cA = (const char*)g.A + (size_t)cur.pm * tstep; const char* cB = (const char*)g.Bt + (size_t)cur.pn * tstep;
    PG8_STAGE(PG8_SB(0, 0), cB, voffB); PG8_STAGE(PG8_SB(0, 1), cB + hstep, voffB); PG8_STAGE(PG8_SA(0, 0), cA, voffA); PG8_STAGE(PG8_SA(0, 1), cA + hstep, voffA);
    if (wr == 1) PG8_BAR;
    PG8_WAIT_V(2); PG8_BAR;
    PG8_STAGE(PG8_SB(1, 0), cB + kstep, voffB); PG8_STAGE(PG8_SA(1, 0), cA + kstep, voffA); PG8_STAGE(PG8_SB(1, 1), cB + hstep + kstep, voffB);
    PG8_WAIT_V(6); PG8_BAR;
    for (;;) {
        const bool has_next = S.next(ui + 1, nxt);
        const char* nA = has_next ? (const char*)g.A + (size_t)nxt.pm * tstep : cA; const char* nB = has_next ? (const char*)g.Bt + (size_t)nxt.pn * tstep : cB;
        for (int t = 0; t < nt; t += 2) {
            const bool last = (t == nt - 2);
            const char* a1 = cA + (size_t)(t + 1) * kstep;
            const char* a2 = last ? nA : cA + (size_t)(t + 2) * kstep; const char* b2 = last ? nB : cB + (size_t)(t + 2) * kstep;
            const char* a3 = a2 + kstep; const char* b3 = b2 + kstep;
            PG8_LDB(B0, 0, 0); PG8_LDB(B1, 0, 1); PG8_SCHED; PG8_LDA(At, 0, 0); PG8_STAGE(PG8_SA(1, 1), a1 + hstep, voffA);
            PG8_WAIT_V(8); PG8_WAIT_L(0); PG8_BAR; PG8_MMA(0, 0, At, B0); PG8_MMA(0, 1, At, B1); PG8_BAR; PG8_SCHED;
            PG8_LDA(At, 0, 1); PG8_STAGE(PG8_SB(0, 0), b2, voffB); PG8_STAGE(PG8_SB(0, 1), b2 + hstep, voffB); PG8_STAGE(PG8_SA(0, 0), a2, voffA);
            PG8_WAIT_V(8); PG8_WAIT_L(0); PG8_BAR; PG8_MMA(1, 0, At, B0); PG8_MMA(1, 1, At, B1); PG8_BAR; PG8_SCHED;
            PG8_LDB(B0, 1, 0); PG8_LDB(B1, 1, 1); PG8_SCHED; PG8_LDA(At, 1, 0); PG8_STAGE(PG8_SA(0, 1), a2 + hstep, voffA);
            PG8_WAIT_V(8); PG8_WAIT_L(0); PG8_BAR; PG8_MMA(0, 0, At, B0); PG8_MMA(0, 1, At, B1); PG8_BAR; PG8_SCHED;
            PG8_LDA(At, 1, 1); PG8_STAGE(PG8_SB(1, 0), b3, voffB); PG8_STAGE(PG8_SB(1, 1), b3 + hstep, voffB); PG8_STAGE(PG8_SA(1, 0), a3, voffA);
            PG8_WAIT_V(8); PG8_WAIT_L(0); PG8_BAR; PG8_MMA(1, 0, At, B0); PG8_MMA(1, 1, At, B1); PG8_BAR; PG8_SCHED;
        }
        if constexpr (ALIGN_EPI) { if (wr == 0) PG8_BAR; }
        E(acc, cur, wr, wc, fr, fq);
        if (!has_next) break;
#pragma unroll
        for (int a = 0; a < 2; ++a)
#pragma unroll
            for (int b = 0; b < 2; ++b)
#pragma unroll
                for (int m = 0; m < 4; ++m)
#pragma unroll
                    for (int n = 0; n < 2; ++n) acc[a][b][m][n] = (f32x4){0.f, 0.f, 0.f, 0.f};
        cur = nxt; cA = nA; cB = nB; ++ui;
        if constexpr (ALIGN_EPI) { if (wr == 1) PG8_BAR; }
    }
    PG8_WAIT_V(0);
    if constexpr (!ALIGN_EPI) { if (wr == 0) PG8_BAR; }
    PG8_BAR;
#undef PG8_SA
#undef PG8_SB
#undef PG8_STAGE
#undef PG8_LDA
#undef PG8_LDB
#undef PG8_MMA
#undef PG8_WAIT_V
#undef PG8_WAIT_L
#undef PG8_BAR
#undef PG8_SCHED
}
}

typedef f32x4 Acc[2][2][4][2];

DI float row_rstd(const float* SS, int row) { return rsqrtf(SS[row] * (1.0f / 1024.0f) + 1e-6f); }

struct EpiInEven {
    static constexpr bool PERM = true;
    const float* SS; bf16_t *A0, *Z0, *GB0;
    DI void operator()(const Acc& acc, const pg8::Unit& u, int wr, int wc, int fr, int fq) const {
        const int row0 = u.pm * 256 + wr * 64 + fr, cl = wc * 32 + fq * 8;
        float rsv[2][4];
#pragma unroll
        for (int ai = 0; ai < 2; ++ai)
#pragma unroll
            for (int m = 0; m < 4; ++m) rsv[ai][m] = row_rstd(SS, row0 + ai * 128 + m * 16);
        if (u.pn < 8) {
            bf16_t* O = (u.pn < 4) ? A0 : Z0; const int colb = (u.pn & 3) * 128 + cl; const bool glu = u.pn < 4;
#pragma unroll
            for (int ai = 0; ai < 2; ++ai)
#pragma unroll
                for (int m = 0; m < 4; ++m) {
                    const int row = row0 + ai * 128 + m * 16;
                    const float rs = rsv[ai][m];
                    f32x4 x0 = acc[ai][0][m][0] * rs, x1 = acc[ai][0][m][1] * rs, y0 = acc[ai][1][m][0] * rs, y1 = acc[ai][1][m][1] * rs;
                    if (glu) {
#pragma unroll
                        for (int i = 0; i < 4; ++i) { y0[i] = sigmoidf_(y0[i]); y1[i] = sigmoidf_(y1[i]); }
                    }
                    *(u32x4*)(O + (size_t)row * MW + colb) = pk8(x0 * y0, x1 * y1);
                }
        } else {
            const int colb = (u.pn - 8) * 256 + cl;
#pragma unroll
            for (int ai = 0; ai < 2; ++ai)
#pragma unroll
                for (int m = 0; m < 4; ++m) {
                    const int row = row0 + ai * 128 + m * 16;
                    const float rs = rsv[ai][m];
#pragma unroll
                    for (int bj = 0; bj < 2; ++bj) *(u32x4*)(GB0 + (size_t)row * MW + colb + bj * 128) = pk8(acc[ai][bj][m][0] * rs, acc[ai][bj][m][1] * rs);
                }
        }
    }
};

template <int MODE> struct EpiResid {
    static constexpr bool PERM = true;
    const float* xin; float* out; bf16_t* XN; float* SS;
    DI void operator()(const Acc& acc, const pg8::Unit& u, int wr, int wc, int fr, int fq) const {
        const int colb = u.pn * 256 + wc * 32 + fq * 8;
        const int row0 = u.pm * 256 + wr * 64 + fr;
        if (MODE == 0) {
#pragma unroll
            for (int ai = 0; ai < 2; ++ai) {
                f32x4 rx[4][2][2];
#pragma unroll
                for (int m = 0; m < 4; ++m)
#pragma unroll
                    for (int bj = 0; bj < 2; ++bj) { const float* s = xin + (size_t)(row0 + ai * 128 + m * 16) * D + colb + bj * 128; rx[m][bj][0] = __builtin_nontemporal_load((const f32x4*)s); rx[m][bj][1] = __builtin_nontemporal_load((const f32x4*)(s + 4)); }
#pragma unroll
                for (int m = 0; m < 4; ++m) {
                    const int row = row0 + ai * 128 + m * 16;
                    float ssq = 0.f;
#pragma unroll
                    for (int bj = 0; bj < 2; ++bj) {
                        const f32x4 v0 = rx[m][bj][0] + acc[ai][bj][m][0], v1 = rx[m][bj][1] + acc[ai][bj][m][1];
                        ssq += (v0[0] * v0[0] + v0[1] * v0[1]) + (v0[2] * v0[2] + v0[3] * v0[3]) + (v1[0] * v1[0] + v1[1] * v1[1]) + (v1[2] * v1[2] + v1[3] * v1[3]);
                        *(u32x4*)(XN + (size_t)row * D + colb + bj * 128) = pk8(v0, v1);
                    }
                    ssq += __shfl_xor(ssq, 16); ssq += __shfl_xor(ssq, 32);
                    if (fq == 0) atomicAdd(SS + row, ssq);
                }
            }
        } else {
#pragma unroll
            for (int ai = 0; ai < 2; ++ai) {
                u32x4 rx[4][2];
#pragma unroll
                for (int m = 0; m < 4; ++m)
#pragma unroll
                    for (int bj = 0; bj < 2; ++bj) rx[m][bj] = *(const u32x4*)(XN + (size_t)(row0 + ai * 128 + m * 16) * D + colb + bj * 128);
#pragma unroll
                for (int m = 0; m < 4; ++m) {
                    const int row = row0 + ai * 128 + m * 16;
                    float ssq = 0.f;
#pragma unroll
                    for (int bj = 0; bj < 2; ++bj) {
                        const int col = colb + bj * 128;
                        float f[8]; unpack8(rx[m][bj], f);
                        const f32x4 v0 = (f32x4){f[0], f[1], f[2], f[3]} + acc[ai][bj][m][0], v1 = (f32x4){f[4], f[5], f[6], f[7]} + acc[ai][bj][m][1];
                        if (MODE == 2) { __builtin_nontemporal_store(v0, (f32x4*)(out + (size_t)row * D + col)); __builtin_nontemporal_store(v1, (f32x4*)(out + (size_t)row * D + col + 4)); }
                        else {
                            ssq += (v0[0] * v0[0] + v0[1] * v0[1]) + (v0[2] * v0[2] + v0[3] * v0[3]) + (v1[0] * v1[0] + v1[1] * v1[1]) + (v1[2] * v1[2] + v1[3] * v1[3]);
                            *(u32x4*)(XN + (size_t)row * D + col) = pk8(v0, v1);
                        }
                    }
                    if (MODE != 2) {
                        ssq += __shfl_xor(ssq, 16); ssq += __shfl_xor(ssq, 32);
                        if (fq == 0) atomicAdd(SS + row, ssq);
                    }
                }
            }
        }
    }
};

struct EpiGateUp {
    static constexpr bool PERM = true;
    const float* SS; bf16_t* HID;
    DI void operator()(const Acc& acc, const pg8::Unit& u, int wr, int wc, int fr, int fq) const {
        const int colb = u.pn * 128 + wc * 32 + fq * 8;
        float rsv[2][4];
#pragma unroll
        for (int ai = 0; ai < 2; ++ai)
#pragma unroll
            for (int m = 0; m < 4; ++m) rsv[ai][m] = row_rstd(SS, u.pm * 256 + ai * 128 + wr * 64 + m * 16 + fr);
#pragma unroll
        for (int ai = 0; ai < 2; ++ai)
#pragma unroll
            for (int m = 0; m < 4; ++m) {
                const int row = u.pm * 256 + ai * 128 + wr * 64 + m * 16 + fr;
                const float rs = rsv[ai][m];
                f32x4 h0, h1;
                const float rs2 = rs * rs, nrl = -rs * LOG2E;
#pragma unroll
                for (int i = 0; i < 4; ++i) {
                    const float a0 = acc[ai][0][m][0][i], a1 = acc[ai][0][m][1][i];
                    h0[i] = (a0 * acc[ai][1][m][0][i]) * rs2 * __builtin_amdgcn_rcpf(1.0f + __builtin_amdgcn_exp2f(a0 * nrl));
                    h1[i] = (a1 * acc[ai][1][m][1][i]) * rs2 * __builtin_amdgcn_rcpf(1.0f + __builtin_amdgcn_exp2f(a1 * nrl));
                }
                *(u32x4*)(HID + (size_t)row * FH + colb) = pk8(h0, h1);
            }
    }
};

struct EpiInOdd {
    static constexpr bool PERM = true;
    const float* SS; bf16_t* QKVUS; const float* qg; const float* kg; float* SVST; float* out;
    DI void operator()(const Acc& acc, const pg8::Unit& u, int wr, int wc, int fr, int fq) const {
        const int typ = u.pn >> 1, ph = u.pn & 1;
        bf16_t* O = QKVUS + (size_t)typ * ((size_t)MT * MW);
        const bool samp = (u.pm == 128);
        const bool keep = samp || ((u.pm & 15) >= 14);
        float rsv[2][4];
#pragma unroll
        for (int ai = 0; ai < 2; ++ai)
#pragma unroll
            for (int m = 0; m < 4; ++m) rsv[ai][m] = row_rstd(SS, u.pm * 256 + ai * 128 + wr * 64 + m * 16 + fr);
        if (typ < 2) {
            const float* gsrc = typ == 0 ? qg : kg;
            f32x4 gv[2][2];
#pragma unroll
            for (int bj = 0; bj < 2; ++bj)
#pragma unroll
                for (int n = 0; n < 2; ++n) gv[bj][n] = *(const f32x4*)(gsrc + 32 * bj + 8 * fq + 4 * n);
            const float osc = typ == 0 ? QSCALE : 1.0f;
            const int head = ph * 4 + wc;
#pragma unroll
            for (int ai = 0; ai < 2; ++ai)
#pragma unroll
                for (int m = 0; m < 4; ++m) {
                    const int row = u.pm * 256 + ai * 128 + wr * 64 + m * 16 + fr;
                    const float rs = rsv[ai][m];
                    f32x4 v[2][2]; float ssq = 0.f;
#pragma unroll
                    for (int bj = 0; bj < 2; ++bj)
#pragma unroll
                        for (int n = 0; n < 2; ++n) { v[bj][n] = acc[ai][bj][m][n] * rs; const f32x4 t = v[bj][n]; ssq += (t[0] * t[0] + t[1] * t[1]) + (t[2] * t[2] + t[3] * t[3]); }
                    ssq += __shfl_xor(ssq, 16); ssq += __shfl_xor(ssq, 32);
                    const float r = rsqrtf(ssq * (1.0f / 64.0f) + 1e-6f);
#pragma unroll
                    for (int bj = 0; bj < 2; ++bj) {
                        const f32x4 o0 = v[bj][0] * r * gv[bj][0], o1 = v[bj][1] * r * gv[bj][1];
                        *(u32x4*)(O + (size_t)row * MW + head * 64 + 32 * bj + 8 * fq) = pk8(o0 * osc, o1 * osc);
                        if (typ == 1 && keep && !(samp && ai == 1)) {
                            float* dst;
                            if (samp) dst = out + O_KS + (size_t)(row - MP) * 512;
                            else { const int b = u.pm >> 4, t = (u.pm & 15) * 256 + ai * 128 + wr * 64 + m * 16 + fr - 3584; dst = out + O_KP + ((size_t)b * 512 + t) * 512; }
                            dst += head * 64 + 32 * bj + 8 * fq;
                            *(f32x4*)dst = o0; *(f32x4*)(dst + 4) = o1;
                        }
                    }
                }
        } else {
#pragma unroll
            for (int ai = 0; ai < 2; ++ai)
#pragma unroll
                for (int m = 0; m < 4; ++m) {
                    const int row = u.pm * 256 + ai * 128 + wr * 64 + m * 16 + fr;
                    const float rs = rsv[ai][m];
                    float s1 = 0.f, s2 = 0.f;
#pragma unroll
                    for (int bj = 0; bj < 2; ++bj) {
                        const f32x4 o0 = acc[ai][bj][m][0] * rs, o1 = acc[ai][bj][m][1] * rs;
                        const int col = ph * 256 + bj * 128 + wc * 32 + fq * 8;
                        *(u32x4*)(O + (size_t)row * MW + col) = pk8(o0, o1);
                        if (typ == 4) {
                            s1 += (o0[0] + o0[1]) + (o0[2] + o0[3]) + (o1[0] + o1[1]) + (o1[2] + o1[3]);
                            s2 += (o0[0] * o0[0] + o0[1] * o0[1]) + (o0[2] * o0[2] + o0[3] * o0[3]) + (o1[0] * o1[0] + o1[1] * o1[1]) + (o1[2] * o1[2] + o1[3] * o1[3]);
                        }
                        if (typ == 2 && keep && !(samp && ai == 1)) {
                            float* dst;
                            if (samp) dst = out + O_VS + (size_t)(row - MP) * 512;
                            else { const int b = u.pm >> 4, t = (u.pm & 15) * 256 + ai * 128 + wr * 64 + m * 16 + fr - 3584; dst = out + O_VP + ((size_t)b * 512 + t) * 512; }
                            dst += col;
                            *(f32x4*)dst = o0; *(f32x4*)(dst + 4) = o1;
                        }
                    }
                    if (typ == 4) {
                        s1 += __shfl_xor(s1, 16); s1 += __shfl_xor(s1, 32); s2 += __shfl_xor(s2, 16); s2 += __shfl_xor(s2, 32);
                        if (fq == 0) *(f32x2*)(SVST + ((size_t)row * 8 + ph * 4 + wc) * 2) = (f32x2){s1, s2};
                    }
                }
        }
    }
};


DI float red16(float v) { v += __shfl_xor(v, 1); v += __shfl_xor(v, 2); v += __shfl_xor(v, 4); v += __shfl_xor(v, 8); return v; }
DI f32x4 shx8(const f32x4 v) { f32x4 o; o[0] = __shfl_xor(v[0], 8); o[1] = __shfl_xor(v[1], 8); o[2] = __shfl_xor(v[2], 8); o[3] = __shfl_xor(v[3], 8); return o; }
DI u32x2 pk4(const f32x4 a) { return (u32x2){pk2(a[0], a[1]), pk2(a[2], a[3])}; }

struct SEpiInEven {
    const float* SS; bf16_t *A0, *Z0, *GB0;
    DI void operator()(const f32x4 vraw, int row, int pn, int wc, int bj, int cl) const {
        const f32x4 v = vraw * row_rstd(SS, row);
        const f32x4 o = shx8(v);
        if (pn < 8) {
            if (bj == 0) {
                f32x4 y = o;
                if (pn < 4) {
#pragma unroll
                    for (int i = 0; i < 4; ++i) y[i] = sigmoidf_(y[i]);
                }
                bf16_t* O = (pn < 4) ? A0 : Z0;
                *(u32x2*)(O + (size_t)row * MW + (pn & 3) * 128 + wc * 32 + cl) = pk4(v * y);
            }
        } else *(u32x2*)(GB0 + (size_t)row * MW + (pn - 8) * 256 + bj * 128 + wc * 32 + cl) = pk4(v);
    }
};
template <int MODE> struct SEpiResid {
    const float* xin; float* out; bf16_t* XN; float* SS;
    DI void operator()(const f32x4 v, int row, int pn, int wc, int bj, int cl) const {
        const int col = pn * 256 + bj * 128 + wc * 32 + cl;
        f32x4 x;
        if (MODE == 0) x = *(const f32x4*)(xin + (size_t)row * D + col);
        else { const u32x2 w = *(const u32x2*)(XN + (size_t)row * D + col); x = (f32x4){bflo(w.x), bfhi(w.x), bflo(w.y), bfhi(w.y)}; }
        x += v;
        if (MODE == 2) *(f32x4*)(out + (size_t)row * D + col) = x;
        else {
            *(u32x2*)(XN + (size_t)row * D + col) = pk4(x);
            const float ssq = red16((x[0] * x[0] + x[1] * x[1]) + (x[2] * x[2] + x[3] * x[3]));
            if ((threadIdx.x & 15) == 0) atomicAdd(SS + row, ssq);
        }
    }
};
struct SEpiGateUp {
    const float* SS; bf16_t* HID;
    DI void operator()(const f32x4 v, int row, int pn, int wc, int bj, int cl) const {
        const float rs = row_rstd(SS, row);
        const f32x4 o = shx8(v);
        if (bj == 0) {
            f32x4 hv;
#pragma unroll
            for (int i = 0; i < 4; ++i) { const float g0 = v[i] * rs; hv[i] = g0 * sigmoidf_(g0) * (o[i] * rs); }
            *(u32x2*)(HID + (size_t)row * FH + pn * 128 + wc * 32 + cl) = pk4(hv);
        }
    }
};
struct SEpiInOdd {
    const float* SS; bf16_t* QKVUS; const float* qg; const float* kg; float* SVST; float* out;
    DI void operator()(const f32x4 v, int row, int pn, int wc, int bj, int cl) const {
        const int typ = pn >> 1, ph = pn & 1;
        bf16_t* O = QKVUS + (size_t)typ * ((size_t)MT * MW);
        const float rs = row_rstd(SS, row);
        const f32x4 x = v * rs;
        if (typ < 2) {
            const int head = ph * 4 + wc, dd = 32 * bj + cl;
            const float ssq = red16((x[0] * x[0] + x[1] * x[1]) + (x[2] * x[2] + x[3] * x[3]));
            const float r = rsqrtf(ssq * (1.0f / 64.0f) + 1e-6f);
            const f32x4 gv = *(const f32x4*)((typ == 0 ? qg : kg) + dd);
            const f32x4 o = x * r * gv;
            *(u32x2*)(O + (size_t)row * MW + head * 64 + dd) = pk4(o * (typ == 0 ? QSCALE : 1.0f));
            if (typ == 1) *(f32x4*)(out + O_KS + (size_t)(row - MP) * 512 + head * 64 + dd) = o;
        } else {
            const int col = ph * 256 + bj * 128 + wc * 32 + cl;
            *(u32x2*)(O + (size_t)row * MW + col) = pk4(x);
            if (typ == 2) *(f32x4*)(out + O_VS + (size_t)(row - MP) * 512 + col) = x;
            if (typ == 4) {
                const float s1 = red16((x[0] + x[1]) + (x[2] + x[3])), s2 = red16((x[0] * x[0] + x[1] * x[1]) + (x[2] * x[2] + x[3] * x[3]));
                if ((threadIdx.x & 15) == 0) *(f32x2*)(SVST + ((size_t)row * 8 + ph * 4 + wc) * 2) = (f32x2){s1, s2};
            }
        }
    }
};

template <class EpiS>
DI void sample_gemm(LAS unsigned char* lds, const bf16_t* A, const bf16_t* Bt, int nN, int K, const EpiS& E) {
    const int tid = threadIdx.x, lane = tid & 63, w = __builtin_amdgcn_readfirstlane(tid >> 6), r32 = lane & 31, h = lane >> 5;
    const int nunits = 16 * nN, kw = K >> 3, nk = kw >> 4;
    for (int un = (int)blockIdx.x; un < nunits; un += (int)gridDim.x) {
        const int rb = un & 3, wc = (un >> 2) & 3, pn = un >> 4;
        const bf16_t* ap = A + (size_t)(MP + rb * 32 + r32) * K + w * kw + h * 8;
        const bf16_t* b0p = Bt + (size_t)(pn * 256 + wc * 32 + r32) * K + w * kw + h * 8;
        const bf16_t* b1p = b0p + (size_t)128 * K;
        f32x16 c0, c1;
#pragma unroll
        for (int r = 0; r < 16; ++r) { c0[r] = 0.f; c1[r] = 0.f; }
#pragma unroll 8
        for (int ks = 0; ks < nk; ++ks) {
            const bf16x8 a = *(const bf16x8*)(ap + ks * 16), b0 = *(const bf16x8*)(b0p + ks * 16), b1 = *(const bf16x8*)(b1p + ks * 16);
            c0 = __builtin_amdgcn_mfma_f32_32x32x16_bf16(a, b0, c0, 0, 0, 0);
            c1 = __builtin_amdgcn_mfma_f32_32x32x16_bf16(a, b1, c1, 0, 0, 0);
        }
        __syncthreads();
        LAS float* part = (LAS float*)(lds + w * 8192);
#pragma unroll
        for (int r = 0; r < 16; ++r) { const int row = (r & 3) + 8 * (r >> 2) + 4 * h; part[row * 64 + r32] = c0[r]; part[row * 64 + 32 + r32] = c1[r]; }
        __syncthreads();
        f32x4 v = (f32x4){0.f, 0.f, 0.f, 0.f};
#pragma unroll
        for (int ww = 0; ww < 8; ++ww) v += *(const LAS f32x4*)(lds + ww * 8192 + (tid >> 4) * 256 + (tid & 15) * 16);
        E(v, MP + rb * 32 + (tid >> 4), pn, wc, (tid >> 3) & 1, 4 * (tid & 7));
    }
    __syncthreads();
}

struct Params {
    const float* in[27];
    float* out;
    unsigned char* ws;
    int ph_lo, ph_hi;
};

DI int map_col(int kind, int n) {
    if (kind == 1) { const int seg = n >> 9, o = n & 511, t = o >> 7, r = o & 127;
        if (seg == 0) return t * 256 + r; if (seg == 1) return t * 256 + 128 + r; if (seg == 2) return 2048 + o;
        if (seg == 3) return 1024 + t * 256 + r; return 1024 + t * 256 + 128 + r; }
    if (kind == 2) { const int up = n >= FH ? 1 : 0, o = up ? n - FH : n; return (o >> 7) * 256 + up * 128 + (o & 127); }
    if (kind == 3) { if (n >= 1024) return n; const int t = n >> 8, hl = (n >> 6) & 3, dd = n & 63; return t * 256 + (dd >> 5) * 128 + hl * 32 + (dd & 31); }
    return n;
}
DI void transpose_item(const float* W, int K, int N, bf16_t* WT, int kind, const float* gain, LAS float* scr, int item, int lane) {
    const int nblk = N / 64, kb = item / nblk, nb = item % nblk, k0 = 64 * kb, n0 = 64 * nb;
    const int lr = lane >> 4, lc = (lane & 15) * 4;
    f32x4 v[16];
#pragma unroll
    for (int i = 0; i < 16; ++i) v[i] = __builtin_nontemporal_load((const f32x4*)(W + (size_t)(k0 + 4 * i + lr) * N + n0 + lc));
    if (gain) {
        float gk[16];
#pragma unroll
        for (int i = 0; i < 16; ++i) gk[i] = gain[k0 + 4 * i + lr];
#pragma unroll
        for (int i = 0; i < 16; ++i) v[i] *= gk[i];
    }
#pragma unroll
    for (int i = 0; i < 16; ++i) { LAS float* d = scr + (4 * i + lr) * 65 + lc; d[0] = v[i][0]; d[1] = v[i][1]; d[2] = v[i][2]; d[3] = v[i][3]; }
    asm volatile("s_waitcnt lgkmcnt(0)" ::: "memory");
    const int c = lane & 7;
#pragma unroll
    for (int j = 0; j < 8; ++j) { const int n = (lane >> 3) + 8 * j; const LAS float* s = scr + (8 * c) * 65 + n;
        u32x4 o; o.x = pk2(s[0 * 65], s[1 * 65]); o.y = pk2(s[2 * 65], s[3 * 65]); o.z = pk2(s[4 * 65], s[5 * 65]); o.w = pk2(s[6 * 65], s[7 * 65]);
        *(u32x4*)(WT + (size_t)map_col(kind, n0 + n) * K + k0 + 8 * c) = o; }
    asm volatile("s_waitcnt lgkmcnt(0)" ::: "memory");
}

DI void phase_prologue(const Params& p, LAS unsigned char* lds) {
    const int tid = threadIdx.x, lane = tid & 63, wave = tid >> 6;
    LAS float* scr = (LAS float*)(lds + wave * 16896);
    const int gw = blockIdx.x * 8 + wave, NGW = gridDim.x * 8;
    unsigned char* ws = p.ws;
    bf16_t* XN = (bf16_t*)(ws + WS_XN);
    float* SS = (float*)(ws + WS_SS);
    for (int q = gw; q < MT / 4; q += NGW) {
        const int row0 = q * 4;
        if (row0 < MREAL) {
            f32x4 v[4][4];
#pragma unroll
            for (int r = 0; r < 4; ++r) {
                const int row = row0 + r;
                const float* src = row < MP ? p.in[0] + (size_t)row * D : p.in[1] + (size_t)(row - MP) * D;
                const f32x4* xr = (const f32x4*)src + lane;
#pragma unroll
                for (int j = 0; j < 4; ++j) v[r][j] = __builtin_nontemporal_load(xr + 64 * j);
            }
#pragma unroll
            for (int r = 0; r < 4; ++r) {
                const int row = row0 + r;
                float s = 0.f;
#pragma unroll
                for (int j = 0; j < 4; ++j) s += (v[r][j][0] * v[r][j][0] + v[r][j][1] * v[r][j][1]) + (v[r][j][2] * v[r][j][2] + v[r][j][3] * v[r][j][3]);
                s = wave_sum(s);
                u32x2* o8 = (u32x2*)(XN + (size_t)row * D) + lane;
#pragma unroll
                for (int j = 0; j < 4; ++j) o8[64 * j] = (u32x2){pk2(v[r][j][0], v[r][j][1]), pk2(v[r][j][2], v[r][j][3])};
                if (lane < 4) SS[(size_t)lane * MT + row] = lane == 0 ? s : 0.f;
            }
        } else {
#pragma unroll
            for (int r = 0; r < 4; ++r) { u32x2* o8 = (u32x2*)(XN + (size_t)(row0 + r) * D) + lane;
#pragma unroll
                for (int j = 0; j < 4; ++j) o8[64 * j] = (u32x2){0u, 0u}; }
        }
    }
    constexpr int I_IN = 16 * 40, I_OUT = 16 * 16, I_GU = 16 * 88, I_DN = 44 * 16, I_L = I_IN + I_OUT + I_GU + I_DN;
    for (int it = gw; it < 2 * I_L; it += NGW) {
        const int L = it >= I_L ? 1 : 0; int r = it - L * I_L;
        if (r < I_IN) { transpose_item(L ? p.in[15] : p.in[7], D, PW, (bf16_t*)(ws + (L ? WS_WIN1 : WS_WIN0)), L ? 3 : 1, L ? p.in[14] : p.in[6], scr, r, lane); continue; } r -= I_IN;
        if (r < I_OUT) { transpose_item(L ? p.in[23] : p.in[13], D, D, (bf16_t*)(ws + (L ? WS_WOUT1 : WS_WOUT0)), 0, nullptr, scr, r, lane); continue; } r -= I_OUT;
        if (r < I_GU) { transpose_item(p.in[25] + (size_t)L * D * 2 * FH, D, 2 * FH, (bf16_t*)(ws + (L ? WS_WGU1 : WS_WGU0)), 2, p.in[24] + L * D, scr, r, lane); continue; } r -= I_GU;
        transpose_item(p.in[26] + (size_t)L * FH * D, FH, D, (bf16_t*)(ws + (L ? WS_WDN1 : WS_WDN0)), 0, nullptr, scr, r, lane);
    }
}


DI float dot2bf(unsigned a, unsigned b, float c) { return __builtin_amdgcn_fdot2_f32_bf16(__builtin_bit_cast(bf16x2_t, a), __builtin_bit_cast(bf16x2_t, b), c, false); }
DI void st8f(float* dst, const u32x4 w) { float f[8]; unpack8(w, f); *(f32x4*)dst = (f32x4){f[0], f[1], f[2], f[3]}; *(f32x4*)(dst + 4) = (f32x4){f[4], f[5], f[6], f[7]}; }

constexpr int CV_PAR = 98304;
DI void phase_conv(const Params& p, LAS unsigned char* lds) {
    const int tid = threadIdx.x, lane = tid & 63, wid = __builtin_amdgcn_readfirstlane(tid >> 6);
    unsigned char* ws = p.ws;
    const bf16_t* A0 = (const bf16_t*)(ws + WS_A); const bf16_t* Z0 = (const bf16_t*)(ws + WS_A + SUB); const bf16_t* GB0 = (const bf16_t*)(ws + WS_A + 2 * SUB);
    bf16_t* CAT = (bf16_t*)(ws + WS_CAT);
    const float* cache_a = p.in[2]; const float* cache_b = p.in[3];
    const float* caw = p.in[8];
    float* out = p.out;
    const int c0 = lane * 8, par = wid >> 2;
    __syncthreads();
    {
        LAS float* pr = (LAS float*)(lds + CV_PAR);
        for (int i = tid; i < 512; i += 512) { pr[i] = p.in[9][i]; pr[512 + i] = p.in[10][i]; pr[1024 + i] = p.in[11][i]; pr[1536 + i] = p.in[12][i]; pr[2048 + i] = p.in[12][512 + i]; pr[2560 + i] = p.in[12][1024 + i]; }
    }
    unsigned wp[16][8];
#pragma unroll
    for (int i = 0; i < 16; ++i) {
        const int ja = par ? 2 * i - 1 : 2 * i, jb = ja + 1;
        f32x4 a0 = (f32x4){0.f, 0.f, 0.f, 0.f}, a1 = a0, b0 = a0, b1 = a0;
        if (ja >= 0) { a0 = *(const f32x4*)(caw + ja * MW + c0); a1 = *(const f32x4*)(caw + ja * MW + c0 + 4); }
        if (jb <= 30) { b0 = *(const f32x4*)(caw + jb * MW + c0); b1 = *(const f32x4*)(caw + jb * MW + c0 + 4); }
#pragma unroll
        for (int k = 0; k < 4; ++k) { asm volatile("v_cvt_pk_bf16_f32 %0, %1, %2" : "=v"(wp[i][k]) : "v"(a0[k]), "v"(b0[k])); asm volatile("v_cvt_pk_bf16_f32 %0, %1, %2" : "=v"(wp[i][4 + k]) : "v"(a1[k]), "v"(b1[k])); }
    }
    for (int un = blockIdx.x; un < 520; un += gridDim.x) {
        const bool samp = un >= 512;
        const int b = samp ? un - 512 : un >> 6, t0 = samp ? 0 : (un & 63) * 64, R = samp ? 16 : 64;
        const size_t rowbase = samp ? (size_t)MP + b * 16 : (size_t)b * SEQ;
        __syncthreads();
        for (int pr_ = wid; pr_ < (R + 30) / 2; pr_ += 8) {
            u32x4 v0 = (u32x4){0u, 0u, 0u, 0u}, v1 = v0;
            const int ta = t0 - 30 + 2 * pr_;
            if (ta >= 0) { v0 = *(const u32x4*)(A0 + (rowbase + ta) * MW + c0); v1 = *(const u32x4*)(A0 + (rowbase + ta + 1) * MW + c0); }
            else if (samp) { const f32x4* s0 = (const f32x4*)(cache_a + ((size_t)b * 30 + (30 + ta)) * MW + c0); const f32x4* s1 = s0 + MW / 4; v0 = pk8(s0[0], s0[1]); v1 = pk8(s1[0], s1[1]); }
            u32x4 e0, e1;
            e0.x = (v0.x & 0xffffu) | (v1.x << 16); e0.y = (v0.x >> 16) | (v1.x & 0xffff0000u); e0.z = (v0.y & 0xffffu) | (v1.y << 16); e0.w = (v0.y >> 16) | (v1.y & 0xffff0000u);
            e1.x = (v0.z & 0xffffu) | (v1.z << 16); e1.y = (v0.z >> 16) | (v1.z & 0xffff0000u); e1.z = (v0.w & 0xffffu) | (v1.w << 16); e1.w = (v0.w >> 16) | (v1.w & 0xffff0000u);
            *(LAS u32x4*)(lds + pr_ * 2048 + lane * 16) = e0; *(LAS u32x4*)(lds + pr_ * 2048 + 1024 + lane * 16) = e1;
        }
        __syncthreads();
        const int nrow = R >> 3;
        for (int i = 0; i < nrow; ++i) {
            const int r = par + 2 * ((wid & 3) + 4 * i);
            const int t = t0 + r; const size_t row = rowbase + t;
            const u32x4 zz = *(const u32x4*)(Z0 + row * MW + c0), gbv = *(const u32x4*)(GB0 + row * MW + c0);
            u32x4 z1 = (u32x4){0u, 0u, 0u, 0u}, z2 = z1;
            if (t >= 1) z1 = *(const u32x4*)(Z0 + (row - 1) * MW + c0);
            else if (samp) { const f32x4* s = (const f32x4*)(cache_b + ((size_t)b * 2 + 1) * MW + c0); z1 = pk8(s[0], s[1]); }
            if (t >= 2) z2 = *(const u32x4*)(Z0 + (row - 2) * MW + c0);
            else if (samp) { const f32x4* s = (const f32x4*)(cache_b + ((size_t)b * 2 + t) * MW + c0); z2 = pk8(s[0], s[1]); }
            const LAS float* pr = (const LAS float*)(lds + CV_PAR) + c0;
            f32x4 ac0 = *(const LAS f32x4*)pr, ac1 = *(const LAS f32x4*)(pr + 4);
            const LAS unsigned char* eb = lds + (r >> 1) * 2048 + lane * 16;
#pragma unroll
            for (int q = 0; q < 16; ++q) {
                const u32x4 e0 = *(const LAS u32x4*)(eb + q * 2048), e1 = *(const LAS u32x4*)(eb + q * 2048 + 1024);
                ac0[0] = dot2bf(e0.x, wp[q][0], ac0[0]); ac0[1] = dot2bf(e0.y, wp[q][1], ac0[1]); ac0[2] = dot2bf(e0.z, wp[q][2], ac0[2]); ac0[3] = dot2bf(e0.w, wp[q][3], ac0[3]);
                ac1[0] = dot2bf(e1.x, wp[q][4], ac1[0]); ac1[1] = dot2bf(e1.y, wp[q][5], ac1[1]); ac1[2] = dot2bf(e1.z, wp[q][6], ac1[2]); ac1[3] = dot2bf(e1.w, wp[q][7], ac1[3]);
                if ((q & 1) == 1) __builtin_amdgcn_sched_barrier(0);
            }
            const float mean = wave_sum((ac0[0] + ac0[1]) + (ac0[2] + ac0[3]) + (ac1[0] + ac1[1]) + (ac1[2] + ac1[3])) * (1.0f / 512.0f);
            ac0 -= mean; ac1 -= mean;
            const float rstd = rsqrtf(wave_sum((ac0[0] * ac0[0] + ac0[1] * ac0[1]) + (ac0[2] * ac0[2] + ac0[3] * ac0[3]) + (ac1[0] * ac1[0] + ac1[1] * ac1[1]) + (ac1[2] * ac1[2] + ac1[3] * ac1[3])) * (1.0f / 512.0f) + 1e-5f);
            const f32x4 g0 = *(const LAS f32x4*)(pr + 512), g1 = *(const LAS f32x4*)(pr + 516), b0 = *(const LAS f32x4*)(pr + 1024), b1 = *(const LAS f32x4*)(pr + 1028);
            f32x4 y0 = ac0 * rstd * g0 + b0, y1 = ac1 * rstd * g1 + b1;
#pragma unroll
            for (int k = 0; k < 4; ++k) { y0[k] *= sigmoidf_(y0[k]); y1[k] *= sigmoidf_(y1[k]); }
            *(u32x4*)(CAT + row * D + c0) = pk8(y0, y1);
            float fz[8], f1[8], f2[8], fg[8];
            unpack8(zz, fz); unpack8(z1, f1); unpack8(z2, f2); unpack8(gbv, fg);
            const f32x4 w00 = *(const LAS f32x4*)(pr + 1536), w01 = *(const LAS f32x4*)(pr + 1540), w10 = *(const LAS f32x4*)(pr + 2048), w11 = *(const LAS f32x4*)(pr + 2052), w20 = *(const LAS f32x4*)(pr + 2560), w21 = *(const LAS f32x4*)(pr + 2564);
            f32x4 o0, o1;
#pragma unroll
            for (int k = 0; k < 4; ++k) { o0[k] = fg[k] * (w00[k] * f2[k] + w10[k] * f1[k] + w20[k] * fz[k]); o1[k] = fg[4 + k] * (w01[k] * f2[4 + k] + w11[k] * f1[4 + k] + w21[k] * fz[4 + k]); }
            *(u32x4*)(CAT + row * D + MW + c0) = pk8(o0, o1);
        }
        if (!samp && (un & 63) == 63) {
            for (int i = wid; i < 30; i += 8) st8f(out + O_CAP + ((size_t)b * 30 + i) * MW + c0, *(const u32x4*)(A0 + (rowbase + 4066 + i) * MW + c0));
            if (wid < 2) st8f(out + O_CBP + ((size_t)b * 2 + wid) * MW + c0, *(const u32x4*)(Z0 + (rowbase + 4094 + wid) * MW + c0));
        }
        if (samp) {
            for (int i = wid; i < 30; i += 8) {
                float* dst = out + O_CAS + ((size_t)b * 30 + i) * MW + c0;
                if (i < 14) { const f32x4* s = (const f32x4*)(cache_a + ((size_t)b * 30 + 16 + i) * MW + c0); *(f32x4*)dst = s[0]; *(f32x4*)(dst + 4) = s[1]; }
                else st8f(dst, *(const u32x4*)(A0 + (rowbase + i - 14) * MW + c0));
            }
            if (wid < 2) st8f(out + O_CBS + ((size_t)b * 2 + wid) * MW + c0, *(const u32x4*)(Z0 + (rowbase + 14 + wid) * MW + c0));
        }
    }
    __syncthreads();
}

typedef short v4i16_t __attribute__((ext_vector_type(4)));
DI s16x4 tr_read(const LAS unsigned char* p) { return __builtin_bit_cast(s16x4, __builtin_amdgcn_ds_read_tr16_b64_v4i16((LAS v4i16_t*)p)); }
#define VFR(lo, hi) ((bf16x8){lo[0], lo[1], lo[2], lo[3], hi[0], hi[1], hi[2], hi[3]})
constexpr int KSTR = 272, VSTR = 320, AT_V = 64 * KSTR, AT_BUF = AT_V + 64 * VSTR, AT_B = 2 * AT_BUF;

template <bool SAMPLE>
DI void attn_load_tile(const Params& p, int b, int cp, int hp, int j, u32x4 (&kr)[2], u32x4 (&vr)[2]) {
    const int tid = threadIdx.x, chunk = tid & 15, k0 = tid >> 4;
    const bf16_t* Kb = (const bf16_t*)(p.ws + WS_A + SUB); const bf16_t* Vb = (const bf16_t*)(p.ws + WS_A + 2 * SUB);
#pragma unroll
    for (int i = 0; i < 2; ++i) {
        const int key = i * 32 + k0;
        if (!SAMPLE) {
            const size_t row = (size_t)b * SEQ + (size_t)(2 * cp - 8 + j) * 64 + key;
            kr[i] = *(const u32x4*)(Kb + row * MW + hp * 128 + chunk * 8);
            vr[i] = *(const u32x4*)(Vb + row * MW + hp * 128 + chunk * 8);
        } else {
            if (j < 8) {
                const size_t off = ((size_t)b * 512 + 64 * j + key) * 512 + hp * 128 + chunk * 8;
                const f32x4* ks = (const f32x4*)(p.in[4] + off); const f32x4* vs = (const f32x4*)(p.in[5] + off);
                kr[i] = pk8(ks[0], ks[1]); vr[i] = pk8(vs[0], vs[1]);
            } else if (key < 16) {
                const size_t row = (size_t)MP + b * 16 + key;
                kr[i] = *(const u32x4*)(Kb + row * MW + hp * 128 + chunk * 8);
                vr[i] = *(const u32x4*)(Vb + row * MW + hp * 128 + chunk * 8);
            } else { kr[i] = (u32x4){0u, 0u, 0u, 0u}; vr[i] = (u32x4){0u, 0u, 0u, 0u}; }
        }
    }
}
DI void attn_store_tile(LAS unsigned char* buf, const u32x4 (&kr)[2], const u32x4 (&vr)[2]) {
    const int tid = threadIdx.x, chunk = tid & 15, k0 = tid >> 4;
#pragma unroll
    for (int i = 0; i < 2; ++i) { const int key = i * 32 + k0;
        *(LAS u32x4*)(buf + key * KSTR + chunk * 16) = kr[i];
        *(LAS u32x4*)(buf + AT_V + key * VSTR + chunk * 16) = vr[i]; }
}

template <int BM, bool SMASK>
DI void attn_tile(const LAS unsigned char* kbase, const LAS unsigned char* vbase, const LAS float* bth, int ibase, int h, const bf16x8 (&qf)[4], f32x16& o0, f32x16& o1, float& lsum) {
#pragma unroll
    for (int kb = 0; kb < 2; ++kb) {
        f32x16 pa;
#pragma unroll
        for (int r = 0; r < 16; ++r) pa[r] = 0.f;
#pragma unroll
        for (int d0 = 0; d0 < 4; ++d0) { const bf16x8 a = *(const LAS bf16x8*)(kbase + kb * 32 * KSTR + d0 * 32); pa = __builtin_amdgcn_mfma_f32_32x32x16_bf16(a, qf[d0], pa, 0, 0, 0); }
        if (BM == 0) {
            const float cb = bth[512];
#pragma unroll
            for (int r = 0; r < 16; ++r) pa[r] += cb;
        } else if (BM == 1) {
#pragma unroll
            for (int r = 0; r < 16; ++r) { int idx = ibase - 32 * kb - ((r & 3) + 8 * (r >> 2)); idx = idx > 512 ? 512 : idx; pa[r] += bth[idx]; }
        } else {
            const LAS float* bp = bth + (ibase - 32 * kb - 27);
#pragma unroll
            for (int r = 0; r < 16; ++r) pa[r] += bp[27 - ((r & 3) + 8 * (r >> 2))];
        }
#pragma unroll
        for (int r = 0; r < 16; ++r) pa[r] = __builtin_amdgcn_exp2f(pa[r]);
        if (SMASK) {
#pragma unroll
            for (int r = 0; r < 16; ++r) { const int key = 32 * kb + (r & 3) + 8 * (r >> 2) + 4 * h; if (key >= 16) pa[r] = 0.f; }
        }
#pragma unroll
        for (int r = 0; r < 16; ++r) lsum += pa[r];
#pragma unroll
        for (int s = 0; s < 2; ++s) {
            u32x4 pw; pw.x = pk2(pa[8 * s], pa[8 * s + 1]); pw.y = pk2(pa[8 * s + 2], pa[8 * s + 3]); pw.z = pk2(pa[8 * s + 4], pa[8 * s + 5]); pw.w = pk2(pa[8 * s + 6], pa[8 * s + 7]);
            const bf16x8 pb = __builtin_bit_cast(bf16x8, pw);
            const LAS unsigned char* va = vbase + (kb * 32 + 16 * s) * VSTR;
            { const s16x4 lo = tr_read(va), hi = tr_read(va + 8 * VSTR); o0 = __builtin_amdgcn_mfma_f32_32x32x16_bf16(VFR(lo, hi), pb, o0, 0, 0, 0); }
            { const s16x4 lo = tr_read(va + 64), hi = tr_read(va + 64 + 8 * VSTR); o1 = __builtin_amdgcn_mfma_f32_32x32x16_bf16(VFR(lo, hi), pb, o1, 0, 0, 0); }
        }
    }
}

template <bool SAMPLE>
DI void attn_unit(const Params& p, LAS unsigned char* lds, int b, int cp, int hp) {
    int tid_ = threadIdx.x; asm volatile("" : "+v"(tid_));
    const int tid = tid_, lane = tid & 63, w = __builtin_amdgcn_readfirstlane(tid >> 6), r32 = lane & 31, h = lane >> 5;
    const int cl = SAMPLE ? 0 : (w >> 2), hl = (w >> 1) & 1, head = hp * 2 + hl, qoff = SAMPLE ? 0 : 32 * (w & 1);
    const bf16_t* Qb = (const bf16_t*)(p.ws + WS_A);
    bf16_t* CAT = (bf16_t*)(p.ws + WS_CAT);
    const size_t qrow = SAMPLE ? (size_t)MP + b * 16 + (r32 & 15) : (size_t)b * SEQ + (2 * cp + cl) * 64 + qoff + r32;
    bf16x8 qf[4];
#pragma unroll
    for (int d0 = 0; d0 < 4; ++d0) qf[d0] = *(const bf16x8*)(Qb + qrow * MW + head * 64 + d0 * 16 + h * 8);
    LAS float* bt = (LAS float*)(lds + AT_B);
    const int j_first = SAMPLE ? 0 : (cp >= 4 ? 0 : 8 - 2 * cp), j_last = SAMPLE ? 8 : 9;
    u32x4 ka[2], va_[2], kb_[2], vb_[2];
    attn_load_tile<SAMPLE>(p, b, cp, hp, j_first, ka, va_);
    __syncthreads();
    attn_store_tile(lds + (j_first & 1) * AT_BUF, ka, va_);
    attn_load_tile<SAMPLE>(p, b, cp, hp, j_first + 1, ka, va_);
    if (j_first + 2 <= j_last) attn_load_tile<SAMPLE>(p, b, cp, hp, j_first + 2, kb_, vb_);
    f32x16 o0, o1;
#pragma unroll
    for (int r = 0; r < 16; ++r) { o0[r] = 0.f; o1[r] = 0.f; }
    float lsum = 0.f;
    const int i16 = lane & 15, qd = i16 >> 2, pp = i16 & 3, g16 = (lane >> 4) & 1;
    const int koff = r32 * KSTR + hl * 128 + h * 16;
    const int voff = AT_V + (4 * h + qd) * VSTR + hl * 128 + (16 * g16 + 4 * pp) * 2;
    const LAS float* bth = bt + hl * 516;
#define ATT_STEP(j, KR, VR) do { \
        __syncthreads();                                        \
        if ((j) < j_last) { attn_store_tile(lds + (((j) + 1) & 1) * AT_BUF, KR, VR); if ((j) + 3 <= j_last) attn_load_tile<SAMPLE>(p, b, cp, hp, (j) + 3, KR, VR); } \
        const int t = (j) - cl; \
        if (t >= 0 && t <= 8) { \
            const LAS unsigned char* bufp = lds + ((j) & 1) * AT_BUF; \
            const int ibase = 768 - 64 * t + qoff + r32 - 4 * h; \
            if (t <= 3) attn_tile<0, false>(bufp + koff, bufp + voff, bth, ibase, h, qf, o0, o1, lsum); \
            else if (t == 4) attn_tile<1, false>(bufp + koff, bufp + voff, bth, ibase, h, qf, o0, o1, lsum); \
            else if (SAMPLE && t == 8) attn_tile<2, true>(bufp + koff, bufp + voff, bth, ibase, h, qf, o0, o1, lsum); \
            else attn_tile<2, false>(bufp + koff, bufp + voff, bth, ibase, h, qf, o0, o1, lsum); \
        } } while (0)
    for (int j = j_first; j <= j_last; j += 2) {
        ATT_STEP(j, ka, va_);
        if (j + 1 <= j_last) ATT_STEP(j + 1, kb_, vb_);
    }
#undef ATT_STEP
    lsum += __shfl_xor(lsum, 32);
    const float inv = 1.0f / lsum;
    const bool do_store = SAMPLE ? (w < 4 && (w & 1) == 0 && r32 < 16) : true;
    if (do_store) {
        bf16_t* dst = CAT + qrow * D + head * 64 + 4 * h;
#pragma unroll
        for (int gq = 0; gq < 4; ++gq) {
            *(u32x2*)(dst + 8 * gq) = (u32x2){pk2(o0[4 * gq] * inv, o0[4 * gq + 1] * inv), pk2(o0[4 * gq + 2] * inv, o0[4 * gq + 3] * inv)};
            *(u32x2*)(dst + 32 + 8 * gq) = (u32x2){pk2(o1[4 * gq] * inv, o1[4 * gq + 1] * inv), pk2(o1[4 * gq + 2] * inv, o1[4 * gq + 3] * inv)};
        }
    }
}

constexpr int SG_STR = 320, SG_LN = 49152;
struct SguRegs { f32x4 st[4]; u32x4 sv[4]; float bsv; };
DI void sgu_load(const Params& p, int uid, int tid, SguRegs& R) {
    const int b = uid >> 7, ch = (uid >> 2) & 31, g = uid & 3;
    const int lane = tid & 63, w = tid >> 6, r32 = lane & 31;
    const bf16_t* SVb = (const bf16_t*)(p.ws + WS_A + 4 * SUB);
    const float* SVST = (const float*)(p.ws + WS_SVST);
    const size_t r0 = (size_t)b * SEQ + ch * 128;
    const int srow = tid >> 2, qt = tid & 3;
    const f32x4* st = (const f32x4*)(SVST + (r0 + srow) * 16);
#pragma unroll
    for (int i = 0; i < 4; ++i) { R.st[i] = st[i]; R.sv[i] = *(const u32x4*)(SVb + (r0 + srow) * MW + g * 128 + qt * 32 + i * 8); }
    const int ib = w & 3, iloc = 32 * ib + r32;
    R.bsv = p.in[22][g * 128 + iloc];
}
DI void sgu_unit(const Params& p, LAS unsigned char* lds, int uid, int tid, const SguRegs& C, bool has_next, int uid_next, SguRegs& R) {
    const int b = uid >> 7, ch = (uid >> 2) & 31, g = uid & 3;
    const int lane = tid & 63, w = __builtin_amdgcn_readfirstlane(tid >> 6), r32 = lane & 31, h = lane >> 5;
    bf16_t* CAT = (bf16_t*)(p.ws + WS_CAT);
    const float* sw = p.in[21];
    const size_t r0 = (size_t)b * SEQ + ch * 128;
    const int ib = w & 3, dh = w >> 2, iloc = 32 * ib + r32;
    const size_t row = r0 + iloc;
    const float* Wrow = sw + ((size_t)g * 128 + iloc) * 128 + 8 * h;
    f32x4 wv[8][2];
#pragma unroll
    for (int js = 0; js < 8; ++js) { if (js <= 2 * ib + 1) { wv[js][0] = *(const f32x4*)(Wrow + 16 * js); wv[js][1] = *(const f32x4*)(Wrow + 16 * js + 4); } else { wv[js][0] = (f32x4){0.f, 0.f, 0.f, 0.f}; wv[js][1] = wv[js][0]; } }
    const bf16_t* Ub = (const bf16_t*)(p.ws + WS_A + 3 * SUB);
    u32x2 uu[2][4];
#pragma unroll
    for (int db = 0; db < 2; ++db)
#pragma unroll
        for (int gq = 0; gq < 4; ++gq) uu[db][gq] = *(const u32x2*)(Ub + row * MW + g * 128 + 64 * dh + 32 * db + 8 * gq + 4 * h);
    if (has_next) sgu_load(p, uid_next, tid, R);
    __syncthreads();
    {
        const int srow = tid >> 2, qt = tid & 3;
        const f32x4 a0 = C.st[0], a1 = C.st[1], a2 = C.st[2], a3 = C.st[3];
        const float s1 = (a0[0] + a0[2]) + (a1[0] + a1[2]) + (a2[0] + a2[2]) + (a3[0] + a3[2]);
        const float s2 = (a0[1] + a0[3]) + (a1[1] + a1[3]) + (a2[1] + a2[3]) + (a3[1] + a3[3]);
        const float mean = s1 * (1.0f / 512.0f), var = s2 * (1.0f / 512.0f) - mean * mean, rstd = rsqrtf(fmaxf(var, 0.f) + 1e-5f);
        const LAS float* lnp = (const LAS float*)(lds + SG_LN);
#pragma unroll
        for (int i = 0; i < 4; ++i) {
            const int c8 = qt * 32 + i * 8, ca = g * 128 + c8;
            float f[8]; unpack8(C.sv[i], f);
            const f32x4 g0 = *(const LAS f32x4*)(lnp + ca), g1 = *(const LAS f32x4*)(lnp + ca + 4), b0 = *(const LAS f32x4*)(lnp + 512 + ca), b1 = *(const LAS f32x4*)(lnp + 512 + ca + 4);
            f32x4 x0, x1;
#pragma unroll
            for (int k = 0; k < 4; ++k) { x0[k] = (f[k] - mean) * rstd * g0[k] + b0[k]; x1[k] = (f[4 + k] - mean) * rstd * g1[k] + b1[k]; }
            *(LAS u32x4*)(lds + srow * SG_STR + c8 * 2) = pk8(x0, x1);
        }
    }
    __syncthreads();
    const int i16 = lane & 15, qd = i16 >> 2, pp = i16 & 3, g16 = (lane >> 4) & 1;
    f32x16 acc0, acc1;
#pragma unroll
    for (int r = 0; r < 16; ++r) { acc0[r] = 0.f; acc1[r] = 0.f; }
    const LAS unsigned char* vb = lds + (8 * h + qd) * SG_STR + (64 * dh + 16 * g16 + 4 * pp) * 2;
#pragma unroll
    for (int js = 0; js < 8; ++js) {
        if (js <= 2 * ib + 1) {
            const int jb = 16 * js + 8 * h;
            f32x4 w0 = wv[js][0], w1 = wv[js][1];
#pragma unroll
            for (int k = 0; k < 4; ++k) { w0[k] = (jb + k <= iloc) ? w0[k] : 0.f; w1[k] = (jb + 4 + k <= iloc) ? w1[k] : 0.f; }
            const bf16x8 bw = __builtin_bit_cast(bf16x8, pk8(w0, w1));
            const LAS unsigned char* va = vb + js * 16 * SG_STR;
            { const s16x4 lo = tr_read(va), hi = tr_read(va + 4 * SG_STR); acc0 = __builtin_amdgcn_mfma_f32_32x32x16_bf16(VFR(lo, hi), bw, acc0, 0, 0, 0); }
            { const s16x4 lo = tr_read(va + 64), hi = tr_read(va + 64 + 4 * SG_STR); acc1 = __builtin_amdgcn_mfma_f32_32x32x16_bf16(VFR(lo, hi), bw, acc1, 0, 0, 0); }
        }
    }
    const float bsv = C.bsv;
#pragma unroll
    for (int gq = 0; gq < 4; ++gq) {
        const int d4 = 64 * dh + 8 * gq + 4 * h;
        { const u32x2 u2 = uu[0][gq];
          *(u32x2*)(CAT + row * D + MW + g * 128 + d4) = (u32x2){pk2(bflo(u2.x) * (acc0[4 * gq] + bsv), bfhi(u2.x) * (acc0[4 * gq + 1] + bsv)), pk2(bflo(u2.y) * (acc0[4 * gq + 2] + bsv), bfhi(u2.y) * (acc0[4 * gq + 3] + bsv))}; }
        { const u32x2 u2 = uu[1][gq];
          *(u32x2*)(CAT + row * D + MW + g * 128 + d4 + 32) = (u32x2){pk2(bflo(u2.x) * (acc1[4 * gq] + bsv), bfhi(u2.x) * (acc1[4 * gq + 1] + bsv)), pk2(bflo(u2.y) * (acc1[4 * gq + 2] + bsv), bfhi(u2.y) * (acc1[4 * gq + 3] + bsv))}; }
    }
}
DI void sgu_all(const Params& p, LAS unsigned char* lds, int first, int stride) {
    int tid_ = threadIdx.x; asm volatile("" : "+v"(tid_));
    const int tid = tid_;
    __syncthreads();
    { LAS float* lnp = (LAS float*)(lds + SG_LN); lnp[tid] = p.in[19][tid]; lnp[512 + tid] = p.in[20][tid]; }
    if (first >= 1024) { __syncthreads(); return; }
    SguRegs R; sgu_load(p, first, tid, R);
    for (int uid = first; uid < 1024; uid += stride) {
        const SguRegs C = R;
        sgu_unit(p, lds, uid, tid, C, uid + stride < 1024, uid + stride, R);
    }
    __syncthreads();
}

DI void sgu_sample_unit(const Params& p, LAS unsigned char* lds, int b) {
    int tid_ = threadIdx.x; asm volatile("" : "+v"(tid_));
    const int tid = tid_, lane = tid & 63, wid = tid >> 6;
    const bf16_t* Ub = (const bf16_t*)(p.ws + WS_A + 3 * SUB); const bf16_t* SVb = (const bf16_t*)(p.ws + WS_A + 4 * SUB);
    bf16_t* CAT = (bf16_t*)(p.ws + WS_CAT);
    const float* lng = p.in[19]; const float* lnb = p.in[20]; const float* sw = p.in[21]; const float* sb = p.in[22];
    LAS float* vn = (LAS float*)lds;
    const size_t r0 = (size_t)MP + b * 16;
    __syncthreads();
    for (int i = wid; i < 16; i += 8) {
        const int c0 = lane * 8;
        float f[8]; unpack8(*(const u32x4*)(SVb + (r0 + i) * MW + c0), f);
        float s = 0.f;
#pragma unroll
        for (int k = 0; k < 8; ++k) s += f[k];
        const float mean = wave_sum(s) * (1.0f / 512.0f);
        float q = 0.f;
#pragma unroll
        for (int k = 0; k < 8; ++k) { f[k] -= mean; q += f[k] * f[k]; }
        const float rstd = rsqrtf(wave_sum(q) * (1.0f / 512.0f) + 1e-5f);
        float* dst = p.out + O_SVS + ((size_t)b * 16 + i) * MW + c0;
#pragma unroll
        for (int k = 0; k < 8; ++k) { const float y = f[k] * rstd * lng[c0 + k] + lnb[c0 + k]; vn[i * 512 + c0 + k] = y; dst[k] = y; }
    }
    LAS float* wl = (LAS float*)(lds + 32768); LAS float* bl = wl + 1024;
    for (int i = tid; i < 1024; i += 512) wl[i] = sw[((size_t)(i >> 8) * 128 + ((i >> 4) & 15)) * 128 + (i & 15)];
    if (tid < 64) bl[tid] = sb[(tid >> 4) * 128 + (tid & 15)];
    const int cch = tid, g = cch >> 7;
    float uvv[16];
#pragma unroll
    for (int i = 0; i < 16; ++i) uvv[i] = bflo((unsigned)Ub[(r0 + i) * MW + cch]);
    __syncthreads();
    {
        float vv[16];
#pragma unroll
        for (int j = 0; j < 16; ++j) vv[j] = vn[j * 512 + cch];
#pragma unroll
        for (int i = 0; i < 16; ++i) {
            float s = bl[g * 16 + i];
#pragma unroll
            for (int j = 0; j <= i; ++j) s += wl[g * 256 + i * 16 + j] * vv[j];
            const unsigned o = pk2(uvv[i] * s, 0.f);
            CAT[(r0 + i) * D + MW + cch] = (bf16_t)(o & 0xffffu);
        }
    }
}

DI void phase_mix_odd(const Params& p, LAS unsigned char* lds) {
    const int blk = blockIdx.x;
    if (gridDim.x == 256) {
        {
            LAS float* bt = (LAS float*)(lds + AT_B); const float* relb = p.in[18]; const int hp = blk & 3;
            __syncthreads();
            for (int i = threadIdx.x; i < 2 * 513; i += 512) { const int hh = i >= 513 ? 1 : 0, j = i - hh * 513; bt[hh * 516 + j] = relb[(hp * 2 + hh) * 513 + j] * LOG2E; }
        }
        if (blk < 32) attn_unit<true>(p, lds, blk >> 2, 0, blk & 3);
        for (int uid = blk; uid < 1024; uid += 256) attn_unit<false>(p, lds, (uid & 31) >> 2, uid >> 5, uid & 3);
        if (blk >= 32 && blk < 40) sgu_sample_unit(p, lds, blk - 32);
        sgu_all(p, lds, blk, 256);
    } else {
        for (int uid = blk; uid < 1056; uid += gridDim.x) {
            { LAS float* bt = (LAS float*)(lds + AT_B); const float* relb = p.in[18]; const int hp = uid & 3;
              __syncthreads();
              for (int i = threadIdx.x; i < 2 * 513; i += 512) { const int hh = i >= 513 ? 1 : 0, j = i - hh * 513; bt[hh * 516 + j] = relb[(hp * 2 + hh) * 513 + j] * LOG2E; } }
            if (uid < 1024) attn_unit<false>(p, lds, (uid & 31) >> 2, uid >> 5, uid & 3);
            else { const int s_ = uid - 1024; attn_unit<true>(p, lds, s_ >> 2, 0, s_ & 3); }
        }
        sgu_all(p, lds, blk, gridDim.x);
        for (int uid = 1024 + blk; uid < 1032; uid += gridDim.x) sgu_sample_unit(p, lds, uid - 1024);
    }
    __syncthreads();
}

#define XB_TMO      128
#define XB_XCNT(j)  (256  + 64 * (j))
#define XB_XSUB(j)  (1280 + 64 * (j))
#define XB_XGEN(j)  (2304 + 64 * (j))
#define XB_TOP      3328
#define XB_TOPGEN   3392
#define XCD_BAR_WORDS 3456
#define XB_SPIN_CAP (1u << 18)
DI unsigned xb_ld(unsigned* p)              { return __hip_atomic_load(p, __ATOMIC_RELAXED, __HIP_MEMORY_SCOPE_AGENT); }
DI unsigned xb_add(unsigned* p, unsigned v) { return __hip_atomic_fetch_add(p, v, __ATOMIC_RELAXED, __HIP_MEMORY_SCOPE_AGENT); }
DI unsigned xb_xcc_id() { return (unsigned)__builtin_amdgcn_s_getreg((3 << 11) | 20) & 0xFu; }
#define XB_SPIN(cond, bar) do { unsigned _sp = 0; while (cond) { __builtin_amdgcn_s_sleep(1); \
    if ((++_sp & 255u) == 0u) { if (xb_ld(&(bar)[XB_TMO])) break; if (_sp > XB_SPIN_CAP) { atomicAdd(&(bar)[XB_TMO], 1u); break; } } } } while (0)
struct XcdBarrier { unsigned* bar; unsigned x; volatile LAS unsigned* st; };
DI XcdBarrier xcd_barrier_post(unsigned* bar, volatile LAS unsigned* st) {
    XcdBarrier b; b.bar = bar; b.x = xb_xcc_id(); b.st = st;
    if (threadIdx.x == 0) (void)xb_add(&bar[XB_XCNT(b.x)], 1u);
    return b;
}
DI void xcd_barrier_complete(unsigned* bar, unsigned x, unsigned& nloc, unsigned& nx) {
    const unsigned G = gridDim.x * gridDim.y * gridDim.z;
    unsigned sum, cnt, mine, sp = 0u;
    for (;;) {
        sum = 0u; cnt = 0u; mine = 0u;
#pragma unroll
        for (unsigned j = 0; j < 16; ++j) { const unsigned c = xb_ld(&bar[XB_XCNT(j)]); sum += c; cnt += (c > 0u) ? 1u : 0u; mine = (j == x) ? c : mine; }
        if (sum == G) break;
        __builtin_amdgcn_s_sleep(1);
        if ((++sp & 255u) == 0u) { if (xb_ld(&bar[XB_TMO])) break; if (sp > XB_SPIN_CAP) { atomicAdd(&bar[XB_TMO], 1u); break; } }
    }
    nloc = mine > 0u ? mine : 1u; nx = cnt > 0u ? cnt : 1u;
}
DI void xcd_barrier(const XcdBarrier& b) {
    asm volatile("s_waitcnt vmcnt(0)" ::: "memory");
    __syncthreads();
    if (threadIdx.x == 0) {
        unsigned* bar = b.bar;
        __builtin_amdgcn_s_waitcnt(0);
        unsigned nloc = b.st[0], nx = b.st[1];
        if (nloc == 0u) { xcd_barrier_complete(bar, b.x, nloc, nx); b.st[0] = nloc; b.st[1] = nx; }
        const unsigned old = xb_add(&bar[XB_XSUB(b.x)], 1u);
        const unsigned gen = old / nloc;
        if (old + 1u == (gen + 1u) * nloc) {
            __builtin_amdgcn_fence(__ATOMIC_RELEASE, "agent");
            asm volatile("s_waitcnt vmcnt(0)" ::: "memory");
            const unsigned og = xb_add(&bar[XB_TOP], 1u);
            const unsigned tg = og / nx;
            if (og + 1u == (tg + 1u) * nx) xb_add(&bar[XB_TOPGEN], 1u);
            else XB_SPIN(xb_ld(&bar[XB_TOPGEN]) == tg, bar);
            __builtin_amdgcn_fence(__ATOMIC_ACQUIRE, "agent");
            xb_add(&bar[XB_XGEN(b.x)], 1u);
            asm volatile("s_waitcnt vmcnt(0)" ::: "memory");
        } else {
            XB_SPIN(xb_ld(&bar[XB_XGEN(b.x)]) == gen, bar);
            __builtin_amdgcn_fence(__ATOMIC_ACQUIRE, "agent");
            asm volatile("s_waitcnt vmcnt(0)" ::: "memory");
        }
    }
    __syncthreads();
}

__global__ void __launch_bounds__(512, 2) fwd_kernel(Params p) {
    extern __shared__ __attribute__((aligned(16))) unsigned char lds_raw[];
    LAS unsigned char* lds = (LAS unsigned char*)lds_raw;
    const int lo = p.ph_lo, hi = p.ph_hi;
    unsigned char* ws = p.ws;
    bf16_t* XN = (bf16_t*)(ws + WS_XN); bf16_t* CAT = (bf16_t*)(ws + WS_CAT); bf16_t* HID = (bf16_t*)(ws + WS_HID);
    bf16_t* AREG = (bf16_t*)(ws + WS_A);
    float* SS = (float*)(ws + WS_SS); float* SVST = (float*)(ws + WS_SVST);
    float* out = p.out;
    const int G = gridDim.x, cid = blockIdx.x;
    volatile LAS unsigned* bst = (volatile LAS unsigned*)(lds + LDS_BYTES - 64);
    XcdBarrier xbar; xbar.bar = (unsigned*)ws; xbar.x = 0; xbar.st = bst;
    if (hi - lo > 1) {
        if (threadIdx.x < 16) bst[threadIdx.x] = 0u;
        __syncthreads();
        xbar = xcd_barrier_post((unsigned*)ws, bst);
    }
#ifndef PHASE_MASK
#define PHASE_MASK 0x7ff
#endif
#define IN(k) (((PHASE_MASK >> (k)) & 1) && lo <= (k) && (k) < hi)
#ifndef PROBE_DUP
#define PROBE_DUP 0
#endif
#define REPS(k) for (int rep_ = 0; rep_ < ((((PROBE_DUP) >> (k)) & 1) ? 2 : 1); ++rep_)
#define RSYNC() do { if (rep_) cg::this_grid().sync(); } while (0)
#define SEAM(k) do { if (IN(k) && IN((k) + 1)) { xcd_barrier(xbar); } } while (0)
    if (hi > 64) cg::this_grid().sync();
    if (IN(0)) REPS(0) { RSYNC(); phase_prologue(p, lds); __syncthreads(); }
    SEAM(0);
    if (IN(1)) REPS(1) {   RSYNC();
        pg8::Gemm g{XN, (const bf16_t*)(ws + WS_WIN0), MP, PW, D}; pg8::StaticOrder S; S.init(MP, PW, G, cid);
        EpiInEven E{SS + 0 * MT, AREG, (bf16_t*)(ws + WS_A + SUB), (bf16_t*)(ws + WS_A + 2 * SUB)};
        pg8::gemm_phase<EpiInEven, true>(lds, g, S, E);
        SEpiInEven ES{SS + 0 * MT, AREG, (bf16_t*)(ws + WS_A + SUB), (bf16_t*)(ws + WS_A + 2 * SUB)};
        sample_gemm(lds, XN, (const bf16_t*)(ws + WS_WIN0), PW / 256, D, ES);
    }
    SEAM(1);
    if (IN(2)) REPS(2) { RSYNC(); phase_conv(p, lds); }
    SEAM(2);
    if (IN(3)) REPS(3) {   RSYNC();
        pg8::Gemm g{CAT, (const bf16_t*)(ws + WS_WOUT0), MP, D, D}; pg8::StaticOrder S; S.init(MP, D, G, cid);
        EpiResid<0> E{p.in[0], out, XN, SS + 1 * MT};
        pg8::gemm_phase<EpiResid<0>, true>(lds, g, S, E);
        SEpiResid<0> ES{p.in[1] - (size_t)MP * D, out, XN, SS + 1 * MT};
        sample_gemm(lds, CAT, (const bf16_t*)(ws + WS_WOUT0), D / 256, D, ES);
    }
    SEAM(3);
    if (IN(4)) REPS(4) {   RSYNC();
        pg8::Gemm g{XN, (const bf16_t*)(ws + WS_WGU0), MP, 2 * FH, D}; pg8::StaticOrder S; S.init(MP, 2 * FH, G, cid);
        EpiGateUp E{SS + 1 * MT, HID};
        pg8::gemm_phase<EpiGateUp, true>(lds, g, S, E);
        SEpiGateUp ES{SS + 1 * MT, HID};
        sample_gemm(lds, XN, (const bf16_t*)(ws + WS_WGU0), 2 * FH / 256, D, ES);
    }
    SEAM(4);
    if (IN(5)) {
        pg8::Gemm g{HID, (const bf16_t*)(ws + WS_WDN0), MP, D, FH}; pg8::StaticOrder S; S.init(MP, D, G, cid);
        EpiResid<1> E{nullptr, out, XN, SS + 2 * MT};
        pg8::gemm_phase<EpiResid<1>, true>(lds, g, S, E);
        SEpiResid<1> ES{nullptr, out, XN, SS + 2 * MT};
        sample_gemm(lds, HID, (const bf16_t*)(ws + WS_WDN0), D / 256, FH, ES);
    }
    SEAM(5);
    if (IN(6)) REPS(6) {   RSYNC();
        pg8::Gemm g{XN, (const bf16_t*)(ws + WS_WIN1), MP, PW, D}; pg8::StaticOrder S; S.init(MP, PW, G, cid);
        EpiInOdd E{SS + 2 * MT, AREG, p.in[16], p.in[17], SVST, out};
        pg8::gemm_phase<EpiInOdd, true>(lds, g, S, E);
        SEpiInOdd ES{SS + 2 * MT, AREG, p.in[16], p.in[17], SVST, out};
        sample_gemm(lds, XN, (const bf16_t*)(ws + WS_WIN1), PW / 256, D, ES);
    }
    SEAM(6);
    if (IN(7)) REPS(7) { RSYNC(); phase_mix_odd(p, lds); }
    SEAM(7);
    if (IN(8)) {
        pg8::Gemm g{CAT, (const bf16_t*)(ws + WS_WOUT1), MP, D, D}; pg8::StaticOrder S; S.init(MP, D, G, cid);
        EpiResid<1> E{nullptr, out, XN, SS + 3 * MT};
        pg8::gemm_phase<EpiResid<1>, true>(lds, g, S, E);
        SEpiResid<1> ES{nullptr, out, XN, SS + 3 * MT};
        sample_gemm(lds, CAT, (const bf16_t*)(ws + WS_WOUT1), D / 256, D, ES);
    }
    SEAM(8);
    if (IN(9)) REPS(9) {   RSYNC();
        pg8::Gemm g{XN, (const bf16_t*)(ws + WS_WGU1), MP, 2 * FH, D}; pg8::StaticOrder S; S.init(MP, 2 * FH, G, cid);
        EpiGateUp E{SS + 3 * MT, HID};
        pg8::gemm_phase<EpiGateUp, true>(lds, g, S, E);
        SEpiGateUp ES{SS + 3 * MT, HID};
        sample_gemm(lds, XN, (const bf16_t*)(ws + WS_WGU1), 2 * FH / 256, D, ES);
    }
    SEAM(9);
    if (IN(10)) {
        pg8::Gemm g{HID, (const bf16_t*)(ws + WS_WDN1), MP, D, FH}; pg8::StaticOrder S; S.init(MP, D, G, cid);
        EpiResid<2> E{nullptr, out, XN, SS};
        pg8::gemm_phase<EpiResid<2>, true>(lds, g, S, E);
        SEpiResid<2> ES{nullptr, out, XN, SS};
        sample_gemm(lds, HID, (const bf16_t*)(ws + WS_WDN1), D / 256, FH, ES);
    }
#undef IN
#undef SEAM
}

constexpr int N_PHASES = 11;

extern "C" void kernel_launch(void* const* d_in, const int* in_sizes, int n_in, void* d_out, int out_size, void* d_ws, size_t ws_size, hipStream_t stream) {
    static int grid = 0;
    if (grid == 0) {
        if (n_in != 27 || ws_size < WS_END) { fprintf(stderr, "kernel_launch: unexpected n_in %d / ws %zu\n", n_in, ws_size); grid = -1; return; }
        int dev = 0, cus = 0, per_cu = 0;
        hipGetDevice(&dev);
        hipDeviceGetAttribute(&cus, hipDeviceAttributeMultiprocessorCount, dev);
        if (hipFuncSetAttribute((const void*)fwd_kernel, hipFuncAttributeMaxDynamicSharedMemorySize, LDS_BYTES) != hipSuccess) { fprintf(stderr, "kernel_launch: hipFuncSetAttribute failed\n"); grid = -1; return; }
        if (hipOccupancyMaxActiveBlocksPerMultiprocessor(&per_cu, (const void*)fwd_kernel, 512, LDS_BYTES) != hipSuccess || per_cu < 1) { fprintf(stderr, "kernel_launch: occupancy query says %d\n", per_cu); per_cu = 1; }
        (void)hipGetLastError();
        grid = cus;
    }
    if (grid < 0) return;
    Params a{};
    for (int i = 0; i < 27; ++i) a.in[i] = (const float*)d_in[i];
    a.out = (float*)d_out; a.ws = (unsigned char*)d_ws;
#if MK_ONE_LAUNCH
    if (hipMemsetAsync(d_ws, 0, 16384, stream) != hipSuccess) { fprintf(stderr, "kernel_launch: memset failed\n"); return; }
    a.ph_lo = 0; a.ph_hi = N_PHASES;
    void* args[] = {&a};
    hipError_t e = hipLaunchCooperativeKernel((const void*)fwd_kernel, dim3(grid), dim3(512), args, LDS_BYTES, stream);
    if (e != hipSuccess) fprintf(stderr, "cooperative launch failed: %s (grid %d)\n", hipGetErrorString(e), grid);
#else
    for (int ph = 0; ph < N_PHASES; ++ph) {
        a.ph_lo = ph; a.ph_hi = ph + 1;
        hipLaunchKernelGGL(fwd_kernel, dim3(grid), dim3(512), LDS_BYTES, stream, a);
    }
#endif
}
```

```cpp
#include <hip/hip_runtime.h>
#include <hip/hip_cooperative_groups.h>
#include <cstdio>
#include <cstdint>
namespace cg = cooperative_groups;

#ifndef MK_ONE_LAUNCH
#define MK_ONE_LAUNCH 1
#endif

#define LAS __attribute__((address_space(3)))
typedef unsigned short bf16_t;
typedef short bf16x8 __attribute__((ext_vector_type(8)));
typedef short s16x4 __attribute__((ext_vector_type(4)));
typedef float f32x4 __attribute__((ext_vector_type(4)));
typedef float f32x2 __attribute__((ext_vector_type(2)));
typedef float f32x16 __attribute__((ext_vector_type(16)));
typedef unsigned u32x4 __attribute__((ext_vector_type(4)));
typedef unsigned u32x2 __attribute__((ext_vector_type(2)));
typedef __bf16 bf16x2_t __attribute__((ext_vector_type(2)));

#define DI __device__ __forceinline__

constexpr int D = 1024, MP = 32768, MS = 128, MREAL = MP + MS, MT = 33024;
constexpr int SEQ = 4096, NB = 8, DSEQ = 16;
constexpr int MW = 512, PW = 2560, FH = 2816;
constexpr float LOG2E = 1.4426950408889634f;
constexpr float QSCALE = 0.125f * LOG2E;

constexpr size_t O_Y = 0;
constexpr size_t O_CAP = 33685504, O_CBP = 33808384, O_KP = 33816576, O_VP = 35913728;
constexpr size_t O_CAS = 38010880, O_CBS = 38133760, O_KS = 38141952, O_VS = 38207488, O_SVS = 38273024;

constexpr size_t MiB = 1u << 20;
constexpr size_t WS_SS = 1 * MiB;
constexpr size_t WS_SVST = 4 * MiB;
constexpr size_t WS_WIN0 = 8 * MiB, WS_WOUT0 = 13 * MiB, WS_WGU0 = 15 * MiB, WS_WDN0 = 26 * MiB;
constexpr size_t WS_WIN1 = 32 * MiB, WS_WOUT1 = 37 * MiB, WS_WGU1 = 39 * MiB, WS_WDN1 = 50 * MiB;
constexpr size_t WS_XN = 56 * MiB;
constexpr size_t WS_A = 122 * MiB;
constexpr size_t SUB = (size_t)MT * MW * 2;
constexpr size_t WS_CAT = 284 * MiB;
constexpr size_t WS_HID = 122 * MiB;
constexpr size_t WS_END = 349 * MiB;

constexpr int LDS_BYTES = 163840;

DI unsigned pk2(float lo, float hi) { f32x2 v = {lo, hi}; bf16x2_t b = __builtin_convertvector(v, bf16x2_t); return __builtin_bit_cast(unsigned, b); }
DI float bflo(unsigned u) { return __uint_as_float(u << 16); }
DI float bfhi(unsigned u) { return __uint_as_float(u & 0xffff0000u); }
DI u32x4 pk8(f32x4 a, f32x4 b) { u32x4 w; w.x = pk2(a[0], a[1]); w.y = pk2(a[2], a[3]); w.z = pk2(b[0], b[1]); w.w = pk2(b[2], b[3]); return w; }
DI void unpack8(const u32x4 w, float (&f)[8]) { f[0] = bflo(w.x); f[1] = bfhi(w.x); f[2] = bflo(w.y); f[3] = bfhi(w.y); f[4] = bflo(w.z); f[5] = bfhi(w.z); f[6] = bflo(w.w); f[7] = bfhi(w.w); }
DI float sigmoidf_(float x) { return __builtin_amdgcn_rcpf(1.0f + __expf(-x)); }
DI float wave_sum(float v) {
#pragma unroll
    for (int o = 1; o < 64; o <<= 1) v += __shfl_xor(v, o);
    return v;
}

namespace pg8 {
constexpr int BM = 256, BK = 64, HALF = 128, HTB = HALF * BK * 2, STAGE_BYTES = 8 * HTB, NXCD = 8, WGM = 8;
__host__ __device__ __forceinline__ int lds_byte(int r, int c) { const int st = (r >> 4) * 2 + (c >> 5), rr = r & 15, cc = c & 31, ob = rr * 64 + cc * 2; return st * 1024 + (ob ^ (((ob >> 9) & 1) << 5)); }
__host__ __device__ __forceinline__ void stage_rc(int b, int& R, int& C) { const int st = b / 1024, sb = b % 1024, swz = sb ^ (((sb >> 9) & 1) << 5); R = (st >> 1) * 16 + swz / 64; C = (st & 1) * 32 + (swz % 64) / 2; }
__host__ __device__ __forceinline__ int perm32(int rho) { const int n = rho >> 4, i = rho & 15; return 8 * (i >> 2) + 4 * n + (i & 3); }

struct Unit { int pm, pn; };
struct Gemm { const bf16_t* A; const bf16_t* Bt; int M, N, K; };

struct StaticOrder {
    int nM, nN, nwg, G, c;
    __device__ void init(int M, int N, int G_, int c_) { nM = M / BM; nN = N / BM; nwg = nM * nN; G = G_; c = c_; }
    __device__ bool next(int i, Unit& u) const {
        const long L = (long)i * G + c; if (L >= nwg) return false;
        int wgid = (int)L; { const int q = nwg / NXCD, r = nwg % NXCD, xcd = wgid % NXCD, off = wgid / NXCD; wgid = (xcd < r ? xcd * (q + 1) : r * (q + 1) + (xcd - r) * q) + off; }
        const int nig = WGM * nN, gid = wgid / nig, fm = gid * WGM, gsz = (nM - fm) < WGM ? (nM - fm) : WGM;
        u.pm = fm + ((wgid % nig) % gsz); u.pn = (wgid % nig) / gsz; return true;
    }
};

template <class Epi, bool ALIGN_EPI>
__device__ __forceinline__ void gemm_phase(LAS unsigned char* lds, const Gemm g, const StaticOrder& S, const Epi& E) {
    const int tid = threadIdx.x, wid = __builtin_amdgcn_readfirstlane(tid >> 6), lane = tid & 63, wr = wid >> 2, wc = wid & 3, fr = lane & 15, fq = lane >> 4;
    const int K = g.K, nt = K / BK;
    unsigned voffA[2], voffB[2];
#pragma unroll
    for (int i = 0; i < 2; ++i) { int R, C; stage_rc(tid * 16 + i * 8192, R, C); const int Rb = Epi::PERM ? ((R & ~31) + perm32(R & 31)) : R;
        voffA[i] = (unsigned)(R * K + C) * 2u; voffB[i] = (unsigned)(Rb * K + C) * 2u; }
    const size_t kstep = (size_t)(BK * 2);
    const size_t hstep = (size_t)HALF * K * 2;
    const size_t tstep = 2 * hstep;
    const unsigned ldsw = (unsigned)wid * 1024u;
    const int aoff = lds_byte(wr * 64 + fr, fq * 8), boff = lds_byte(wc * 32 + fr, fq * 8);
#define PG8_SA(b, h) (((b) * 2 + (h)) * HTB)
#define PG8_SB(b, h) ((4 + (b) * 2 + (h)) * HTB)
#define PG8_STAGE(bufoff, gbase, voff) do { _Pragma("unroll") for (int _i = 0; _i < 2; ++_i) \
        __builtin_amdgcn_global_load_lds((const unsigned*)((const char*)(gbase) + (voff)[_i]), (LAS unsigned*)(lds + (bufoff) + ldsw + _i * 8192), 16, 0, 0); } while (0)
#define PG8_LDA(dst, b, h) do { _Pragma("unroll") for (int m = 0; m < 4; ++m) _Pragma("unroll") for (int k = 0; k < 2; ++k) dst[m][k] = *(const LAS bf16x8*)(lds + PG8_SA(b, h) + aoff + m * 2048 + k * 1024); } while (0)
#define PG8_LDB(dst, b, h) do { _Pragma("unroll") for (int n = 0; n < 2; ++n) _Pragma("unroll") for (int k = 0; k < 2; ++k) dst[n][k] = *(const LAS bf16x8*)(lds + PG8_SB(b, h) + boff + n * 2048 + k * 1024); } while (0)
#define PG8_MMA(ai, bj, At, Bt) do { __builtin_amdgcn_s_setprio(3); _Pragma("unroll") for (int m = 0; m < 4; ++m) _Pragma("unroll") for (int n = 0; n < 2; ++n) _Pragma("unroll") for (int k = 0; k < 2; ++k) \
        acc[ai][bj][m][n] = __builtin_amdgcn_mfma_f32_16x16x32_bf16(Bt[n][k], At[m][k], acc[ai][bj][m][n], 0, 0, 0); __builtin_amdgcn_s_setprio(0); } while (0)
#define PG8_WAIT_V(n) asm volatile("s_waitcnt vmcnt(" #n ")" ::: "memory")
#define PG8_WAIT_L(n) asm volatile("s_waitcnt lgkmcnt(" #n ")" ::: "memory")
#define PG8_BAR __builtin_amdgcn_s_barrier()
#define PG8_SCHED __builtin_amdgcn_sched_barrier(0)
    Unit cur, nxt; int ui = 0;
    if (!S.next(0, cur)) return;
    f32x4 acc[2][2][4][2];
#pragma unroll
    for (int a = 0; a < 2; ++a)
#pragma unroll
        for (int b = 0; b < 2; ++b)
#pragma unroll
            for (int m = 0; m < 4; ++m)
#pragma unroll
                for (int n = 0; n < 2; ++n) acc[a][b][m][n] = (f32x4){0.f, 0.f, 0.f, 0.f};
    bf16x8 At[4][2], B0[2][2], B1[2][2];
    const char* cA = (const char*)g.A + (size_t)cur.pm * tstep; const char* cB = (const char*)g.Bt + (size_t)cur.pn * tstep;
    PG8_STAGE(PG8_SB(0, 0), cB, voffB); PG8_STAGE(PG8_SB(0, 1), cB + hstep, voffB); PG8_STAGE(PG8_SA(0, 0), cA, voffA); PG8_STAGE(PG8_SA(0, 1), cA + hstep, voffA);
    if (wr == 1) PG8_BAR;
    PG8_WAIT_V(2); PG8_BAR;
    PG8_STAGE(PG8_SB(1, 0), cB + kstep, voffB); PG8_STAGE(PG8_SA(1, 0), cA + kstep, voffA); PG8_STAGE(PG8_SB(1, 1), cB + hstep + kstep, voffB);
    PG8_WAIT_V(6); PG8_BAR;
    for (;;) {
        const bool has_next = S.next(ui + 1, nxt);
        const char* nA = has_next ? (const char*)g.A + (size_t)nxt.pm * tstep : cA; const char* nB = has_next ? (const char*)g.Bt + (size_t)nxt.pn * tstep : cB;
        for (int t = 0; t < nt; t += 2) {
            const bool last = (t == nt - 2);
            const char* a1 = cA + (size_t)(t + 1) * kstep;
            const char* a2 = last ? nA : cA + (size_t)(t + 2) * kstep; const char* b2 = last ? nB : cB + (size_t)(t + 2) * kstep;
            const char* a3 = a2 + kstep; const char* b3 = b2 + kstep;
            PG8_LDB(B0, 0, 0); PG8_LDB(B1, 0, 1); PG8_SCHED; PG8_LDA(At, 0, 0); PG8_STAGE(PG8_SA(1, 1), a1 + hstep, voffA);
            PG8_WAIT_V(8); PG8_WAIT_L(0); PG8_BAR; PG8_MMA(0, 0, At, B0); PG8_MMA(0, 1, At, B1); PG8_BAR; PG8_SCHED;
            PG8_LDA(At, 0, 1); PG8_STAGE(PG8_SB(0, 0), b2, voffB); PG8_STAGE(PG8_SB(0, 1), b2 + hstep, voffB); PG8_STAGE(PG8_SA(0, 0), a2, voffA);
            PG8_WAIT_V(8); PG8_WAIT_L(0); PG8_BAR; PG8_MMA(1, 0, At, B0); PG8_MMA(1, 1, At, B1); PG8_BAR; PG8_SCHED;
            PG8_LDB(B0, 1, 0); PG8_LDB(B1, 1, 1); PG8_SCHED; PG8_LDA(At, 1, 0); PG8_STAGE(PG8_SA(0, 1), a2 + hstep, voffA);
            PG8_WAIT_V(8); PG8_WAIT_L(0); PG8_BAR; PG8_MMA(0, 0, At, B0); PG8_MMA(0, 1, At, B1); PG8_BAR; PG8_SCHED;
            PG8_LDA(At, 1, 1); PG8_STAGE(PG8_SB(1, 0), b3, voffB); PG8_STAGE(PG8_SB(1, 1), b3 + hstep, voffB); PG8_STAGE(PG8_SA(1, 0), a3, voffA);
            PG8_WAIT_V(8); PG8_WAIT_L(0); PG8_BAR; PG8_MMA(1, 0, At, B0); PG8_MMA(1, 1, At, B1); PG8_BAR; PG8_SCHED;
        }
        if constexpr (ALIGN_EPI) { if (wr == 0) PG8_BAR; }
        E(acc, cur, wr, wc, fr, fq);
        if (!has_next) break;
#pragma unroll
        for (int a = 0; a < 2; ++a)
#pragma unroll
            for (int b = 0; b < 2; ++b)
#pragma unroll
                for (int m = 0; m < 4; ++m)
#pragma unroll
                    for (int n = 0; n < 2; ++n) acc[a][b][m][n] = (f32x4){0.f, 0.f, 0.f, 0.f};
        cur = nxt; cA = nA; cB = nB; ++ui;
        if constexpr (ALIGN_EPI) { if (wr == 1) PG8_BAR; }
    }
    PG8_WAIT_V(0);
    if constexpr (!ALIGN_EPI) { if (wr == 0) PG8_BAR; }
    PG8_BAR;
#undef PG8_SA
#undef PG8_SB
#undef PG8_STAGE
#undef PG8_LDA
#undef PG8_LDB
#undef PG8_MMA
#undef PG8_WAIT_V
#undef PG8_WAIT_L
#undef PG8_BAR
#undef PG8_SCHED
}
}

typedef f32x4 Acc[2][2][4][2];

DI float row_rstd(const float* SS, int row) { return rsqrtf(SS[row] * (1.0f / 1024.0f) + 1e-6f); }

struct EpiInEven {
    static constexpr bool PERM = true;
    const float* SS; bf16_t *A0, *Z0, *GB0;
    DI void operator()(const Acc& acc, const pg8::Unit& u, int wr, int wc, int fr, int fq) const {
        const int row0 = u.pm * 256 + wr * 64 + fr, cl = wc * 32 + fq * 8;
        float rsv[2][4];
#pragma unroll
        for (int ai = 0; ai < 2; ++ai)
#pragma unroll
            for (int m = 0; m < 4; ++m) rsv[ai][m] = row_rstd(SS, row0 + ai * 128 + m * 16);
        if (u.pn < 8) {
            bf16_t* O = (u.pn < 4) ? A0 : Z0; const int colb = (u.pn & 3) * 128 + cl; const bool glu = u.pn < 4;
#pragma unroll
            for (int ai = 0; ai < 2; ++ai)
#pragma unroll
                for (int m = 0; m < 4; ++m) {
                    const int row = row0 + ai * 128 + m * 16;
                    const float rs = rsv[ai][m];
                    f32x4 x0 = acc[ai][0][m][0] * rs, x1 = acc[ai][0][m][1] * rs, y0 = acc[ai][1][m][0] * rs, y1 = acc[ai][1][m][1] * rs;
                    if (glu) {
#pragma unroll
                        for (int i = 0; i < 4; ++i) { y0[i] = sigmoidf_(y0[i]); y1[i] = sigmoidf_(y1[i]); }
                    }
                    *(u32x4*)(O + (size_t)row * MW + colb) = pk8(x0 * y0, x1 * y1);
                }
        } else {
            const int colb = (u.pn - 8) * 256 + cl;
#pragma unroll
            for (int ai = 0; ai < 2; ++ai)
#pragma unroll
                for (int m = 0; m < 4; ++m) {
                    const int row = row0 + ai * 128 + m * 16;
                    const float rs = rsv[ai][m];
#pragma unroll
                    for (int bj = 0; bj < 2; ++bj) *(u32x4*)(GB0 + (size_t)row * MW + colb + bj * 128) = pk8(acc[ai][bj][m][0] * rs, acc[ai][bj][m][1] * rs);
                }
        }
    }
};

template <int MODE> struct EpiResid {
    static constexpr bool PERM = true;
    const float* xin; float* out; bf16_t* XN; float* SS;
    DI void operator()(const Acc& acc, const pg8::Unit& u, int wr, int wc, int fr, int fq) const {
        const int colb = u.pn * 256 + wc * 32 + fq * 8;
        const int row0 = u.pm * 256 + wr * 64 + fr;
        if (MODE == 0) {
#pragma unroll
            for (int ai = 0; ai < 2; ++ai) {
                f32x4 rx[4][2][2];
#pragma unroll
                for (int m = 0; m < 4; ++m)
#pragma unroll
                    for (int bj = 0; bj < 2; ++bj) { const float* s = xin + (size_t)(row0 + ai * 128 + m * 16) * D + colb + bj * 128; rx[m][bj][0] = __builtin_nontemporal_load((const f32x4*)s); rx[m][bj][1] = __builtin_nontemporal_load((const f32x4*)(s + 4)); }
#pragma unroll
                for (int m = 0; m < 4; ++m) {
                    const int row = row0 + ai * 128 + m * 16;
                    float ssq = 0.f;
#pragma unroll
                    for (int bj = 0; bj < 2; ++bj) {
                        const f32x4 v0 = rx[m][bj][0] + acc[ai][bj][m][0], v1 = rx[m][bj][1] + acc[ai][bj][m][1];
                        ssq += (v0[0] * v0[0] + v0[1] * v0[1]) + (v0[2] * v0[2] + v0[3] * v0[3]) + (v1[0] * v1[0] + v1[1] * v1[1]) + (v1[2] * v1[2] + v1[3] * v1[3]);
                        *(u32x4*)(XN + (size_t)row * D + colb + bj * 128) = pk8(v0, v1);
                    }
                    ssq += __shfl_xor(ssq, 16); ssq += __shfl_xor(ssq, 32);
                    if (fq == 0) atomicAdd(SS + row, ssq);
                }
            }
        } else {
#pragma unroll
            for (int ai = 0; ai < 2; ++ai) {
                u32x4 rx[4][2];
#pragma unroll
                for (int m = 0; m < 4; ++m)
#pragma unroll
                    for (int bj = 0; bj < 2; ++bj) rx[m][bj] = *(const u32x4*)(XN + (size_t)(row0 + ai * 128 + m * 16) * D + colb + bj * 128);
#pragma unroll
                for (int m = 0; m < 4; ++m) {
                    const int row = row0 + ai * 128 + m * 16;
                    float ssq = 0.f;
#pragma unroll
                    for (int bj = 0; bj < 2; ++bj) {
                        const int col = colb + bj * 128;
                        float f[8]; unpack8(rx[m][bj], f);
                        const f32x4 v0 = (f32x4){f[0], f[1], f[2], f[3]} + acc[ai][bj][m][0], v1 = (f32x4){f[4], f[5], f[6], f[7]} + acc[ai][bj][m][1];
                        if (MODE == 2) { __builtin_nontemporal_store(v0, (f32x4*)(out + (size_t)row * D + col)); __builtin_nontemporal_store(v1, (f32x4*)(out + (size_t)row * D + col + 4)); }
                        else {
                            ssq += (v0[0] * v0[0] + v0[1] * v0[1]) + (v0[2] * v0[2] + v0[3] * v0[3]) + (v1[0] * v1[0] + v1[1] * v1[1]) + (v1[2] * v1[2] + v1[3] * v1[3]);
                            *(u32x4*)(XN + (size_t)row * D + col) = pk8(v0, v1);
                        }
                    }
                    if (MODE != 2) {
                        ssq += __shfl_xor(ssq, 16); ssq += __shfl_xor(ssq, 32);
                        if (fq == 0) atomicAdd(SS + row, ssq);
                    }
                }
            }
        }
    }
};

struct EpiGateUp {
    static constexpr bool PERM = true;
    const float* SS; bf16_t* HID;
    DI void operator()(const Acc& acc, const pg8::Unit& u, int wr, int wc, int fr, int fq) const {
        const int colb = u.pn * 128 + wc * 32 + fq * 8;
        float rsv[2][4];
#pragma unroll
        for (int ai = 0; ai < 2; ++ai)
#pragma unroll
            for (int m = 0; m < 4; ++m) rsv[ai][m] = row_rstd(SS, u.pm * 256 + ai * 128 + wr * 64 + m * 16 + fr);
#pragma unroll
        for (int ai = 0; ai < 2; ++ai)
#pragma unroll
            for (int m = 0; m < 4; ++m) {
                const int row = u.pm * 256 + ai * 128 + wr * 64 + m * 16 + fr;
                const float rs = rsv[ai][m];
                f32x4 h0, h1;
                const float rs2 = rs * rs, nrl = -rs * LOG2E;
#pragma unroll
                for (int i = 0; i < 4; ++i) {
                    const float a0 = acc[ai][0][m][0][i], a1 = acc[ai][0][m][1][i];
                    h0[i] = (a0 * acc[ai][1][m][0][i]) * rs2 * __builtin_amdgcn_rcpf(1.0f + __builtin_amdgcn_exp2f(a0 * nrl));
                    h1[i] = (a1 * acc[ai][1][m][1][i]) * rs2 * __builtin_amdgcn_rcpf(1.0f + __builtin_amdgcn_exp2f(a1 * nrl));
                }
                *(u32x4*)(HID + (size_t)row * FH + colb) = pk8(h0, h1);
            }
    }
};

struct EpiInOdd {
    static constexpr bool PERM = true;
    const float* SS; bf16_t* QKVUS; const float* qg; const float* kg; float* SVST; float* out;
    DI void operator()(const Acc& acc, const pg8::Unit& u, int wr, int wc, int fr, int fq) const {
        const int typ = u.pn >> 1, ph = u.pn & 1;
        bf16_t* O = QKVUS + (size_t)typ * ((size_t)MT * MW);
        const bool samp = (u.pm == 128);
        const bool keep = samp || ((u.pm & 15) >= 14);
        float rsv[2][4];
#pragma unroll
        for (int ai = 0; ai < 2; ++ai)
#pragma unroll
            for (int m = 0; m < 4; ++m) rsv[ai][m] = row_rstd(SS, u.pm * 256 + ai * 128 + wr * 64 + m * 16 + fr);
        if (typ < 2) {
            const float* gsrc = typ == 0 ? qg : kg;
            f32x4 gv[2][2];
#pragma unroll
            for (int bj = 0; bj < 2; ++bj)
#pragma unroll
                for (int n = 0; n < 2; ++n) gv[bj][n] = *(const f32x4*)(gsrc + 32 * bj + 8 * fq + 4 * n);
            const float osc = typ == 0 ? QSCALE : 1.0f;
            const int head = ph * 4 + wc;
#pragma unroll
            for (int ai = 0; ai < 2; ++ai)
#pragma unroll
                for (int m = 0; m < 4; ++m) {
                    const int row = u.pm * 256 + ai * 128 + wr * 64 + m * 16 + fr;
                    const float rs = rsv[ai][m];
                    f32x4 v[2][2]; float ssq = 0.f;
#pragma unroll
                    for (int bj = 0; bj < 2; ++bj)
#pragma unroll
                        for (int n = 0; n < 2; ++n) { v[bj][n] = acc[ai][bj][m][n] * rs; const f32x4 t = v[bj][n]; ssq += (t[0] * t[0] + t[1] * t[1]) + (t[2] * t[2] + t[3] * t[3]); }
                    ssq += __shfl_xor(ssq, 16); ssq += __shfl_xor(ssq, 32);
                    const float r = rsqrtf(ssq * (1.0f / 64.0f) + 1e-6f);
#pragma unroll
                    for (int bj = 0; bj < 2; ++bj) {
                        const f32x4 o0 = v[bj][0] * r * gv[bj][0], o1 = v[bj][1] * r * gv[bj][1];
                        *(u32x4*)(O + (size_t)row * MW + head * 64 + 32 * bj + 8 * fq) = pk8(o0 * osc, o1 * osc);
                        if (typ == 1 && keep && !(samp && ai == 1)) {
                            float* dst;
                            if (samp) dst = out + O_KS + (size_t)(row - MP) * 512;
                            else { const int b = u.pm >> 4, t = (u.pm & 15) * 256 + ai * 128 + wr * 64 + m * 16 + fr - 3584; dst = out + O_KP + ((size_t)b * 512 + t) * 512; }
                            dst += head * 64 + 32 * bj + 8 * fq;
                            *(f32x4*)dst = o0; *(f32x4*)(dst + 4) = o1;
                        }
                    }
                }
        } else {
#pragma unroll
            for (int ai = 0; ai < 2; ++ai)
#pragma unroll
                for (int m = 0; m < 4; ++m) {
                    const int row = u.pm * 256 + ai * 128 + wr * 64 + m * 16 + fr;
                    const float rs = rsv[ai][m];
                    float s1 = 0.f, s2 = 0.f;
#pragma unroll
                    for (int bj = 0; bj < 2; ++bj) {
                        const f32x4 o0 = acc[ai][bj][m][0] * rs, o1 = acc[ai][bj][m][1] * rs;
                        const int col = ph * 256 + bj * 128 + wc * 32 + fq * 8;
                        *(u32x4*)(O + (size_t)row * MW + col) = pk8(o0, o1);
                        if (typ == 4) {
                            s1 += (o0[0] + o0[1]) + (o0[2] + o0[3]) + (o1[0] + o1[1]) + (o1[2] + o1[3]);
                            s2 += (o0[0] * o0[0] + o0[1] * o0[1]) + (o0[2] * o0[2] + o0[3] * o0[3]) + (o1[0] * o1[0] + o1[1] * o1[1]) + (o1[2] * o1[2] + o1[3] * o1[3]);
                        }
                        if (typ == 2 && keep && !(samp && ai == 1)) {
                            float* dst;
                            if (samp) dst = out + O_VS + (size_t)(row - MP) * 512;
                            else { const int b = u.pm >> 4, t = (u.pm & 15) * 256 + ai * 128 + wr * 64 + m * 16 + fr - 3584; dst = out + O_VP + ((size_t)b * 512 + t) * 512; }
                            dst += col;
                            *(f32x4*)dst = o0; *(f32x4*)(dst + 4) = o1;
                        }
                    }
                    if (typ == 4) {
                        s1 += __shfl_xor(s1, 16); s1 += __shfl_xor(s1, 32); s2 += __shfl_xor(s2, 16); s2 += __shfl_xor(s2, 32);
                        if (fq == 0) *(f32x2*)(SVST + ((size_t)row * 8 + ph * 4 + wc) * 2) = (f32x2){s1, s2};
                    }
                }
        }
    }
};


DI float red16(float v) { v += __shfl_xor(v, 1); v += __shfl_xor(v, 2); v += __shfl_xor(v, 4); v += __shfl_xor(v, 8); return v; }
DI f32x4 shx8(const f32x4 v) { f32x4 o; o[0] = __shfl_xor(v[0], 8); o[1] = __shfl_xor(v[1], 8); o[2] = __shfl_xor(v[2], 8); o[3] = __shfl_xor(v[3], 8); return o; }
DI u32x2 pk4(const f32x4 a) { return (u32x2){pk2(a[0], a[1]), pk2(a[2], a[3])}; }

struct SEpiInEven {
    const float* SS; bf16_t *A0, *Z0, *GB0;
    DI void operator()(const f32x4 vraw, int row, int pn, int wc, int bj, int cl) const {
        const f32x4 v = vraw * row_rstd(SS, row);
        const f32x4 o = shx8(v);
        if (pn < 8) {
            if (bj == 0) {
                f32x4 y = o;
                if (pn < 4) {
#pragma unroll
                    for (int i = 0; i < 4; ++i) y[i] = sigmoidf_(y[i]);
                }
                bf16_t* O = (pn < 4) ? A0 : Z0;
                *(u32x2*)(O + (size_t)row * MW + (pn & 3) * 128 + wc * 32 + cl) = pk4(v * y);
            }
        } else *(u32x2*)(GB0 + (size_t)row * MW + (pn - 8) * 256 + bj * 128 + wc * 32 + cl) = pk4(v);
    }
};
template <int MODE> struct SEpiResid {
    const float* xin; float* out; bf16_t* XN; float* SS;
    DI void operator()(const f32x4 v, int row, int pn, int wc, int bj, int cl) const {
        const int col = pn * 256 + bj * 128 + wc * 32 + cl;
        f32x4 x;
        if (MODE == 0) x = *(const f32x4*)(xin + (size_t)row * D + col);
        else { const u32x2 w = *(const u32x2*)(XN + (size_t)row * D + col); x = (f32x4){bflo(w.x), bfhi(w.x), bflo(w.y), bfhi(w.y)}; }
        x += v;
        if (MODE == 2) *(f32x4*)(out + (size_t)row * D + col) = x;
        else {
            *(u32x2*)(XN + (size_t)row * D + col) = pk4(x);
            const float ssq = red16((x[0] * x[0] + x[1] * x[1]) + (x[2] * x[2] + x[3] * x[3]));
            if ((threadIdx.x & 15) == 0) atomicAdd(SS + row, ssq);
        }
    }
};
struct SEpiGateUp {
    const float* SS; bf16_t* HID;
    DI void operator()(const f32x4 v, int row, int pn, int wc, int bj, int cl) const {
        const float rs = row_rstd(SS, row);
        const f32x4 o = shx8(v);
        if (bj == 0) {
            f32x4 hv;
#pragma unroll
            for (int i = 0; i < 4; ++i) { const float g0 = v[i] * rs; hv[i] = g0 * sigmoidf_(g0) * (o[i] * rs); }
            *(u32x2*)(HID + (size_t)row * FH + pn * 128 + wc * 32 + cl) = pk4(hv);
        }
    }
};
struct SEpiInOdd {
    const float* SS; bf16_t* QKVUS; const float* qg; const float* kg; float* SVST; float* out;
    DI void operator()(const f32x4 v, int row, int pn, int wc, int bj, int cl) const {
        const int typ = pn >> 1, ph = pn & 1;
        bf16_t* O = QKVUS + (size_t)typ * ((size_t)MT * MW);
        const float rs = row_rstd(SS, row);
        const f32x4 x = v * rs;
        if (typ < 2) {
            const int head = ph * 4 + wc, dd = 32 * bj + cl;
            const float ssq = red16((x[0] * x[0] + x[1] * x[1]) + (x[2] * x[2] + x[3] * x[3]));
            const float r = rsqrtf(ssq * (1.0f / 64.0f) + 1e-6f);
            const f32x4 gv = *(const f32x4*)((typ == 0 ? qg : kg) + dd);
            const f32x4 o = x * r * gv;
            *(u32x2*)(O + (size_t)row * MW + head * 64 + dd) = pk4(o * (typ == 0 ? QSCALE : 1.0f));
            if (typ == 1) *(f32x4*)(out + O_KS + (size_t)(row - MP) * 512 + head * 64 + dd) = o;
        } else {
            const int col = ph * 256 + bj * 128 + wc * 32 + cl;
            *(u32x2*)(O + (size_t)row * MW + col) = pk4(x);
            if (typ == 2) *(f32x4*)(out + O_VS + (size_t)(row - MP) * 512 + col) = x;
            if (typ == 4) {
                const float s1 = red16((x[0] + x[1]) + (x[2] + x[3])), s2 = red16((x[0] * x[0] + x[1] * x[1]) + (x[2] * x[2] + x[3] * x[3]));
                if ((threadIdx.x & 15) == 0) *(f32x2*)(SVST + ((size_t)row * 8 + ph * 4 + wc) * 2) = (f32x2){s1, s2};
            }
        }
    }
};

template <class EpiS>
DI void sample_gemm(LAS unsigned char* lds, const bf16_t* A, const bf16_t* Bt, int nN, int K, const EpiS& E) {
    const int tid = threadIdx.x, lane = tid & 63, w = __builtin_amdgcn_readfirstlane(tid >> 6), r32 = lane & 31, h = lane >> 5;
    const int nunits = 16 * nN, kw = K >> 3, nk = kw >> 4;
    for (int un = (int)blockIdx.x; un < nunits; un += (int)gridDim.x) {
        const int rb = un & 3, wc = (un >> 2) & 3, pn = un >> 4;
        const bf16_t* ap = A + (size_t)(MP + rb * 32 + r32) * K + w * kw + h * 8;
        const bf16_t* b0p = Bt + (size_t)(pn * 256 + wc * 32 + r32) * K + w * kw + h * 8;
        const bf16_t* b1p = b0p + (size_t)128 * K;
        f32x16 c0, c1;
#pragma unroll
        for (int r = 0; r < 16; ++r) { c0[r] = 0.f; c1[r] = 0.f; }
#pragma unroll 8
        for (int ks = 0; ks < nk; ++ks) {
            const bf16x8 a = *(const bf16x8*)(ap + ks * 16), b0 = *(const bf16x8*)(b0p + ks * 16), b1 = *(const bf16x8*)(b1p + ks * 16);
            c0 = __builtin_amdgcn_mfma_f32_32x32x16_bf16(a, b0, c0, 0, 0, 0);
            c1 = __builtin_amdgcn_mfma_f32_32x32x16_bf16(a, b1, c1, 0, 0, 0);
        }
        __syncthreads();
        LAS float* part = (LAS float*)(lds + w * 8192);
#pragma unroll
        for (int r = 0; r < 16; ++r) { const int row = (r & 3) + 8 * (r >> 2) + 4 * h; part[row * 64 + r32] = c0[r]; part[row * 64 + 32 + r32] = c1[r]; }
        __syncthreads();
        f32x4 v = (f32x4){0.f, 0.f, 0.f, 0.f};
#pragma unroll
        for (int ww = 0; ww < 8; ++ww) v += *(const LAS f32x4*)(lds + ww * 8192 + (tid >> 4) * 256 + (tid & 15) * 16);
        E(v, MP + rb * 32 + (tid >> 4), pn, wc, (tid >> 3) & 1, 4 * (tid & 7));
    }
    __syncthreads();
}

struct Params {
    const float* in[27];
    float* out;
    unsigned char* ws;
    int ph_lo, ph_hi;
};

DI int map_col(int kind, int n) {
    if (kind == 1) { const int seg = n >> 9, o = n & 511, t = o >> 7, r = o & 127;
        if (seg == 0) return t * 256 + r; if (seg == 1) return t * 256 + 128 + r; if (seg == 2) return 2048 + o;
        if (seg == 3) return 1024 + t * 256 + r; return 1024 + t * 256 + 128 + r; }
    if (kind == 2) { const int up = n >= FH ? 1 : 0, o = up ? n - FH : n; return (o >> 7) * 256 + up * 128 + (o & 127); }
    if (kind == 3) { if (n >= 1024) return n; const int t = n >> 8, hl = (n >> 6) & 3, dd = n & 63; return t * 256 + (dd >> 5) * 128 + hl * 32 + (dd & 31); }
    return n;
}
DI void transpose_item(const float* W, int K, int N, bf16_t* WT, int kind, const float* gain, LAS float* scr, int item, int lane) {
    const int nblk = N / 64, kb = item / nblk, nb = item % nblk, k0 = 64 * kb, n0 = 64 * nb;
    const int lr = lane >> 4, lc = (lane & 15) * 4;
    f32x4 v[16];
#pragma unroll
    for (int i = 0; i < 16; ++i) v[i] = __builtin_nontemporal_load((const f32x4*)(W + (size_t)(k0 + 4 * i + lr) * N + n0 + lc));
    if (gain) {
        float gk[16];
#pragma unroll
        for (int i = 0; i < 16; ++i) gk[i] = gain[k0 + 4 * i + lr];
#pragma unroll
        for (int i = 0; i < 16; ++i) v[i] *= gk[i];
    }
#pragma unroll
    for (int i = 0; i < 16; ++i) { LAS float* d = scr + (4 * i + lr) * 65 + lc; d[0] = v[i][0]; d[1] = v[i][1]; d[2] = v[i][2]; d[3] = v[i][3]; }
    asm volatile("s_waitcnt lgkmcnt(0)" ::: "memory");
    const int c = lane & 7;
#pragma unroll
    for (int j = 0; j < 8; ++j) { const int n = (lane >> 3) + 8 * j; const LAS float* s = scr + (8 * c) * 65 + n;
        u32x4 o; o.x = pk2(s[0 * 65], s[1 * 65]); o.y = pk2(s[2 * 65], s[3 * 65]); o.z = pk2(s[4 * 65], s[5 * 65]); o.w = pk2(s[6 * 65], s[7 * 65]);
        *(u32x4*)(WT + (size_t)map_col(kind, n0 + n) * K + k0 + 8 * c) = o; }
    asm volatile("s_waitcnt lgkmcnt(0)" ::: "memory");
}

DI void phase_prologue(const Params& p, LAS unsigned char* lds) {
    const int tid = threadIdx.x, lane = tid & 63, wave = tid >> 6;
    LAS float* scr = (LAS float*)(lds + wave * 16896);
    const int gw = blockIdx.x * 8 + wave, NGW = gridDim.x * 8;
    unsigned char* ws = p.ws;
    bf16_t* XN = (bf16_t*)(ws + WS_XN);
    float* SS = (float*)(ws + WS_SS);
    for (int q = gw; q < MT / 4; q += NGW) {
        const int row0 = q * 4;
        if (row0 < MREAL) {
            f32x4 v[4][4];
#pragma unroll
            for (int r = 0; r < 4; ++r) {
                const int row = row0 + r;
                const float* src = row < MP ? p.in[0] + (size_t)row * D : p.in[1] + (size_t)(row - MP) * D;
                const f32x4* xr = (const f32x4*)src + lane;
#pragma unroll
                for (int j = 0; j < 4; ++j) v[r][j] = __builtin_nontemporal_load(xr + 64 * j);
            }
#pragma unroll
            for (int r = 0; r < 4; ++r) {
                const int row = row0 + r;
                float s = 0.f;
#pragma unroll
                for (int j = 0; j < 4; ++j) s += (v[r][j][0] * v[r][j][0] + v[r][j][1] * v[r][j][1]) + (v[r][j][2] * v[r][j][2] + v[r][j][3] * v[r][j][3]);
                s = wave_sum(s);
                u32x2* o8 = (u32x2*)(XN + (size_t)row * D) + lane;
#pragma unroll
                for (int j = 0; j < 4; ++j) o8[64 * j] = (u32x2){pk2(v[r][j][0], v[r][j][1]), pk2(v[r][j][2], v[r][j][3])};
                if (lane < 4) SS[(size_t)lane * MT + row] = lane == 0 ? s : 0.f;
            }
        } else {
#pragma unroll
            for (int r = 0; r < 4; ++r) { u32x2* o8 = (u32x2*)(XN + (size_t)(row0 + r) * D) + lane;
#pragma unroll
                for (int j = 0; j < 4; ++j) o8[64 * j] = (u32x2){0u, 0u}; }
        }
    }
    constexpr int I_IN = 16 * 40, I_OUT = 16 * 16, I_GU = 16 * 88, I_DN = 44 * 16, I_L = I_IN + I_OUT + I_GU + I_DN;
    for (int it = gw; it < 2 * I_L; it += NGW) {
        const int L = it >= I_L ? 1 : 0; int r = it - L * I_L;
        if (r < I_IN) { transpose_item(L ? p.in[15] : p.in[7], D, PW, (bf16_t*)(ws + (L ? WS_WIN1 : WS_WIN0)), L ? 3 : 1, L ? p.in[14] : p.in[6], scr, r, lane); continue; } r -= I_IN;
        if (r < I_OUT) { transpose_item(L ? p.in[23] : p.in[13], D, D, (bf16_t*)(ws + (L ? WS_WOUT1 : WS_WOUT0)), 0, nullptr, scr, r, lane); continue; } r -= I_OUT;
        if (r < I_GU) { transpose_item(p.in[25] + (size_t)L * D * 2 * FH, D, 2 * FH, (bf16_t*)(ws + (L ? WS_WGU1 : WS_WGU0)), 2, p.in[24] + L * D, scr, r, lane); continue; } r -= I_GU;
        transpose_item(p.in[26] + (size_t)L * FH * D, FH, D, (bf16_t*)(ws + (L ? WS_WDN1 : WS_WDN0)), 0, nullptr, scr, r, lane);
    }
}


DI float dot2bf(unsigned a, unsigned b, float c) { return __builtin_amdgcn_fdot2_f32_bf16(__builtin_bit_cast(bf16x2_t, a), __builtin_bit_cast(bf16x2_t, b), c, false); }
DI void st8f(float* dst, const u32x4 w) { float f[8]; unpack8(w, f); *(f32x4*)dst = (f32x4){f[0], f[1], f[2], f[3]}; *(f32x4*)(dst + 4) = (f32x4){f[4], f[5], f[6], f[7]}; }

constexpr int CV_PAR = 98304;
DI void phase_conv(const Params& p, LAS unsigned char* lds) {
    const int tid = threadIdx.x, lane = tid & 63, wid = __builtin_amdgcn_readfirstlane(tid >> 6);
    unsigned char* ws = p.ws;
    const bf16_t* A0 = (const bf16_t*)(ws + WS_A); const bf16_t* Z0 = (const bf16_t*)(ws + WS_A + SUB); const bf16_t* GB0 = (const bf16_t*)(ws + WS_A + 2 * SUB);
    bf16_t* CAT = (bf16_t*)(ws + WS_CAT);
    const float* cache_a = p.in[2]; const float* cache_b = p.in[3];
    const float* caw = p.in[8];
    float* out = p.out;
    const int c0 = lane * 8, par = wid >> 2;
    __syncthreads();
    {
        LAS float* pr = (LAS float*)(lds + CV_PAR);
        for (int i = tid; i < 512; i += 512) { pr[i] = p.in[9][i]; pr[512 + i] = p.in[10][i]; pr[1024 + i] = p.in[11][i]; pr[1536 + i] = p.in[12][i]; pr[2048 + i] = p.in[12][512 + i]; pr[2560 + i] = p.in[12][1024 + i]; }
    }
    unsigned wp[16][8];
#pragma unroll
    for (int i = 0; i < 16; ++i) {
        const int ja = par ? 2 * i - 1 : 2 * i, jb = ja + 1;
        f32x4 a0 = (f32x4){0.f, 0.f, 0.f, 0.f}, a1 = a0, b0 = a0, b1 = a0;
        if (ja >= 0) { a0 = *(const f32x4*)(caw + ja * MW + c0); a1 = *(const f32x4*)(caw + ja * MW + c0 + 4); }
        if (jb <= 30) { b0 = *(const f32x4*)(caw + jb * MW + c0); b1 = *(const f32x4*)(caw + jb * MW + c0 + 4); }
#pragma unroll
        for (int k = 0; k < 4; ++k) { asm volatile("v_cvt_pk_bf16_f32 %0, %1, %2" : "=v"(wp[i][k]) : "v"(a0[k]), "v"(b0[k])); asm volatile("v_cvt_pk_bf16_f32 %0, %1, %2" : "=v"(wp[i][4 + k]) : "v"(a1[k]), "v"(b1[k])); }
    }
    for (int un = blockIdx.x; un < 520; un += gridDim.x) {
        const bool samp = un >= 512;
        const int b = samp ? un - 512 : un >> 6, t0 = samp ? 0 : (un & 63) * 64, R = samp ? 16 : 64;
        const size_t rowbase = samp ? (size_t)MP + b * 16 : (size_t)b * SEQ;
        __syncthreads();
        for (int pr_ = wid; pr_ < (R + 30) / 2; pr_ += 8) {
            u32x4 v0 = (u32x4){0u, 0u, 0u, 0u}, v1 = v0;
            const int ta = t0 - 30 + 2 * pr_;
            if (ta >= 0) { v0 = *(const u32x4*)(A0 + (rowbase + ta) * MW + c0); v1 = *(const u32x4*)(A0 + (rowbase + ta + 1) * MW + c0); }
            else if (samp) { const f32x4* s0 = (const f32x4*)(cache_a + ((size_t)b * 30 + (30 + ta)) * MW + c0); const f32x4* s1 = s0 + MW / 4; v0 = pk8(s0[0], s0[1]); v1 = pk8(s1[0], s1[1]); }
            u32x4 e0, e1;
            e0.x = (v0.x & 0xffffu) | (v1.x << 16); e0.y = (v0.x >> 16) | (v1.x & 0xffff0000u); e0.z = (v0.y & 0xffffu) | (v1.y << 16); e0.w = (v0.y >> 16) | (v1.y & 0xffff0000u);
            e1.x = (v0.z & 0xffffu) | (v1.z << 16); e1.y = (v0.z >> 16) | (v1.z & 0xffff0000u); e1.z = (v0.w & 0xffffu) | (v1.w << 16); e1.w = (v0.w >> 16) | (v1.w & 0xffff0000u);
            *(LAS u32x4*)(lds + pr_ * 2048 + lane * 16) = e0; *(LAS u32x4*)(lds + pr_ * 2048 + 1024 + lane * 16) = e1;
        }
        __syncthreads();
        const int nrow = R >> 3;
        for (int i = 0; i < nrow; ++i) {
            const int r = par + 2 * ((wid & 3) + 4 * i);
            const int t = t0 + r; const size_t row = rowbase + t;
            const u32x4 zz = *(const u32x4*)(Z0 + row * MW + c0), gbv = *(const u32x4*)(GB0 + row * MW + c0);
            u32x4 z1 = (u32x4){0u, 0u, 0u, 0u}, z2 = z1;
            if (t >= 1) z1 = *(const u32x4*)(Z0 + (row - 1) * MW + c0);
            else if (samp) { const f32x4* s = (const f32x4*)(cache_b + ((size_t)b * 2 + 1) * MW + c0); z1 = pk8(s[0], s[1]); }
            if (t >= 2) z2 = *(const u32x4*)(Z0 + (row - 2) * MW + c0);
            else if (samp) { const f32x4* s = (const f32x4*)(cache_b + ((size_t)b * 2 + t) * MW + c0); z2 = pk8(s[0], s[1]); }
            const LAS float* pr = (const LAS float*)(lds + CV_PAR) + c0;
            f32x4 ac0 = *(const LAS f32x4*)pr, ac1 = *(const LAS f32x4*)(pr + 4);
            const LAS unsigned char* eb = lds + (r >> 1) * 2048 + lane * 16;
#pragma unroll
            for (int q = 0; q < 16; ++q) {
                const u32x4 e0 = *(const LAS u32x4*)(eb + q * 2048), e1 = *(const LAS u32x4*)(eb + q * 2048 + 1024);
                ac0[0] = dot2bf(e0.x, wp[q][0], ac0[0]); ac0[1] = dot2bf(e0.y, wp[q][1], ac0[1]); ac0[2] = dot2bf(e0.z, wp[q][2], ac0[2]); ac0[3] = dot2bf(e0.w, wp[q][3], ac0[3]);
                ac1[0] = dot2bf(e1.x, wp[q][4], ac1[0]); ac1[1] = dot2bf(e1.y, wp[q][5], ac1[1]); ac1[2] = dot2bf(e1.z, wp[q][6], ac1[2]); ac1[3] = dot2bf(e1.w, wp[q][7], ac1[3]);
                if ((q & 1) == 1) __builtin_amdgcn_sched_barrier(0);
            }
            const float mean = wave_sum((ac0[0] + ac0[1]) + (ac0[2] + ac0[3]) + (ac1[0] + ac1[1]) + (ac1[2] + ac1[3])) * (1.0f / 512.0f);
            ac0 -= mean; ac1 -= mean;
            const float rstd = rsqrtf(wave_sum((ac0[0] * ac0[0] + ac0[1] * ac0[1]) + (ac0[2] * ac0[2] + ac0[3] * ac0[3]) + (ac1[0] * ac1[0] + ac1[1] * ac1[1]) + (ac1[2] * ac1[2] + ac1[3] * ac1[3])) * (1.0f / 512.0f) + 1e-5f);
            const f32x4 g0 = *(const LAS f32x4*)(pr + 512), g1 = *(const LAS f32x4*)(pr + 516), b0 = *(const LAS f32x4*)(pr + 1024), b1 = *(const LAS f32x4*)(pr + 1028);
            f32x4 y0 = ac0 * rstd * g0 + b0, y1 = ac1 * rstd * g1 + b1;
#pragma unroll
            for (int k = 0; k < 4; ++k) { y0[k] *= sigmoidf_(y0[k]); y1[k] *= sigmoidf_(y1[k]); }
            *(u32x4*)(CAT + row * D + c0) = pk8(y0, y1);
            float fz[8], f1[8], f2[8], fg[8];
            unpack8(zz, fz); unpack8(z1, f1); unpack8(z2, f2); unpack8(gbv, fg);
            const f32x4 w00 = *(const LAS f32x4*)(pr + 1536), w01 = *(const LAS f32x4*)(pr + 1540), w10 = *(const LAS f32x4*)(pr + 2048), w11 = *(const LAS f32x4*)(pr + 2052), w20 = *(const LAS f32x4*)(pr + 2560), w21 = *(const LAS f32x4*)(pr + 2564);
            f32x4 o0, o1;
#pragma unroll
            for (int k = 0; k < 4; ++k) { o0[k] = fg[k] * (w00[k] * f2[k] + w10[k] * f1[k] + w20[k] * fz[k]); o1[k] = fg[4 + k] * (w01[k] * f2[4 + k] + w11[k] * f1[4 + k] + w21[k] * fz[4 + k]); }
            *(u32x4*)(CAT + row * D + MW + c0) = pk8(o0, o1);
        }
        if (!samp && (un & 63) == 63) {
            for (int i = wid; i < 30; i += 8) st8f(out + O_CAP + ((size_t)b * 30 + i) * MW + c0, *(const u32x4*)(A0 + (rowbase + 4066 + i) * MW + c0));
            if (wid < 2) st8f(out + O_CBP + ((size_t)b * 2 + wid) * MW + c0, *(const u32x4*)(Z0 + (rowbase + 4094 + wid) * MW + c0));
        }
        if (samp) {
            for (int i = wid; i < 30; i += 8) {
                float* dst = out + O_CAS + ((size_t)b * 30 + i) * MW + c0;
                if (i < 14) { const f32x4* s = (const f32x4*)(cache_a + ((size_t)b * 30 + 16 + i) * MW + c0); *(f32x4*)dst = s[0]; *(f32x4*)(dst + 4) = s[1]; }
                else st8f(dst, *(const u32x4*)(A0 + (rowbase + i - 14) * MW + c0));
            }
            if (wid < 2) st8f(out + O_CBS + ((size_t)b * 2 + wid) * MW + c0, *(const u32x4*)(Z0 + (rowbase + 14 + wid) * MW + c0));
        }
    }
    __syncthreads();
}

typedef short v4i16_t __attribute__((ext_vector_type(4)));
DI s16x4 tr_read(const LAS unsigned char* p) { return __builtin_bit_cast(s16x4, __builtin_amdgcn_ds_read_tr16_b64_v4i16((LAS v4i16_t*)p)); }
#define VFR(lo, hi) ((bf16x8){lo[0], lo[1], lo[2], lo[3], hi[0], hi[1], hi[2], hi[3]})
constexpr int KSTR = 272, VSTR = 320, AT_V = 64 * KSTR, AT_BUF = AT_V + 64 * VSTR, AT_B = 2 * AT_BUF;

template <bool SAMPLE>
DI void attn_load_tile(const Params& p, int b, int cp, int hp, int j, u32x4 (&kr)[2], u32x4 (&vr)[2]) {
    const int tid = threadIdx.x, chunk = tid & 15, k0 = tid >> 4;
    const bf16_t* Kb = (const bf16_t*)(p.ws + WS_A + SUB); const bf16_t* Vb = (const bf16_t*)(p.ws + WS_A + 2 * SUB);
#pragma unroll
    for (int i = 0; i < 2; ++i) {
        const int key = i * 32 + k0;
        if (!SAMPLE) {
            const size_t row = (size_t)b * SEQ + (size_t)(2 * cp - 8 + j) * 64 + key;
            kr[i] = *(const u32x4*)(Kb + row * MW + hp * 128 + chunk * 8);
            vr[i] = *(const u32x4*)(Vb + row * MW + hp * 128 + chunk * 8);
        } else {
            if (j < 8) {
                const size_t off = ((size_t)b * 512 + 64 * j + key) * 512 + hp * 128 + chunk * 8;
                const f32x4* ks = (const f32x4*)(p.in[4] + off); const f32x4* vs = (const f32x4*)(p.in[5] + off);
                kr[i] = pk8(ks[0], ks[1]); vr[i] = pk8(vs[0], vs[1]);
            } else if (key < 16) {
                const size_t row = (size_t)MP + b * 16 + key;
                kr[i] = *(const u32x4*)(Kb + row * MW + hp * 128 + chunk * 8);
                vr[i] = *(const u32x4*)(Vb + row * MW + hp * 128 + chunk * 8);
            } else { kr[i] = (u32x4){0u, 0u, 0u, 0u}; vr[i] = (u32x4){0u, 0u, 0u, 0u}; }
        }
    }
}
DI void attn_store_tile(LAS unsigned char* buf, const u32x4 (&kr)[2], const u32x4 (&vr)[2]) {
    const int tid = threadIdx.x, chunk = tid & 15, k0 = tid >> 4;
#pragma unroll
    for (int i = 0; i < 2; ++i) { const int key = i * 32 + k0;
        *(LAS u32x4*)(buf + key * KSTR + chunk * 16) = kr[i];
        *(LAS u32x4*)(buf + AT_V + key * VSTR + chunk * 16) = vr[i]; }
}

template <int BM, bool SMASK>
DI void attn_tile(const LAS unsigned char* kbase, const LAS unsigned char* vbase, const LAS float* bth, int ibase, int h, const bf16x8 (&qf)[4], f32x16& o0, f32x16& o1, float& lsum) {
#pragma unroll
    for (int kb = 0; kb < 2; ++kb) {
        f32x16 pa;
#pragma unroll
        for (int r = 0; r < 16; ++r) pa[r] = 0.f;
#pragma unroll
        for (int d0 = 0; d0 < 4; ++d0) { const bf16x8 a = *(const LAS bf16x8*)(kbase + kb * 32 * KSTR + d0 * 32); pa = __builtin_amdgcn_mfma_f32_32x32x16_bf16(a, qf[d0], pa, 0, 0, 0); }
        if (BM == 0) {
            const float cb = bth[512];
#pragma unroll
            for (int r = 0; r < 16; ++r) pa[r] += cb;
        } else if (BM == 1) {
#pragma unroll
            for (int r = 0; r < 16; ++r) { int idx = ibase - 32 * kb - ((r & 3) + 8 * (r >> 2)); idx = idx > 512 ? 512 : idx; pa[r] += bth[idx]; }
        } else {
            const LAS float* bp = bth + (ibase - 32 * kb - 27);
#pragma unroll
            for (int r = 0; r < 16; ++r) pa[r] += bp[27 - ((r & 3) + 8 * (r >> 2))];
        }
#pragma unroll
        for (int r = 0; r < 16; ++r) pa[r] = __builtin_amdgcn_exp2f(pa[r]);
        if (SMASK) {
#pragma unroll
            for (int r = 0; r < 16; ++r) { const int key = 32 * kb + (r & 3) + 8 * (r >> 2) + 4 * h; if (key >= 16) pa[r] = 0.f; }
        }
#pragma unroll
        for (int r = 0; r < 16; ++r) lsum += pa[r];
#pragma unroll
        for (int s = 0; s < 2; ++s) {
            u32x4 pw; pw.x = pk2(pa[8 * s], pa[8 * s + 1]); pw.y = pk2(pa[8 * s + 2], pa[8 * s + 3]); pw.z = pk2(pa[8 * s + 4], pa[8 * s + 5]); pw.w = pk2(pa[8 * s + 6], pa[8 * s + 7]);
            const bf16x8 pb = __builtin_bit_cast(bf16x8, pw);
            const LAS unsigned char* va = vbase + (kb * 32 + 16 * s) * VSTR;
            { const s16x4 lo = tr_read(va), hi = tr_read(va + 8 * VSTR); o0 = __builtin_amdgcn_mfma_f32_32x32x16_bf16(VFR(lo, hi), pb, o0, 0, 0, 0); }
            { const s16x4 lo = tr_read(va + 64), hi = tr_read(va + 64 + 8 * VSTR); o1 = __builtin_amdgcn_mfma_f32_32x32x16_bf16(VFR(lo, hi), pb, o1, 0, 0, 0); }
        }
    }
}

template <bool SAMPLE>
DI void attn_unit(const Params& p, LAS unsigned char* lds, int b, int cp, int hp) {
    int tid_ = threadIdx.x; asm volatile("" : "+v"(tid_));
    const int tid = tid_, lane = tid & 63, w = __builtin_amdgcn_readfirstlane(tid >> 6), r32 = lane & 31, h = lane >> 5;
    const int cl = SAMPLE ? 0 : (w >> 2), hl = (w >> 1) & 1, head = hp * 2 + hl, qoff = SAMPLE ? 0 : 32 * (w & 1);
    const bf16_t* Qb = (const bf16_t*)(p.ws + WS_A);
    bf16_t* CAT = (bf16_t*)(p.ws + WS_CAT);
    const size_t qrow = SAMPLE ? (size_t)MP + b * 16 + (r32 & 15) : (size_t)b * SEQ + (2 * cp + cl) * 64 + qoff + r32;
    bf16x8 qf[4];
#pragma unroll
    for (int d0 = 0; d0 < 4; ++d0) qf[d0] = *(const bf16x8*)(Qb + qrow * MW + head * 64 + d0 * 16 + h * 8);
    LAS float* bt = (LAS float*)(lds + AT_B);
    const int j_first = SAMPLE ? 0 : (cp >= 4 ? 0 : 8 - 2 * cp), j_last = SAMPLE ? 8 : 9;
    u32x4 ka[2], va_[2], kb_[2], vb_[2];
    attn_load_tile<SAMPLE>(p, b, cp, hp, j_first, ka, va_);
    __syncthreads();
    attn_store_tile(lds + (j_first & 1) * AT_BUF, ka, va_);
    attn_load_tile<SAMPLE>(p, b, cp, hp, j_first + 1, ka, va_);
    if (j_first + 2 <= j_last) attn_load_tile<SAMPLE>(p, b, cp, hp, j_first + 2, kb_, vb_);
    f32x16 o0, o1;
#pragma unroll
    for (int r = 0; r < 16; ++r) { o0[r] = 0.f; o1[r] = 0.f; }
    float lsum = 0.f;
    const int i16 = lane & 15, qd = i16 >> 2, pp = i16 & 3, g16 = (lane >> 4) & 1;
    const int koff = r32 * KSTR + hl * 128 + h * 16;
    const int voff = AT_V + (4 * h + qd) * VSTR + hl * 128 + (16 * g16 + 4 * pp) * 2;
    const LAS float* bth = bt + hl * 516;
#define ATT_STEP(j, KR, VR) do { \
        __syncthreads();                                        \
        if ((j) < j_last) { attn_store_tile(lds + (((j) + 1) & 1) * AT_BUF, KR, VR); if ((j) + 3 <= j_last) attn_load_tile<SAMPLE>(p, b, cp, hp, (j) + 3, KR, VR); } \
        const int t = (j) - cl; \
        if (t >= 0 && t <= 8) { \
            const LAS unsigned char* bufp = lds + ((j) & 1) * AT_BUF; \
            const int ibase = 768 - 64 * t + qoff + r32 - 4 * h; \
            if (t <= 3) attn_tile<0, false>(bufp + koff, bufp + voff, bth, ibase, h, qf, o0, o1, lsum); \
            else if (t == 4) attn_tile<1, false>(bufp + koff, bufp + voff, bth, ibase, h, qf, o0, o1, lsum); \
            else if (SAMPLE && t == 8) attn_tile<2, true>(bufp + koff, bufp + voff, bth, ibase, h, qf, o0, o1, lsum); \
            else attn_tile<2, false>(bufp + koff, bufp + voff, bth, ibase, h, qf, o0, o1, lsum); \
        } } while (0)
    for (int j = j_first; j <= j_last; j += 2) {
        ATT_STEP(j, ka, va_);
        if (j + 1 <= j_last) ATT_STEP(j + 1, kb_, vb_);
    }
#undef ATT_STEP
    lsum += __shfl_xor(lsum, 32);
    const float inv = 1.0f / lsum;
    const bool do_store = SAMPLE ? (w < 4 && (w & 1) == 0 && r32 < 16) : true;
    u32x2 og[8];
#pragma unroll
    for (int gq = 0; gq < 4; ++gq) {
        og[gq] = (u32x2){pk2(o0[4 * gq] * inv, o0[4 * gq + 1] * inv), pk2(o0[4 * gq + 2] * inv, o0[4 * gq + 3] * inv)};
        og[4 + gq] = (u32x2){pk2(o1[4 * gq] * inv, o1[4 * gq + 1] * inv), pk2(o1[4 * gq + 2] * inv, o1[4 * gq + 3] * inv)};
    }
    unsigned char* dstb = (unsigned char*)(CAT + qrow * D + head * 64) + (h ? 16 : 0);
#pragma unroll
    for (int k = 0; k < 8; k += 2) {
        u32x2 a = og[k], b = og[k + 1];
        { auto r = __builtin_amdgcn_permlane32_swap(a.x, b.x, false, false); a.x = r[0]; b.x = r[1]; }
        { auto r = __builtin_amdgcn_permlane32_swap(a.y, b.y, false, false); a.y = r[0]; b.y = r[1]; }
        if (do_store) *(u32x4*)(dstb + 16 * k) = (u32x4){a.x, a.y, b.x, b.y};
    }
}

constexpr int SG_STR = 320, SG_LN = 49152;
struct SguRegs { f32x4 st[4]; u32x4 sv[4]; float bsv; };
DI void sgu_load(const Params& p, int uid, int tid, SguRegs& R) {
    const int b = uid >> 7, ch = (uid >> 2) & 31, g = uid & 3;
    const int lane = tid & 63, w = tid >> 6, r32 = lane & 31;
    const bf16_t* SVb = (const bf16_t*)(p.ws + WS_A + 4 * SUB);
    const float* SVST = (const float*)(p.ws + WS_SVST);
    const size_t r0 = (size_t)b * SEQ + ch * 128;
    const int srow = tid >> 2, qt = tid & 3;
    const f32x4* st = (const f32x4*)(SVST + (r0 + srow) * 16);
#pragma unroll
    for (int i = 0; i < 4; ++i) { R.st[i] = st[i]; R.sv[i] = *(const u32x4*)(SVb + (r0 + srow) * MW + g * 128 + qt * 32 + i * 8); }
    const int ib = w & 3, iloc = 32 * ib + r32;
    R.bsv = p.in[22][g * 128 + iloc];
}
DI void sgu_unit(const Params& p, LAS unsigned char* lds, int uid, int tid, const SguRegs& C, bool has_next, int uid_next, SguRegs& R) {
    const int b = uid >> 7, ch = (uid >> 2) & 31, g = uid & 3;
    const int lane = tid & 63, w = __builtin_amdgcn_readfirstlane(tid >> 6), r32 = lane & 31, h = lane >> 5;
    bf16_t* CAT = (bf16_t*)(p.ws + WS_CAT);
    const float* sw = p.in[21];
    const size_t r0 = (size_t)b * SEQ + ch * 128;
    const int ib = w & 3, dh = w >> 2, iloc = 32 * ib + r32;
    const size_t row = r0 + iloc;
    const float* Wrow = sw + ((size_t)g * 128 + iloc) * 128 + 8 * h;
    f32x4 wv[8][2];
#pragma unroll
    for (int js = 0; js < 8; ++js) { if (js <= 2 * ib + 1) { wv[js][0] = *(const f32x4*)(Wrow + 16 * js); wv[js][1] = *(const f32x4*)(Wrow + 16 * js + 4); } else { wv[js][0] = (f32x4){0.f, 0.f, 0.f, 0.f}; wv[js][1] = wv[js][0]; } }
    const bf16_t* Ub = (const bf16_t*)(p.ws + WS_A + 3 * SUB);
    u32x4 uw[4];
    { const unsigned char* ub = (const unsigned char*)(Ub + row * MW + g * 128 + 64 * dh) + (h ? 16 : 0);
#pragma unroll
      for (int kk = 0; kk < 4; ++kk) uw[kk] = *(const u32x4*)(ub + 32 * kk); }
    if (has_next) sgu_load(p, uid_next, tid, R);
    __syncthreads();
    {
        const int srow = tid >> 2, qt = tid & 3;
        const f32x4 a0 = C.st[0], a1 = C.st[1], a2 = C.st[2], a3 = C.st[3];
        const float s1 = (a0[0] + a0[2]) + (a1[0] + a1[2]) + (a2[0] + a2[2]) + (a3[0] + a3[2]);
        const float s2 = (a0[1] + a0[3]) + (a1[1] + a1[3]) + (a2[1] + a2[3]) + (a3[1] + a3[3]);
        const float mean = s1 * (1.0f / 512.0f), var = s2 * (1.0f / 512.0f) - mean * mean, rstd = rsqrtf(fmaxf(var, 0.f) + 1e-5f);
        const LAS float* lnp = (const LAS float*)(lds + SG_LN);
#pragma unroll
        for (int i = 0; i < 4; ++i) {
            const int c8 = qt * 32 + i * 8, ca = g * 128 + c8;
            float f[8]; unpack8(C.sv[i], f);
            const f32x4 g0 = *(const LAS f32x4*)(lnp + ca), g1 = *(const LAS f32x4*)(lnp + ca + 4), b0 = *(const LAS f32x4*)(lnp + 512 + ca), b1 = *(const LAS f32x4*)(lnp + 512 + ca + 4);
            f32x4 x0, x1;
#pragma unroll
            for (int k = 0; k < 4; ++k) { x0[k] = (f[k] - mean) * rstd * g0[k] + b0[k]; x1[k] = (f[4 + k] - mean) * rstd * g1[k] + b1[k]; }
            *(LAS u32x4*)(lds + srow * SG_STR + c8 * 2) = pk8(x0, x1);
        }
    }
    __syncthreads();
    const int i16 = lane & 15, qd = i16 >> 2, pp = i16 & 3, g16 = (lane >> 4) & 1;
    f32x16 acc0, acc1;
#pragma unroll
    for (int r = 0; r < 16; ++r) { acc0[r] = 0.f; acc1[r] = 0.f; }
    const LAS unsigned char* vb = lds + (8 * h + qd) * SG_STR + (64 * dh + 16 * g16 + 4 * pp) * 2;
#pragma unroll
    for (int js = 0; js < 8; ++js) {
        if (js <= 2 * ib + 1) {
            const int jb = 16 * js + 8 * h;
            f32x4 w0 = wv[js][0], w1 = wv[js][1];
#pragma unroll
            for (int k = 0; k < 4; ++k) { w0[k] = (jb + k <= iloc) ? w0[k] : 0.f; w1[k] = (jb + 4 + k <= iloc) ? w1[k] : 0.f; }
            const bf16x8 bw = __builtin_bit_cast(bf16x8, pk8(w0, w1));
            const LAS unsigned char* va = vb + js * 16 * SG_STR;
            { const s16x4 lo = tr_read(va), hi = tr_read(va + 4 * SG_STR); acc0 = __builtin_amdgcn_mfma_f32_32x32x16_bf16(VFR(lo, hi), bw, acc0, 0, 0, 0); }
            { const s16x4 lo = tr_read(va + 64), hi = tr_read(va + 64 + 4 * SG_STR); acc1 = __builtin_amdgcn_mfma_f32_32x32x16_bf16(VFR(lo, hi), bw, acc1, 0, 0, 0); }
        }
    }
    const float bsv = C.bsv;
    unsigned char* cb = (unsigned char*)(CAT + row * D + MW + g * 128 + 64 * dh) + (h ? 16 : 0);
#pragma unroll
    for (int kk = 0; kk < 4; ++kk) {
        u32x4 u4 = uw[kk];
        { auto r = __builtin_amdgcn_permlane32_swap(u4.x, u4.z, false, false); u4.x = r[0]; u4.z = r[1]; }
        { auto r = __builtin_amdgcn_permlane32_swap(u4.y, u4.w, false, false); u4.y = r[0]; u4.w = r[1]; }
        u32x2 a, b;
        if (kk < 2) {
            const int q0 = 2 * kk, q1 = 2 * kk + 1;
            a = (u32x2){pk2(bflo(u4.x) * (acc0[4 * q0] + bsv), bfhi(u4.x) * (acc0[4 * q0 + 1] + bsv)), pk2(bflo(u4.y) * (acc0[4 * q0 + 2] + bsv), bfhi(u4.y) * (acc0[4 * q0 + 3] + bsv))};
            b = (u32x2){pk2(bflo(u4.z) * (acc0[4 * q1] + bsv), bfhi(u4.z) * (acc0[4 * q1 + 1] + bsv)), pk2(bflo(u4.w) * (acc0[4 * q1 + 2] + bsv), bfhi(u4.w) * (acc0[4 * q1 + 3] + bsv))};
        } else {
            const int q0 = 2 * kk - 4, q1 = 2 * kk - 3;
            a = (u32x2){pk2(bflo(u4.x) * (acc1[4 * q0] + bsv), bfhi(u4.x) * (acc1[4 * q0 + 1] + bsv)), pk2(bflo(u4.y) * (acc1[4 * q0 + 2] + bsv), bfhi(u4.y) * (acc1[4 * q0 + 3] + bsv))};
            b = (u32x2){pk2(bflo(u4.z) * (acc1[4 * q1] + bsv), bfhi(u4.z) * (acc1[4 * q1 + 1] + bsv)), pk2(bflo(u4.w) * (acc1[4 * q1 + 2] + bsv), bfhi(u4.w) * (acc1[4 * q1 + 3] + bsv))};
        }
        { auto r = __builtin_amdgcn_permlane32_swap(a.x, b.x, false, false); a.x = r[0]; b.x = r[1]; }
        { auto r = __builtin_amdgcn_permlane32_swap(a.y, b.y, false, false); a.y = r[0]; b.y = r[1]; }
        *(u32x4*)(cb + 32 * kk) = (u32x4){a.x, a.y, b.x, b.y};
    }
}
DI void sgu_all(const Params& p, LAS unsigned char* lds, int first, int stride) {
    int tid_ = threadIdx.x; asm volatile("" : "+v"(tid_));
    const int tid = tid_;
    __syncthreads();
    { LAS float* lnp = (LAS float*)(lds + SG_LN); lnp[tid] = p.in[19][tid]; lnp[512 + tid] = p.in[20][tid]; }
    if (first >= 1024) { __syncthreads(); return; }
    SguRegs R; sgu_load(p, first, tid, R);
    for (int uid = first; uid < 1024; uid += stride) {
        const SguRegs C = R;
        sgu_unit(p, lds, uid, tid, C, uid + stride < 1024, uid + stride, R);
    }
    __syncthreads();
}

DI void sgu_sample_unit(const Params& p, LAS unsigned char* lds, int b) {
    int tid_ = threadIdx.x; asm volatile("" : "+v"(tid_));
    const int tid = tid_, lane = tid & 63, wid = tid >> 6;
    const bf16_t* Ub = (const bf16_t*)(p.ws + WS_A + 3 * SUB); const bf16_t* SVb = (const bf16_t*)(p.ws + WS_A + 4 * SUB);
    bf16_t* CAT = (bf16_t*)(p.ws + WS_CAT);
    const float* lng = p.in[19]; const float* lnb = p.in[20]; const float* sw = p.in[21]; const float* sb = p.in[22];
    LAS float* vn = (LAS float*)lds;
    const size_t r0 = (size_t)MP + b * 16;
    __syncthreads();
    for (int i = wid; i < 16; i += 8) {
        const int c0 = lane * 8;
        float f[8]; unpack8(*(const u32x4*)(SVb + (r0 + i) * MW + c0), f);
        float s = 0.f;
#pragma unroll
        for (int k = 0; k < 8; ++k) s += f[k];
        const float mean = wave_sum(s) * (1.0f / 512.0f);
        float q = 0.f;
#pragma unroll
        for (int k = 0; k < 8; ++k) { f[k] -= mean; q += f[k] * f[k]; }
        const float rstd = rsqrtf(wave_sum(q) * (1.0f / 512.0f) + 1e-5f);
        float* dst = p.out + O_SVS + ((size_t)b * 16 + i) * MW + c0;
#pragma unroll
        for (int k = 0; k < 8; ++k) { const float y = f[k] * rstd * lng[c0 + k] + lnb[c0 + k]; vn[i * 512 + c0 + k] = y; dst[k] = y; }
    }
    LAS float* wl = (LAS float*)(lds + 32768); LAS float* bl = wl + 1024;
    for (int i = tid; i < 1024; i += 512) wl[i] = sw[((size_t)(i >> 8) * 128 + ((i >> 4) & 15)) * 128 + (i & 15)];
    if (tid < 64) bl[tid] = sb[(tid >> 4) * 128 + (tid & 15)];
    const int cch = tid, g = cch >> 7;
    float uvv[16];
#pragma unroll
    for (int i = 0; i < 16; ++i) uvv[i] = bflo((unsigned)Ub[(r0 + i) * MW + cch]);
    __syncthreads();
    {
        float vv[16];
#pragma unroll
        for (int j = 0; j < 16; ++j) vv[j] = vn[j * 512 + cch];
#pragma unroll
        for (int i = 0; i < 16; ++i) {
            float s = bl[g * 16 + i];
#pragma unroll
            for (int j = 0; j <= i; ++j) s += wl[g * 256 + i * 16 + j] * vv[j];
            const unsigned o = pk2(uvv[i] * s, 0.f);
            CAT[(r0 + i) * D + MW + cch] = (bf16_t)(o & 0xffffu);
        }
    }
}

DI void phase_mix_odd(const Params& p, LAS unsigned char* lds) {
    const int blk = blockIdx.x;
    if (gridDim.x == 256) {
        {
            LAS float* bt = (LAS float*)(lds + AT_B); const float* relb = p.in[18]; const int hp = blk & 3;
            __syncthreads();
            for (int i = threadIdx.x; i < 2 * 513; i += 512) { const int hh = i >= 513 ? 1 : 0, j = i - hh * 513; bt[hh * 516 + j] = relb[(hp * 2 + hh) * 513 + j] * LOG2E; }
        }
        if (blk < 32) attn_unit<true>(p, lds, blk >> 2, 0, blk & 3);
        for (int uid = blk; uid < 1024; uid += 256) attn_unit<false>(p, lds, (uid & 31) >> 2, uid >> 5, uid & 3);
        if (blk >= 32 && blk < 40) sgu_sample_unit(p, lds, blk - 32);
        sgu_all(p, lds, blk, 256);
    } else {
        for (int uid = blk; uid < 1056; uid += gridDim.x) {
            { LAS float* bt = (LAS float*)(lds + AT_B); const float* relb = p.in[18]; const int hp = uid & 3;
              __syncthreads();
              for (int i = threadIdx.x; i < 2 * 513; i += 512) { const int hh = i >= 513 ? 1 : 0, j = i - hh * 513; bt[hh * 516 + j] = relb[(hp * 2 + hh) * 513 + j] * LOG2E; } }
            if (uid < 1024) attn_unit<false>(p, lds, (uid & 31) >> 2, uid >> 5, uid & 3);
            else { const int s_ = uid - 1024; attn_unit<true>(p, lds, s_ >> 2, 0, s_ & 3); }
        }
        sgu_all(p, lds, blk, gridDim.x);
        for (int uid = 1024 + blk; uid < 1032; uid += gridDim.x) sgu_sample_unit(p, lds, uid - 1024);
    }
    __syncthreads();
}

#define XB_TMO      128
#define XB_XCNT(j)  (256  + 64 * (j))
#define XB_XSUB(j)  (1280 + 64 * (j))
#define XB_XGEN(j)  (2304 + 64 * (j))
#define XB_TOP      3328
#define XB_TOPGEN   3392
#define XCD_BAR_WORDS 3456
#define XB_SPIN_CAP (1u << 18)
DI unsigned xb_ld(unsigned* p)              { return __hip_atomic_load(p, __ATOMIC_RELAXED, __HIP_MEMORY_SCOPE_AGENT); }
DI unsigned xb_add(unsigned* p, unsigned v) { return __hip_atomic_fetch_add(p, v, __ATOMIC_RELAXED, __HIP_MEMORY_SCOPE_AGENT); }
DI unsigned xb_xcc_id() { return (unsigned)__builtin_amdgcn_s_getreg((3 << 11) | 20) & 0xFu; }
#define XB_SPIN(cond, bar) do { unsigned _sp = 0; while (cond) { __builtin_amdgcn_s_sleep(1); \
    if ((++_sp & 255u) == 0u) { if (xb_ld(&(bar)[XB_TMO])) break; if (_sp > XB_SPIN_CAP) { atomicAdd(&(bar)[XB_TMO], 1u); break; } } } } while (0)
struct XcdBarrier { unsigned* bar; unsigned x; volatile LAS unsigned* st; };
DI XcdBarrier xcd_barrier_post(unsigned* bar, volatile LAS unsigned* st) {
    XcdBarrier b; b.bar = bar; b.x = xb_xcc_id(); b.st = st;
    if (threadIdx.x == 0) (void)xb_add(&bar[XB_XCNT(b.x)], 1u);
    return b;
}
DI void xcd_barrier_complete(unsigned* bar, unsigned x, unsigned& nloc, unsigned& nx) {
    const unsigned G = gridDim.x * gridDim.y * gridDim.z;
    unsigned sum, cnt, mine, sp = 0u;
    for (;;) {
        sum = 0u; cnt = 0u; mine = 0u;
#pragma unroll
        for (unsigned j = 0; j < 16; ++j) { const unsigned c = xb_ld(&bar[XB_XCNT(j)]); sum += c; cnt += (c > 0u) ? 1u : 0u; mine = (j == x) ? c : mine; }
        if (sum == G) break;
        __builtin_amdgcn_s_sleep(1);
        if ((++sp & 255u) == 0u) { if (xb_ld(&bar[XB_TMO])) break; if (sp > XB_SPIN_CAP) { atomicAdd(&bar[XB_TMO], 1u); break; } }
    }
    nloc = mine > 0u ? mine : 1u; nx = cnt > 0u ? cnt : 1u;
}
DI void xcd_barrier(const XcdBarrier& b) {
    asm volatile("s_waitcnt vmcnt(0)" ::: "memory");
    __syncthreads();
    if (threadIdx.x == 0) {
        unsigned* bar = b.bar;
        __builtin_amdgcn_s_waitcnt(0);
        unsigned nloc = b.st[0], nx = b.st[1];
        if (nloc == 0u) { xcd_barrier_complete(bar, b.x, nloc, nx); b.st[0] = nloc; b.st[1] = nx; }
        const unsigned old = xb_add(&bar[XB_XSUB(b.x)], 1u);
        const unsigned gen = old / nloc;
        if (old + 1u == (gen + 1u) * nloc) {
            __builtin_amdgcn_fence(__ATOMIC_RELEASE, "agent");
            asm volatile("s_waitcnt vmcnt(0)" ::: "memory");
            const unsigned og = xb_add(&bar[XB_TOP], 1u);
            const unsigned tg = og / nx;
            if (og + 1u == (tg + 1u) * nx) xb_add(&bar[XB_TOPGEN], 1u);
            else XB_SPIN(xb_ld(&bar[XB_TOPGEN]) == tg, bar);
            __builtin_amdgcn_fence(__ATOMIC_ACQUIRE, "agent");
            xb_add(&bar[XB_XGEN(b.x)], 1u);
            asm volatile("s_waitcnt vmcnt(0)" ::: "memory");
        } else {
            XB_SPIN(xb_ld(&bar[XB_XGEN(b.x)]) == gen, bar);
            __builtin_amdgcn_fence(__ATOMIC_ACQUIRE, "agent");
            asm volatile("s_waitcnt vmcnt(0)" ::: "memory");
        }
    }
    __syncthreads();
}

__global__ void __launch_bounds__(512, 2) fwd_kernel(Params p) {
    extern __shared__ __attribute__((aligned(16))) unsigned char lds_raw[];
    LAS unsigned char* lds = (LAS unsigned char*)lds_raw;
    const int lo = p.ph_lo, hi = p.ph_hi;
    unsigned char* ws = p.ws;
    bf16_t* XN = (bf16_t*)(ws + WS_XN); bf16_t* CAT = (bf16_t*)(ws + WS_CAT); bf16_t* HID = (bf16_t*)(ws + WS_HID);
    bf16_t* AREG = (bf16_t*)(ws + WS_A);
    float* SS = (float*)(ws + WS_SS); float* SVST = (float*)(ws + WS_SVST);
    float* out = p.out;
    const int G = gridDim.x, cid = blockIdx.x;
    volatile LAS unsigned* bst = (volatile LAS unsigned*)(lds + LDS_BYTES - 64);
    XcdBarrier xbar; xbar.bar = (unsigned*)ws; xbar.x = 0; xbar.st = bst;
    if (hi - lo > 1) {
        if (threadIdx.x < 16) bst[threadIdx.x] = 0u;
        __syncthreads();
        xbar = xcd_barrier_post((unsigned*)ws, bst);
    }
#ifndef PHASE_MASK
#define PHASE_MASK 0x7ff
#endif
#define IN(k) (((PHASE_MASK >> (k)) & 1) && lo <= (k) && (k) < hi)
#ifndef PROBE_DUP
#define PROBE_DUP 0
#endif
#define REPS(k) for (int rep_ = 0; rep_ < ((((PROBE_DUP) >> (k)) & 1) ? 2 : 1); ++rep_)
#define RSYNC() do { if (rep_) cg::this_grid().sync(); } while (0)
#define SEAM(k) do { if (IN(k) && IN((k) + 1)) { xcd_barrier(xbar); } } while (0)
    if (hi > 64) cg::this_grid().sync();
    if (IN(0)) REPS(0) { RSYNC(); phase_prologue(p, lds); __syncthreads(); }
    SEAM(0);
    if (IN(1)) REPS(1) {   RSYNC();
        pg8::Gemm g{XN, (const bf16_t*)(ws + WS_WIN0), MP, PW, D}; pg8::StaticOrder S; S.init(MP, PW, G, cid);
        EpiInEven E{SS + 0 * MT, AREG, (bf16_t*)(ws + WS_A + SUB), (bf16_t*)(ws + WS_A + 2 * SUB)};
        pg8::gemm_phase<EpiInEven, true>(lds, g, S, E);
        SEpiInEven ES{SS + 0 * MT, AREG, (bf16_t*)(ws + WS_A + SUB), (bf16_t*)(ws + WS_A + 2 * SUB)};
        sample_gemm(lds, XN, (const bf16_t*)(ws + WS_WIN0), PW / 256, D, ES);
    }
    SEAM(1);
    if (IN(2)) REPS(2) { RSYNC(); phase_conv(p, lds); }
    SEAM(2);
    if (IN(3)) REPS(3) {   RSYNC();
        pg8::Gemm g{CAT, (const bf16_t*)(ws + WS_WOUT0), MP, D, D}; pg8::StaticOrder S; S.init(MP, D, G, cid);
        EpiResid<0> E{p.in[0], out, XN, SS + 1 * MT};
        pg8::gemm_phase<EpiResid<0>, true>(lds, g, S, E);
        SEpiResid<0> ES{p.in[1] - (size_t)MP * D, out, XN, SS + 1 * MT};
        sample_gemm(lds, CAT, (const bf16_t*)(ws + WS_WOUT0), D / 256, D, ES);
    }
    SEAM(3);
    if (IN(4)) REPS(4) {   RSYNC();
        pg8::Gemm g{XN, (const bf16_t*)(ws + WS_WGU0), MP, 2 * FH, D}; pg8::StaticOrder S; S.init(MP, 2 * FH, G, cid);
        EpiGateUp E{SS + 1 * MT, HID};
        pg8::gemm_phase<EpiGateUp, true>(lds, g, S, E);
        SEpiGateUp ES{SS + 1 * MT, HID};
        sample_gemm(lds, XN, (const bf16_t*)(ws + WS_WGU0), 2 * FH / 256, D, ES);
    }
    SEAM(4);
    if (IN(5)) {
        pg8::Gemm g{HID, (const bf16_t*)(ws + WS_WDN0), MP, D, FH}; pg8::StaticOrder S; S.init(MP, D, G, cid);
        EpiResid<1> E{nullptr, out, XN, SS + 2 * MT};
        pg8::gemm_phase<EpiResid<1>, true>(lds, g, S, E);
        SEpiResid<1> ES{nullptr, out, XN, SS + 2 * MT};
        sample_gemm(lds, HID, (const bf16_t*)(ws + WS_WDN0), D / 256, FH, ES);
    }
    SEAM(5);
    if (IN(6)) REPS(6) {   RSYNC();
        pg8::Gemm g{XN, (const bf16_t*)(ws + WS_WIN1), MP, PW, D}; pg8::StaticOrder S; S.init(MP, PW, G, cid);
        EpiInOdd E{SS + 2 * MT, AREG, p.in[16], p.in[17], SVST, out};
        pg8::gemm_phase<EpiInOdd, true>(lds, g, S, E);
        SEpiInOdd ES{SS + 2 * MT, AREG, p.in[16], p.in[17], SVST, out};
        sample_gemm(lds, XN, (const bf16_t*)(ws + WS_WIN1), PW / 256, D, ES);
    }
    SEAM(6);
    if (IN(7)) REPS(7) { RSYNC(); phase_mix_odd(p, lds); }
    SEAM(7);
    if (IN(8)) {
        pg8::Gemm g{CAT, (const bf16_t*)(ws + WS_WOUT1), MP, D, D}; pg8::StaticOrder S; S.init(MP, D, G, cid);
        EpiResid<1> E{nullptr, out, XN, SS + 3 * MT};
        pg8::gemm_phase<EpiResid<1>, true>(lds, g, S, E);
        SEpiResid<1> ES{nullptr, out, XN, SS + 3 * MT};
        sample_gemm(lds, CAT, (const bf16_t*)(ws + WS_WOUT1), D / 256, D, ES);
    }
    SEAM(8);
    if (IN(9)) REPS(9) {   RSYNC();
        pg8::Gemm g{XN, (const bf16_t*)(ws + WS_WGU1), MP, 2 * FH, D}; pg8::StaticOrder S; S.init(MP, 2 * FH, G, cid);
        EpiGateUp E{SS + 3 * MT, HID};
        pg8::gemm_phase<EpiGateUp, true>(lds, g, S, E);
        SEpiGateUp ES{SS + 3 * MT, HID};
        sample_gemm(lds, XN, (const bf16_t*)(ws + WS_WGU1), 2 * FH / 256, D, ES);
    }
    SEAM(9);
    if (IN(10)) {
        pg8::Gemm g{HID, (const bf16_t*)(ws + WS_WDN1), MP, D, FH}; pg8::StaticOrder S; S.init(MP, D, G, cid);
        EpiResid<2> E{nullptr, out, XN, SS};
        pg8::gemm_phase<EpiResid<2>, true>(lds, g, S, E);
        SEpiResid<2> ES{nullptr, out, XN, SS};
        sample_gemm(lds, HID, (const bf16_t*)(ws + WS_WDN1), D / 256, FH, ES);
    }
#undef IN
#undef SEAM
}

constexpr int N_PHASES = 11;

extern "C" void kernel_launch(void* const* d_in, const int* in_sizes, int n_in, void* d_out, int out_size, void* d_ws, size_t ws_size, hipStream_t stream) {
    static int grid = 0;
    if (grid == 0) {
        if (n_in != 27 || ws_size < WS_END) { fprintf(stderr, "kernel_launch: unexpected n_in %d / ws %zu\n", n_in, ws_size); grid = -1; return; }
        int dev = 0, cus = 0, per_cu = 0;
        hipGetDevice(&dev);
        hipDeviceGetAttribute(&cus, hipDeviceAttributeMultiprocessorCount, dev);
        if (hipFuncSetAttribute((const void*)fwd_kernel, hipFuncAttributeMaxDynamicSharedMemorySize, LDS_BYTES) != hipSuccess) { fprintf(stderr, "kernel_launch: hipFuncSetAttribute failed\n"); grid = -1; return; }
        if (hipOccupancyMaxActiveBlocksPerMultiprocessor(&per_cu, (const void*)fwd_kernel, 512, LDS_BYTES) != hipSuccess || per_cu < 1) { fprintf(stderr, "kernel_launch: occupancy query says %d\n", per_cu); per_cu = 1; }
        (void)hipGetLastError();
        grid = cus;
    }
    if (grid < 0) return;
    Params a{};
    for (int i = 0; i < 27; ++i) a.in[i] = (const float*)d_in[i];
    a.out = (float*)d_out; a.ws = (unsigned char*)d_ws;
#if MK_ONE_LAUNCH
    if (hipMemsetAsync(d_ws, 0, 16384, stream) != hipSuccess) { fprintf(stderr, "kernel_launch: memset failed\n"); return; }
    a.ph_lo = 0; a.ph_hi = N_PHASES;
    void* args[] = {&a};
    hipError_t e = hipLaunchCooperativeKernel((const void*)fwd_kernel, dim3(grid), dim3(512), args, LDS_BYTES, stream);
    if (e != hipSuccess) fprintf(stderr, "cooperative launch failed: %s (grid %d)\n", hipGetErrorString(e), grid);
#else
    for (int ph = 0; ph < N_PHASES; ++ph) {
        a.ph_lo = ph; a.ph_hi = ph + 1;
        hipLaunchKernelGGL(fwd_kernel, dim3(grid), dim3(512), LDS_BYTES, stream, a);
    }
#endif
}
```
